# Optimizing an MI355X kernel written in HIP

```python
import math
import jax
import jax.numpy as jnp
from jax import lax
import numpy as np

D_MODEL = 1024
BATCH = 8
SEQ = 2048
DEPTH = 4

CTX_LEN = 256
GRID_W = 64
N_MIXERS = 2
NA_HEADS = 16
NA_HEAD_DIM = D_MODEL // NA_HEADS
NA_WIN_ROWS = 8
NA_WIN_COLS = 16
DIFF_HEADS = 8
DIFF_HEAD_DIM = D_MODEL // (2 * DIFF_HEADS)
ROPE_THETA = 10000.0
Q_BLOCK = 128
N_EXPERTS = 16
N_GROUPS = 4
EXPERTS_PER_GROUP = N_EXPERTS // N_GROUPS
TOP_K = 2
D_EXPERT = 1024
N_MOD = 6
NORM_EPS = 1e-6
N_NA_LAYERS = (DEPTH + 1) // 2
N_DIFF_LAYERS = DEPTH // 2

kernel_name = "hybrid_natten_diffattn_grouped_moe_dit"


def rms_norm(x, g):
    xf = x.astype(jnp.float32)
    y = xf * lax.rsqrt(jnp.mean(xf * xf, axis=-1, keepdims=True) + NORM_EPS)
    return (y * g.astype(jnp.float32)).astype(x.dtype)


def modulate(h, shift, scale):
    return h * (1 + scale) + shift


def to_heads(t, n_heads, head_dim):
    b, n, _ = t.shape
    return t.reshape(b, n, n_heads, head_dim).transpose(0, 2, 1, 3)


def from_heads(t):
    b, h, n, d = t.shape
    return t.transpose(0, 2, 1, 3).reshape(b, n, h * d)


def axial_rope(n_tokens, head_dim):
    t = jnp.arange(n_tokens)
    row = (t // GRID_W).astype(jnp.float32)
    col = (t % GRID_W).astype(jnp.float32)
    n_freq = head_dim // 4
    inv_freq = ROPE_THETA ** (-jnp.arange(n_freq, dtype=jnp.float32) / n_freq)
    ang = jnp.concatenate([row[:, None] * inv_freq, col[:, None] * inv_freq], axis=-1)
    return jnp.cos(ang), jnp.sin(ang)


def apply_rope(x, cos, sin):
    cos = cos.astype(x.dtype)
    sin = sin.astype(x.dtype)
    x1, x2 = jnp.split(x, 2, axis=-1)
    return jnp.concatenate([x1 * cos - x2 * sin, x1 * sin + x2 * cos], axis=-1)


def dense_attention(q, k, v, scale):
    s = jnp.einsum("bhqd,bhkd->bhqk", q, k).astype(jnp.float32) * scale
    p = jax.nn.softmax(s, axis=-1).astype(v.dtype)
    return jnp.einsum("bhqk,bhkd->bhqd", p, v)


def neighbourhood_attention(hl, hc, w_qkv, w_o, rpb, ctx_out):
    b, s, _ = hl.shape
    rows = s // GRID_W
    wr = min(NA_WIN_ROWS, rows)
    n_band = wr * GRID_W
    scale = NA_HEAD_DIM ** -0.5
    ql, kl, vl = [to_heads(t, NA_HEADS, NA_HEAD_DIM) for t in jnp.split(hl @ w_qkv, 3, axis=-1)]
    qc, kc, vc = [to_heads(t, NA_HEADS, NA_HEAD_DIM) for t in jnp.split(hc @ w_qkv, 3, axis=-1)]
    kl_rows = kl.reshape(b, NA_HEADS, rows, GRID_W, NA_HEAD_DIM)
    vl_rows = vl.reshape(b, NA_HEADS, rows, GRID_W, NA_HEAD_DIM)
    q_blocks = ql.reshape(b, NA_HEADS, rows, GRID_W, NA_HEAD_DIM).transpose(2, 0, 1, 3, 4)
    row_ids = jnp.arange(rows)
    row_start = jnp.clip(row_ids - wr // 2, 0, rows - wr)
    col = jnp.arange(GRID_W)
    col_start = jnp.clip(col - NA_WIN_COLS // 2, 0, GRID_W - NA_WIN_COLS)
    in_window = (col[None, :] >= col_start[:, None]) & (col[None, :] < col_start[:, None] + NA_WIN_COLS)
    band_mask = jnp.broadcast_to(in_window[:, None, :], (GRID_W, wr, GRID_W)).reshape(GRID_W, n_band)
    n_dc = 2 * NA_WIN_COLS - 1
    dc_idx = jnp.clip(col[None, :] - col[:, None] + NA_WIN_COLS - 1, 0, n_dc - 1)
    rpb_flat = rpb.reshape(NA_HEADS, -1)

    def row_block(args):
        q, r, r0 = args
        k = lax.dynamic_slice_in_dim(kl_rows, r0, wr, axis=2).reshape(b, NA_HEADS, n_band, NA_HEAD_DIM)
        v = lax.dynamic_slice_in_dim(vl_rows, r0, wr, axis=2).reshape(b, NA_HEADS, n_band, NA_HEAD_DIM)
        dr_idx = r0 + jnp.arange(wr) - r + NA_WIN_ROWS - 1
        bias_idx = (dr_idx[None, :, None] * n_dc + dc_idx[:, None, :]).reshape(GRID_W, n_band)
        bias = rpb_flat[:, bias_idx].astype(jnp.float32)
        s_nb = jnp.einsum("bhqd,bhkd->bhqk", q, k).astype(jnp.float32) * scale + bias
        s_nb = jnp.where(band_mask, s_nb, -jnp.inf)
        s_ctx = jnp.einsum("bhqd,bhkd->bhqk", q, kc).astype(jnp.float32) * scale
        p = jax.nn.softmax(jnp.concatenate([s_nb, s_ctx], axis=-1), axis=-1).astype(v.dtype)
        return (jnp.einsum("bhqk,bhkd->bhqd", p[..., :n_band], v)
                + jnp.einsum("bhqk,bhkd->bhqd", p[..., n_band:], vc))

    o = lax.map(row_block, (q_blocks, row_ids, row_start))
    o = o.transpose(1, 2, 0, 3, 4).reshape(b, NA_HEADS, s, NA_HEAD_DIM)
    yl = from_heads(o) @ w_o
    yc = from_heads(dense_attention(qc, kc, vc, scale)) @ w_o if ctx_out else None
    return yl, yc


def diff_lambda_init(layer_idx):
    return 0.8 - 0.6 * math.exp(-0.3 * (layer_idx - 1))


def diff_attention(hl, hc, w_qkv, w_o, lam, subln_g, lam_init, cos, sin, ctx_out):
    b, s, _ = hl.shape
    scale = DIFF_HEAD_DIM ** -0.5

    def project(h):
        n = h.shape[1]
        q, k, v = jnp.split(h @ w_qkv, 3, axis=-1)
        q = q.reshape(b, n, DIFF_HEADS, 2, DIFF_HEAD_DIM).transpose(0, 2, 3, 1, 4)
        k = k.reshape(b, n, DIFF_HEADS, 2, DIFF_HEAD_DIM).transpose(0, 2, 3, 1, 4)
        v = to_heads(v, DIFF_HEADS, 2 * DIFF_HEAD_DIM)
        return q, k, v

    ql, kl, vl = project(hl)
    qc, kc, vc = project(hc)
    ql = apply_rope(ql, cos, sin)
    kl = apply_rope(kl, cos, sin)
    lam_f = lam.astype(jnp.float32)
    lam_full = jnp.exp(jnp.sum(lam_f[0] * lam_f[1])) - jnp.exp(jnp.sum(lam_f[2] * lam_f[3])) + lam_init

    def diff_map(q, k, v):
        sc = jnp.einsum("bhiqd,bhikd->bhiqk", q, k).astype(jnp.float32) * scale
        p = jax.nn.softmax(sc, axis=-1)
        a = (p[:, :, 0] - lam_full * p[:, :, 1]).astype(v.dtype)
        return jnp.einsum("bhqk,bhkd->bhqd", a, v)

    k_all = jnp.concatenate([kl, kc], axis=3)
    v_all = jnp.concatenate([vl, vc], axis=2)
    nb = s // Q_BLOCK
    q_blocks = ql.reshape(b, DIFF_HEADS, 2, nb, Q_BLOCK, DIFF_HEAD_DIM).transpose(3, 0, 1, 2, 4, 5)
    o = lax.map(lambda q: diff_map(q, k_all, v_all), q_blocks)
    o = o.transpose(1, 2, 0, 3, 4).reshape(b, DIFF_HEADS, s, 2 * DIFF_HEAD_DIM)

    def finish(t):
        return from_heads(rms_norm(t, subln_g) * (1 - lam_init)) @ w_o

    yl = finish(o)
    yc = finish(diff_map(qc, kc, vc)) if ctx_out else None
    return yl, yc


def grouped_moe(h, router_w, router_b, w_gate, w_up, w_down):
    t = h.shape[0]
    scores = jax.nn.sigmoid((h @ router_w).astype(jnp.float32))
    sel = (scores + router_b.astype(jnp.float32)).reshape(t, N_GROUPS, EXPERTS_PER_GROUP)
    group_score = jnp.sum(lax.top_k(sel, 2)[0], axis=-1)
    group = jnp.argmax(group_score, axis=-1)
    sel_in = jnp.take_along_axis(sel, group[:, None, None], axis=1)[:, 0]
    _, local = lax.top_k(sel_in, TOP_K)
    expert = group[:, None] * EXPERTS_PER_GROUP + local
    gate = jnp.take_along_axis(scores, expert, axis=-1)
    gate = gate / jnp.sum(gate, axis=-1, keepdims=True)
    flat_e = expert.reshape(-1)
    order = jnp.argsort(flat_e)
    tok = order // TOP_K
    sizes = jnp.bincount(flat_e, length=N_EXPERTS).astype(jnp.int32)
    xs = h[tok]
    a = lax.ragged_dot(xs, w_gate, sizes)
    u = lax.ragged_dot(xs, w_up, sizes)
    y = lax.ragged_dot(jax.nn.silu(a) * u, w_down, sizes)
    y = y * gate.reshape(-1)[order][:, None].astype(y.dtype)
    return jnp.zeros_like(h).at[tok].add(y.astype(h.dtype))


def setup_inputs(seed: int = 0) -> dict:
    key = jax.random.key(seed)
    ks = jax.random.split(key, 19)
    d = D_MODEL
    inv = d ** -0.5

    def normal(k, shape, std):
        return jax.random.normal(k, shape, jnp.float32) * std

    return {
        "x": normal(ks[0], (BATCH, SEQ, d), 1.0),
        "c": normal(ks[1], (BATCH, d), 1.0),
        "ctx": normal(ks[2], (BATCH, CTX_LEN, d), 1.0),
        "c_ctx": normal(ks[3], (d,), 1.0),
        "mod_w": normal(ks[4], (DEPTH, d, N_MOD * d), 0.5 * inv),
        "mod_b": normal(ks[5], (DEPTH, N_MOD * d), 0.02),
        "norm_mix": 1.0 + normal(ks[6], (DEPTH, d), 0.02),
        "norm_ffn": 1.0 + normal(ks[7], (DEPTH, d), 0.02),
        "w_qkv": normal(ks[8], (DEPTH, d, 3 * d), inv),
        "w_o": normal(ks[9], (DEPTH, d, d), inv),
        "na_rpb": normal(ks[10], (N_NA_LAYERS, NA_HEADS, 2 * NA_WIN_ROWS - 1, 2 * NA_WIN_COLS - 1), 0.1),
        "diff_lambda": normal(ks[11], (N_DIFF_LAYERS, 4, DIFF_HEAD_DIM), 0.1),
        "diff_subln": 1.0 + normal(ks[12], (N_DIFF_LAYERS, 2 * DIFF_HEAD_DIM), 0.02),
        "router_w": normal(ks[13], (d, N_EXPERTS), inv),
        "router_b": normal(ks[14], (N_EXPERTS,), 0.01),
        "expert_w_gate": normal(ks[15], (DEPTH, N_EXPERTS, d, D_EXPERT), inv),
        "expert_w_up": normal(ks[16], (DEPTH, N_EXPERTS, d, D_EXPERT), inv),
        "expert_w_down": normal(ks[17], (DEPTH, N_EXPERTS, D_EXPERT, d), D_EXPERT ** -0.5),
        "final_norm": 1.0 + normal(ks[18], (d,), 0.02),
    }


def reference(x, c, ctx, c_ctx, mod_w, mod_b, norm_mix, norm_ffn, w_qkv, w_o, na_rpb, diff_lambda,
              diff_subln, router_w, router_b, expert_w_gate, expert_w_up, expert_w_down, final_norm):
    b, s, d_model = x.shape
    cos, sin = axial_rope(s, DIFF_HEAD_DIM)
    c_act = jax.nn.silu(c)
    c_ctx_act = jax.nn.silu(c_ctx)
    xl, xc = x, ctx
    for i in range(DEPTH):
        last = i == DEPTH - 1
        mod_l = jnp.split((c_act @ mod_w[i] + mod_b[i])[:, None, :], N_MOD, axis=-1)
        mod_c = jnp.split((c_ctx_act @ mod_w[i] + mod_b[i])[None, None, :], N_MOD, axis=-1)
        hl = modulate(rms_norm(xl, norm_mix[i]), mod_l[0], mod_l[1])
        hc = modulate(rms_norm(xc, norm_mix[i]), mod_c[0], mod_c[1])
        j = i // N_MIXERS
        if i % N_MIXERS == 0:
            yl, yc = neighbourhood_attention(hl, hc, w_qkv[i], w_o[i], na_rpb[j], not last)
        else:
            yl, yc = diff_attention(hl, hc, w_qkv[i], w_o[i], diff_lambda[j], diff_subln[j],
                                    diff_lambda_init(i + 1), cos, sin, not last)
        xl = xl + mod_l[2] * yl
        hl = modulate(rms_norm(xl, norm_ffn[i]), mod_l[3], mod_l[4])
        if last:
            y = grouped_moe(hl.reshape(-1, d_model), router_w, router_b,
                            expert_w_gate[i], expert_w_up[i], expert_w_down[i])
            xl = xl + mod_l[5] * y.reshape(b, s, d_model)
        else:
            xc = xc + mod_c[2] * yc
            hc = modulate(rms_norm(xc, norm_ffn[i]), mod_c[3], mod_c[4])
            n_lat = b * s
            tokens = jnp.concatenate([hl.reshape(-1, d_model), hc.reshape(-1, d_model)], axis=0)
            y = grouped_moe(tokens, router_w, router_b, expert_w_gate[i], expert_w_up[i], expert_w_down[i])
            xl = xl + mod_l[5] * y[:n_lat].reshape(b, s, d_model)
            xc = xc + mod_c[5] * y[n_lat:].reshape(xc.shape)
    return rms_norm(xl, final_norm)
```

```cpp
#include <hip/hip_runtime.h>
#include <hip/hip_cooperative_groups.h>
#include <cstdio>
#include <cstdint>
namespace cg = cooperative_groups;


typedef unsigned short bf16_t;
typedef float v4f __attribute__((ext_vector_type(4)));
constexpr int D = 1024, NB = 8, SEQ = 2048, CL = 256, NLAT = NB * SEQ, NCTX = NB * CL, NTOK = NLAT + NCTX;
constexpr int DEPTH = 4, NE = 16, NMOD = 6, GW = 64;
constexpr float EPS = 1e-6f, LOG2E = 1.4426950408889634f, QSCALE = 0.125f * 1.4426950408889634f;
constexpr int NTHR = 512, NWAVE = 8;
constexpr int SLOTS = 40960;

constexpr size_t MiB = 1u << 20;
constexpr size_t WS_CTL = 0, CTL_BYTES = 1 * MiB;
constexpr size_t WS_MODS = 1 * MiB;
constexpr size_t WS_ROPE = 2 * MiB;
constexpr size_t WS_TOKI = 3 * MiB;
constexpr size_t WS_LIST = 4 * MiB;
constexpr size_t WS_X = 6 * MiB;
constexpr size_t WS_H = 78 * MiB;
constexpr size_t WS_QK = 114 * MiB;
constexpr size_t WS_VT = 186 * MiB;
constexpr size_t WS_O = 222 * MiB;
constexpr size_t WS_ACT = 258 * MiB;
constexpr size_t WS_Y = 338 * MiB;
constexpr size_t WS_W = 418 * MiB;
constexpr size_t WL_BYTES = 104 * MiB, WO_QK = 0, WO_V = 4 * MiB, WO_O = 6 * MiB, WO_E = 8 * MiB, WE_BYTES = 6 * MiB, WE_2 = 4 * MiB;
constexpr size_t WS_END = WS_W + 4 * WL_BYTES;
constexpr int CW_CNT = 1024;

struct Params {
    const float *x, *c, *ctx, *c_ctx, *mod_w, *mod_b, *norm_mix, *norm_ffn, *w_qkv, *w_o, *na_rpb, *diff_lambda, *diff_subln,
        *router_w, *router_b, *wg, *wu, *wd, *final_norm;
    float* out;
    unsigned char* ws;
    int step_lo, step_hi;
};

__device__ __forceinline__ int tidx() { int t = threadIdx.x; asm volatile("" : "+v"(t)); return t; }
__device__ __forceinline__ int bidx() { int t = blockIdx.x; asm volatile("" : "+s"(t)); return t; }
__device__ __forceinline__ float bf2f(bf16_t v) { return __uint_as_float(((unsigned)v) << 16); }
__device__ __forceinline__ bf16_t f2bf(float f) { unsigned u = __float_as_uint(f); return (bf16_t)((u + 0x7fffu + ((u >> 16) & 1u)) >> 16); }
__device__ __forceinline__ float wave_sum(float v) {
#pragma unroll
    for (int o = 1; o < 64; o <<= 1) v += __shfl_xor(v, o);
    return v;
}
__device__ __forceinline__ float silu_f(float v) { return v / (1.f + __expf(-v)); }
__device__ __forceinline__ int mod_row(int row) { return row < NLAT ? row / SEQ : NB; }
__device__ __forceinline__ float lam_init_of(int layer) { return 0.8f - 0.6f * expf(-0.3f * (float)layer); }

struct Ws {
    unsigned* ctl; float* mods; float* rope_cos; float* rope_sin; int4* toki; float2* tokw; int* list;
    float* X; bf16_t *H, *QK, *VT, *O, *ACT, *Y;
};
__device__ __forceinline__ Ws make_ws(unsigned char* ws) {
    Ws w;
    w.ctl = (unsigned*)(ws + WS_CTL); w.mods = (float*)(ws + WS_MODS); w.rope_cos = (float*)(ws + WS_ROPE); w.rope_sin = w.rope_cos + SEQ * 32;
    w.toki = (int4*)(ws + WS_TOKI); w.tokw = (float2*)(ws + WS_TOKI + (size_t)NTOK * 16); w.list = (int*)(ws + WS_LIST);
    w.X = (float*)(ws + WS_X); w.H = (bf16_t*)(ws + WS_H); w.QK = (bf16_t*)(ws + WS_QK); w.VT = (bf16_t*)(ws + WS_VT); w.O = (bf16_t*)(ws + WS_O);
    w.ACT = (bf16_t*)(ws + WS_ACT); w.Y = (bf16_t*)(ws + WS_Y);
    return w;
}
__device__ __forceinline__ void expert_offsets(const Ws& w, int layer, int* cnt, int* off) {
    int acc = 0;
#pragma unroll
    for (int e = 0; e < NE; ++e) {
        const int c = (int)__hip_atomic_load(w.ctl + CW_CNT + (layer * NE + e) * 64, __ATOMIC_RELAXED, __HIP_MEMORY_SCOPE_AGENT);
        cnt[e] = c; off[e] = acc; acc += (c + 255) & ~255;
    }
    off[NE] = acc;
}

__device__ __forceinline__ void phase_prologue(const Params& p, const Ws& w, float* smem) {
    const int tid = tidx(), bid = bidx(), nb = gridDim.x;
    float* sact = smem;
    float* part = smem + 9 * 1024;
    for (int i = tid; i < 9 * 1024; i += NTHR) { const int r = i >> 10, k = i & 1023; const float v = r < NB ? p.c[r * D + k] : p.c_ctx[k]; sact[i] = silu_f(v); }
    __syncthreads();
    const int col = tid & 127, ks = tid >> 7;
    for (int u = bid; u < DEPTH * (NMOD * D / 128); u += nb) {
        const int layer = u / (NMOD * D / 128), col0 = (u % (NMOD * D / 128)) * 128;
        float acc[9];
#pragma unroll
        for (int r = 0; r < 9; ++r) acc[r] = 0.f;
        const float* wp = p.mod_w + ((size_t)layer * D + ks * 256) * (NMOD * D) + col0 + col;
#pragma unroll 4
        for (int k = 0; k < 256; ++k) {
            const float wv = wp[(size_t)k * (NMOD * D)];
#pragma unroll
            for (int r = 0; r < 9; ++r) acc[r] += sact[r * 1024 + ks * 256 + k] * wv;
        }
#pragma unroll
        for (int r = 0; r < 9; ++r) part[(ks * 9 + r) * 128 + col] = acc[r];
        __syncthreads();
        for (int i = tid; i < 9 * 128; i += NTHR) {
            const int r = i >> 7, cc = i & 127;
            const float v = part[(0 * 9 + r) * 128 + cc] + part[(1 * 9 + r) * 128 + cc] + part[(2 * 9 + r) * 128 + cc] + part[(3 * 9 + r) * 128 + cc];
            w.mods[((size_t)layer * 9 + r) * (NMOD * D) + col0 + cc] = v + p.mod_b[layer * (NMOD * D) + col0 + cc];
        }
        __syncthreads();
    }
    for (int i = bid * NTHR + tid; i < SEQ * 32; i += nb * NTHR) {
        const int t = i >> 5, j = i & 31, f = j & 15;
        const float pos = (float)(j < 16 ? t / GW : t % GW);
        const float inv = powf(10000.0f, -(float)f / 16.0f);
        const float ang = pos * inv;
        w.rope_cos[i] = cosf(ang); w.rope_sin[i] = sinf(ang);
    }
}

__device__ __forceinline__ void phase_norm(const Params& p, const Ws& w, int layer, int mode, __attribute__((address_space(3))) unsigned char* lds) {
#define NLAS __attribute__((address_space(3)))
    const int tid = tidx(), lane = tid & 63, wave = tid >> 6;
    const int gw = bidx() * NWAVE + wave, ngw = gridDim.x * NWAVE;
    const bool combine = (mode == 0 && layer > 0) || mode == 2;
    const int clayer = (mode == 2) ? DEPTH - 1 : layer - 1;
    int cnt[NE], off[NE + 1];
    if (combine) expert_offsets(w, clayer, cnt, off);
    int nrows = NTOK;
    if (mode == 2) nrows = NLAT;
    if (mode == 1 && layer == DEPTH - 1) nrows = NLAT;
    NLAS unsigned* lcnt = (NLAS unsigned*)lds;
    NLAS v4f* lgb = (NLAS v4f*)(lds + 1024);
    const NLAS v4f* rwl = (const NLAS v4f*)(lds + 16384);
    const int rpb = (nrows + (int)gridDim.x - 1) / (int)gridDim.x;
    const int chunk0 = bidx() * rpb;
    if (mode == 1) {
        if (tid < 32) lcnt[tid] = 0u;
        for (int c = tid; c < D * 4; c += NTHR) { const int k = c >> 2, e4 = c & 3, j = k >> 8, ln = (k & 255) >> 2, q = k & 3;
            ((NLAS v4f*)(lds + 16384))[((j * 4 + q) * 4 + e4) * 64 + ln] = ((const v4f*)p.router_w)[c]; }
        __syncthreads();
    }
    const bool from_input = (layer == 0 && mode == 0);
    const int row0 = (mode == 1) ? chunk0 + wave : gw, rstep = (mode == 1) ? NWAVE : ngw;
    const int rend = (mode == 1) ? min(nrows, chunk0 + rpb) : nrows;
    v4f vn[4]; int4 tin = make_int4(0, 0, 0, 0); float2 twn = make_float2(0.f, 0.f);
    if (row0 < rend) {
        const float* src = from_input ? (row0 < NLAT ? p.x + (size_t)row0 * D : p.ctx + (size_t)(row0 - NLAT) * D) : w.X + (size_t)row0 * D;
#pragma unroll
        for (int j = 0; j < 4; ++j) vn[j] = ((const v4f*)src)[64 * j + lane];
        if (combine) { tin = w.toki[row0]; twn = w.tokw[row0]; }
    }
    for (int row = row0; row < rend; row += rstep) {
        const int r = mod_row(row);
        v4f v[4];
#pragma unroll
        for (int j = 0; j < 4; ++j) v[j] = vn[j];
        const int4 ti = tin; const float2 tw = twn;
        {
            const int nrow = row + rstep;
            if (nrow < rend) {
                const float* src = from_input ? (nrow < NLAT ? p.x + (size_t)nrow * D : p.ctx + (size_t)(nrow - NLAT) * D) : w.X + (size_t)nrow * D;
#pragma unroll
                for (int j = 0; j < 4; ++j) vn[j] = ((const v4f*)src)[64 * j + lane];
                if (combine) { tin = w.toki[nrow]; twn = w.tokw[nrow]; }
            }
        }
        if (combine) {
            int o0 = 0, o1 = 0;
#pragma unroll
            for (int e = 0; e < NE; ++e) { if (e == ti.x) o0 = off[e]; if (e == ti.z) o1 = off[e]; }
            const bf16_t* y0 = w.Y + (size_t)(o0 + ti.y) * D; const bf16_t* y1 = w.Y + (size_t)(o1 + ti.w) * D;
            const float* g5 = w.mods + ((size_t)clayer * 9 + r) * (NMOD * D) + 5 * D;
#pragma unroll
            for (int j = 0; j < 4; ++j) {
                const int k = 4 * (64 * j + lane);
                const uint2 a = *(const uint2*)(y0 + k), b = *(const uint2*)(y1 + k);
                const v4f g = *(const v4f*)(g5 + k);
                v[j][0] += g[0] * (tw.x * bf2f((bf16_t)(a.x & 0xffff)) + tw.y * bf2f((bf16_t)(b.x & 0xffff)));
                v[j][1] += g[1] * (tw.x * bf2f((bf16_t)(a.x >> 16)) + tw.y * bf2f((bf16_t)(b.x >> 16)));
                v[j][2] += g[2] * (tw.x * bf2f((bf16_t)(a.y & 0xffff)) + tw.y * bf2f((bf16_t)(b.y & 0xffff)));
                v[j][3] += g[3] * (tw.x * bf2f((bf16_t)(a.y >> 16)) + tw.y * bf2f((bf16_t)(b.y >> 16)));
            }
            if (mode != 2) {
                float* xdst = w.X;
#pragma unroll
                for (int j = 0; j < 4; ++j) ((v4f*)(xdst + (size_t)row * D))[64 * j + lane] = v[j];
            }
        }
        float ss = 0.f;
#pragma unroll
        for (int j = 0; j < 4; ++j) ss += v[j][0] * v[j][0] + v[j][1] * v[j][1] + v[j][2] * v[j][2] + v[j][3] * v[j][3];
        ss = wave_sum(ss);
        const float rinv = rsqrtf(ss * (1.f / D) + EPS);
        if (mode == 2) {
#pragma unroll
            for (int j = 0; j < 4; ++j) {
                const int k = 4 * (64 * j + lane); const v4f g = *(const v4f*)(p.final_norm + k);
                ((v4f*)(p.out + (size_t)row * D))[64 * j + lane] = v[j] * rinv * g;
            }
            continue;
        }
        const float* gn = (mode == 0 ? p.norm_mix : p.norm_ffn) + layer * D;
        const float* mv = w.mods + ((size_t)layer * 9 + r) * (NMOD * D) + (mode == 0 ? 0 : 3 * D);
        float hv[16];
#pragma unroll
        for (int j = 0; j < 4; ++j) {
            const int k = 4 * (64 * j + lane);
            const v4f g = *(const v4f*)(gn + k), sh = *(const v4f*)(mv + k), sc = *(const v4f*)(mv + D + k);
            const v4f hh = v[j] * rinv * g * (1.f + sc) + sh;
            hv[4 * j + 0] = hh[0]; hv[4 * j + 1] = hh[1]; hv[4 * j + 2] = hh[2]; hv[4 * j + 3] = hh[3];
            uint2 o; o.x = (unsigned)f2bf(hv[4 * j]) | ((unsigned)f2bf(hv[4 * j + 1]) << 16); o.y = (unsigned)f2bf(hv[4 * j + 2]) | ((unsigned)f2bf(hv[4 * j + 3]) << 16);
            *(uint2*)(w.H + (size_t)row * D + k) = o;
        }
        if (mode == 1) {
            float lg[NE];
#pragma unroll
            for (int e = 0; e < NE; ++e) lg[e] = 0.f;
#pragma unroll
            for (int j = 0; j < 4; ++j) {
                v4f tw[16];
#pragma unroll
                for (int qe = 0; qe < 16; ++qe) tw[qe] = rwl[(j * 16 + qe) * 64 + lane];
                __builtin_amdgcn_sched_barrier(0);
#pragma unroll
                for (int q = 0; q < 4; ++q) {
                    const float hh = hv[4 * j + q];
#pragma unroll
                    for (int e4 = 0; e4 < 4; ++e4) { const v4f t = tw[q * 4 + e4]; lg[4 * e4] += hh * t[0]; lg[4 * e4 + 1] += hh * t[1]; lg[4 * e4 + 2] += hh * t[2]; lg[4 * e4 + 3] += hh * t[3]; }
                }
            }
            {
                const bool b5 = (lane & 32) != 0, b4 = (lane & 16) != 0, b3 = (lane & 8) != 0, b2 = (lane & 4) != 0;
                float a8[8], a4[4], a2[2];
#pragma unroll
                for (int j = 0; j < 8; ++j) { const float keep = b5 ? lg[j + 8] : lg[j], send = b5 ? lg[j] : lg[j + 8]; a8[j] = keep + __shfl_xor(send, 32); }
#pragma unroll
                for (int j = 0; j < 4; ++j) { const float keep = b4 ? a8[j + 4] : a8[j], send = b4 ? a8[j] : a8[j + 4]; a4[j] = keep + __shfl_xor(send, 16); }
#pragma unroll
                for (int j = 0; j < 2; ++j) { const float keep = b3 ? a4[j + 2] : a4[j], send = b3 ? a4[j] : a4[j + 2]; a2[j] = keep + __shfl_xor(send, 8); }
                float a1 = (b2 ? a2[1] : a2[0]) + __shfl_xor(b2 ? a2[0] : a2[1], 4);
                a1 += __shfl_xor(a1, 2); a1 += __shfl_xor(a1, 1);
                if ((lane & 3) == 0) ((NLAS float*)lgb)[(row - chunk0) * 16 + (lane >> 2)] = a1;
            }
        }
    }
    if (mode == 1) {
        __syncthreads();
        const int row = chunk0 + tid; const bool act = (tid < rpb && row < nrows);
        int i1 = 0, i2 = 0; unsigned lp1 = 0, lp2 = 0; float w1 = 0.f, w2 = 0.f;
        if (act) {
            float sc[NE], sel[NE];
#pragma unroll
            for (int e4 = 0; e4 < 4; ++e4) { const v4f t = lgb[tid * 4 + e4];
#pragma unroll
                for (int q = 0; q < 4; ++q) { const int e = 4 * e4 + q; sc[e] = 1.f / (1.f + expf(-t[q])); sel[e] = sc[e] + p.router_b[e]; } }
            int bg = 0; float bgs = -INFINITY;
#pragma unroll
            for (int g = 0; g < 4; ++g) {
                float m1 = -INFINITY, m2 = -INFINITY;
#pragma unroll
                for (int q = 0; q < 4; ++q) { const float t = sel[4 * g + q]; if (t > m1) { m2 = m1; m1 = t; } else if (t > m2) m2 = t; }
                const float gs = m1 + m2;
                if (gs > bgs) { bgs = gs; bg = g; }
            }
            float m1 = -INFINITY, m2 = -INFINITY;
#pragma unroll
            for (int g = 0; g < 4; ++g) {
                if (g == bg) {
#pragma unroll
                    for (int q = 0; q < 4; ++q) { const float t = sel[4 * g + q]; if (t > m1) { m2 = m1; i2 = i1; m1 = t; i1 = 4 * g + q; } else if (t > m2) { m2 = t; i2 = 4 * g + q; } }
                }
            }
            float s1 = 0.f, s2 = 0.f;
#pragma unroll
            for (int e = 0; e < NE; ++e) { if (e == i1) s1 = sc[e]; if (e == i2) s2 = sc[e]; }
            const float inv = 1.f / (s1 + s2); w1 = s1 * inv; w2 = s2 * inv;
            lp1 = __hip_atomic_fetch_add(lcnt + i1, 1u, __ATOMIC_RELAXED, __HIP_MEMORY_SCOPE_WORKGROUP);
            lp2 = __hip_atomic_fetch_add(lcnt + i2, 1u, __ATOMIC_RELAXED, __HIP_MEMORY_SCOPE_WORKGROUP);
        }
        __syncthreads();
        if (tid < NE) lcnt[16 + tid] = atomicAdd(w.ctl + CW_CNT + (layer * NE + tid) * 64, lcnt[tid]);
        __syncthreads();
        if (act) {
            const int p1 = (int)(lcnt[16 + i1] + lp1), p2 = (int)(lcnt[16 + i2] + lp2);
            w.list[(size_t)i1 * NTOK + p1] = row; w.list[(size_t)i2 * NTOK + p2] = row;
            w.toki[row] = make_int4(i1, p1, i2, p2); w.tokw[row] = make_float2(w1, w2);
        }
        __syncthreads();
    }
#undef NLAS
}

#define LAS __attribute__((address_space(3)))
#define GAS __attribute__((address_space(1)))
typedef short bf16x8 __attribute__((ext_vector_type(8)));
typedef float f32x4 __attribute__((ext_vector_type(4)));
typedef unsigned u32x4 __attribute__((ext_vector_type(4)));
typedef unsigned u32x2 __attribute__((ext_vector_type(2)));

constexpr int RING_BYTES = 131072;
constexpr int LDSCTL_OFF = RING_BYTES, MISC_OFF = LDSCTL_OFF + 320, TILETAB_OFF = LDSCTL_OFF + 1024, STASH_OFF = LDSCTL_OFF + 4096;
constexpr int LDS_BYTES = 147456;

__device__ __forceinline__ unsigned cvt_pk_bf16(float lo, float hi) { unsigned r; asm volatile("v_cvt_pk_bf16_f32 %0, %1, %2" : "=v"(r) : "v"(lo), "v"(hi)); return r; }

namespace pg8 {
constexpr int BM = 256, BK = 64, HALF = 128, HTB = HALF * BK * 2, STAGE_BYTES = 8 * HTB, NXCD = 8, WGM = 8;
__host__ __device__ __forceinline__ int lds_byte(int r, int c) { const int st = (r >> 4) * 2 + (c >> 5), rr = r & 15, cc = c & 31, ob = rr * 64 + cc * 2; return st * 1024 + (ob ^ (((ob >> 9) & 1) << 5)); }
__host__ __device__ __forceinline__ void stage_rc(int b, int& R, int& C) { const int st = b / 1024, sb = b % 1024, swz = sb ^ (((sb >> 9) & 1) << 5); R = (st >> 1) * 16 + swz / 64; C = (st & 1) * 32 + (swz % 64) / 2; }
__host__ __device__ __forceinline__ int perm32(int rho) { const int n = rho >> 4, i = rho & 15; return 8 * (i >> 2) + 4 * n + (i & 3); }

struct Unit { int pm, pn, kind, aux; const char* a; const char* b; const int* lst; int valid; };
__device__ __forceinline__ void tile_order(int L, int nM, int nN, int& pm, int& pn) {
    const int nwg = nM * nN; int wgid = L;
    { const int q = nwg / NXCD, r = nwg % NXCD, xcd = wgid % NXCD, off = wgid / NXCD; wgid = (xcd < r ? xcd * (q + 1) : r * (q + 1) + (xcd - r) * q) + off; }
    const int nig = WGM * nN, gid = wgid / nig, fm = gid * WGM, gsz = (nM - fm) < WGM ? (nM - fm) : WGM;
    pm = fm + ((wgid % nig) % gsz); pn = (wgid % nig) / gsz;
}

template <class Epi, class Sched, bool ALIGN_EPI, bool SP2>
__device__ __forceinline__ void gemm_phase(LAS unsigned char* lds, const int K, const Sched& S, const Epi& E) {
    const int tid = tidx(), wid = __builtin_amdgcn_readfirstlane(tid >> 6), lane = tid & 63, wr = wid >> 2, wc = wid & 3, fr = lane & 15, fq = lane >> 4;
    const int nt = K / BK;
    unsigned voffB[2];
#pragma unroll
    for (int i = 0; i < 2; ++i) { int R, C; stage_rc(tid * 16 + i * 8192, R, C); const int Rb = Epi::PERM ? ((R & ~31) + perm32(R & 31)) : R; voffB[i] = (unsigned)(Rb * K + C) * 2u; }
#define PG8_AOFF(u, h, i) ([&]() { int R_, C_; stage_rc(tid * 16 + (i) * 8192, R_, C_); return S.a_off((u), (h), R_, C_, K); }())
    const size_t kstep = (size_t)(BK * 2);
    const size_t hstep = (size_t)HALF * K * 2;
    const unsigned ldsw = (unsigned)wid * 1024u;
    const int aoff = lds_byte(wr * 64 + fr, fq * 8), boff = lds_byte(wc * 32 + fr, fq * 8);
#define PG8_SA(b, h) (((b) * 2 + (h)) * HTB)
#define PG8_SB(b, h) ((4 + (b) * 2 + (h)) * HTB)
#define PG8_STAGE(bufoff, gbase, voff) do { _Pragma("unroll") for (int _i = 0; _i < 2; ++_i) \
        __builtin_amdgcn_global_load_lds((const unsigned*)((const char*)(gbase) + (voff)[_i]), (LAS unsigned*)(lds + (bufoff) + ldsw + _i * 8192), 16, 0, 0); } while (0)
#define PG8_LDA(dst, b, h) do { _Pragma("unroll") for (int m = 0; m < 4; ++m) _Pragma("unroll") for (int k = 0; k < 2; ++k) dst[m][k] = *(const LAS bf16x8*)(lds + PG8_SA(b, h) + aoff + m * 2048 + k * 1024); } while (0)
#define PG8_LDB(dst, b, h) do { _Pragma("unroll") for (int n = 0; n < 2; ++n) _Pragma("unroll") for (int k = 0; k < 2; ++k) dst[n][k] = *(const LAS bf16x8*)(lds + PG8_SB(b, h) + boff + n * 2048 + k * 1024); } while (0)
#define PG8_MMA(ai, bj, At, Bt) do { __builtin_amdgcn_s_setprio(1); _Pragma("unroll") for (int m = 0; m < 4; ++m) _Pragma("unroll") for (int n = 0; n < 2; ++n) _Pragma("unroll") for (int k = 0; k < 2; ++k) \
        acc[ai][bj][m][n] = __builtin_amdgcn_mfma_f32_16x16x32_bf16(Bt[n][k], At[m][k], acc[ai][bj][m][n], 0, 0, 0); __builtin_amdgcn_s_setprio(0); } while (0)
#define PG8_WAIT_V(n) asm volatile("s_waitcnt vmcnt(" #n ")" ::: "memory")
#define PG8_WAIT_L(n) asm volatile("s_waitcnt lgkmcnt(" #n ")" ::: "memory")
#define PG8_BAR __builtin_amdgcn_s_barrier()
#define PG8_SCHED __builtin_amdgcn_sched_barrier(0)
    Unit cur, nxt; int ui = 0;
    if (!S.next(0, cur)) return;
    unsigned vAc[2][2];
#define PG8_STASH ((LAS u32x4*)(lds + (STASH_OFF - 0)) + tid)
#pragma unroll
    for (int h = 0; h < 2; ++h)
#pragma unroll
        for (int i = 0; i < 2; ++i) vAc[h][i] = PG8_AOFF(cur, h, i);
    f32x4 acc[2][2][4][2];
#pragma unroll
    for (int a = 0; a < 2; ++a)
#pragma unroll
        for (int b = 0; b < 2; ++b)
#pragma unroll
            for (int m = 0; m < 4; ++m)
#pragma unroll
                for (int n = 0; n < 2; ++n) acc[a][b][m][n] = (f32x4){0.f, 0.f, 0.f, 0.f};
    bf16x8 At[4][2], B0[2][2], B1[2][2];
    const char* cA = cur.a; const char* cB = cur.b;
    if constexpr (SP2) {
        PG8_STAGE(PG8_SB(0, 0), cB, voffB); PG8_STAGE(PG8_SB(0, 1), cB + hstep, voffB); PG8_STAGE(PG8_SA(0, 0), cA, vAc[0]); PG8_STAGE(PG8_SA(0, 1), cA, vAc[1]);
        if (wr == 1) PG8_BAR;
        PG8_WAIT_V(2); PG8_BAR;
        PG8_STAGE(PG8_SB(1, 0), cB + kstep, voffB); PG8_STAGE(PG8_SA(1, 0), cA + kstep, vAc[0]); PG8_STAGE(PG8_SB(1, 1), cB + hstep + kstep, voffB);
        PG8_WAIT_V(6); PG8_BAR;
    } else {
        PG8_STAGE(PG8_SB(0, 0), cB, voffB); PG8_STAGE(PG8_SA(0, 0), cA, vAc[0]); PG8_STAGE(PG8_SB(0, 1), cB + hstep, voffB); PG8_STAGE(PG8_SA(0, 1), cA, vAc[1]);
        if (wr == 1) PG8_BAR;
        PG8_WAIT_V(4); PG8_BAR;
        PG8_STAGE(PG8_SB(1, 0), cB + kstep, voffB); PG8_STAGE(PG8_SA(1, 0), cA + kstep, vAc[0]); PG8_STAGE(PG8_SB(1, 1), cB + hstep + kstep, voffB);
        PG8_WAIT_V(6); PG8_BAR;
    }
    for (;;) {
        const bool has_next = S.next(ui + 1, nxt);
        const char* nA = has_next ? nxt.a : cA; const char* nB = has_next ? nxt.b : cB;
        if (Sched::GATHER && has_next) { u32x4 t4; t4.x = PG8_AOFF(nxt, 0, 0); t4.y = PG8_AOFF(nxt, 0, 1); t4.z = PG8_AOFF(nxt, 1, 0); t4.w = PG8_AOFF(nxt, 1, 1); *PG8_STASH = t4; }
        for (int t = 0; t < nt; t += 2) {
            const bool last = (t == nt - 2);
            const char* a1 = cA + (size_t)(t + 1) * kstep;
            const char* a2 = last ? nA : cA + (size_t)(t + 2) * kstep; const char* b2 = last ? nB : cB + (size_t)(t + 2) * kstep;
            const char* a3 = a2 + kstep; const char* b3 = b2 + kstep;
            if constexpr (SP2) {
            PG8_LDB(B0, 0, 0); PG8_LDB(B1, 0, 1); PG8_SCHED; PG8_LDA(At, 0, 0); PG8_STAGE(PG8_SA(1, 1), a1, vAc[1]);
            if (Sched::GATHER && last && has_next) { const u32x4 t4 = *PG8_STASH; vAc[0][0] = t4.x; vAc[0][1] = t4.y; vAc[1][0] = t4.z; vAc[1][1] = t4.w; }
            PG8_WAIT_V(8); PG8_WAIT_L(0); PG8_BAR; PG8_MMA(0, 0, At, B0); PG8_MMA(0, 1, At, B1); PG8_BAR; PG8_SCHED;
            PG8_LDA(At, 0, 1); PG8_STAGE(PG8_SB(0, 0), b2, voffB); PG8_STAGE(PG8_SB(0, 1), b2 + hstep, voffB); PG8_STAGE(PG8_SA(0, 0), a2, vAc[0]);
            PG8_WAIT_V(8); PG8_WAIT_L(0); PG8_BAR; PG8_MMA(1, 0, At, B0); PG8_MMA(1, 1, At, B1); PG8_BAR; PG8_SCHED;
            PG8_LDB(B0, 1, 0); PG8_LDB(B1, 1, 1); PG8_SCHED; PG8_LDA(At, 1, 0); PG8_STAGE(PG8_SA(0, 1), a2, vAc[1]);
            PG8_WAIT_V(8); PG8_WAIT_L(0); PG8_BAR; PG8_MMA(0, 0, At, B0); PG8_MMA(0, 1, At, B1); PG8_BAR; PG8_SCHED;
            PG8_LDA(At, 1, 1); PG8_STAGE(PG8_SB(1, 0), b3, voffB); PG8_STAGE(PG8_SB(1, 1), b3 + hstep, voffB); PG8_STAGE(PG8_SA(1, 0), a3, vAc[0]);
            PG8_WAIT_V(8); PG8_WAIT_L(0); PG8_BAR; PG8_MMA(1, 0, At, B0); PG8_MMA(1, 1, At, B1); PG8_BAR; PG8_SCHED;
            } else {
            PG8_LDB(B0, 0, 0); PG8_SCHED; PG8_LDA(At, 0, 0); PG8_STAGE(PG8_SA(1, 1), a1, vAc[1]);
            if (Sched::GATHER && last && has_next) { const u32x4 t4 = *PG8_STASH; vAc[0][0] = t4.x; vAc[0][1] = t4.y; vAc[1][0] = t4.z; vAc[1][1] = t4.w; }
            PG8_WAIT_L(8); PG8_BAR; PG8_WAIT_L(0); PG8_MMA(0, 0, At, B0); PG8_BAR; PG8_SCHED;
            PG8_LDB(B1, 0, 1); PG8_STAGE(PG8_SB(0, 0), b2, voffB);
            PG8_BAR; PG8_WAIT_L(0); PG8_MMA(0, 1, At, B1); PG8_BAR;
            PG8_LDA(At, 0, 1); PG8_STAGE(PG8_SA(0, 0), a2, vAc[0]);
            PG8_BAR; PG8_WAIT_L(0); PG8_MMA(1, 0, At, B0); PG8_BAR; PG8_SCHED;
            PG8_STAGE(PG8_SB(0, 1), b2 + hstep, voffB);
            PG8_WAIT_V(6); PG8_BAR; PG8_MMA(1, 1, At, B1); PG8_BAR;
            PG8_LDB(B0, 1, 0); PG8_SCHED; PG8_LDA(At, 1, 0); PG8_STAGE(PG8_SA(0, 1), a2, vAc[1]);
            PG8_WAIT_L(8); PG8_BAR; PG8_WAIT_L(0); PG8_MMA(0, 0, At, B0); PG8_BAR; PG8_SCHED;
            PG8_LDB(B1, 1, 1); PG8_STAGE(PG8_SB(1, 0), b3, voffB);
            PG8_BAR; PG8_WAIT_L(0); PG8_MMA(0, 1, At, B1); PG8_BAR;
            PG8_LDA(At, 1, 1); PG8_STAGE(PG8_SA(1, 0), a3, vAc[0]);
            PG8_BAR; PG8_WAIT_L(0); PG8_MMA(1, 0, At, B0); PG8_BAR; PG8_SCHED;
            PG8_STAGE(PG8_SB(1, 1), b3 + hstep, voffB);
            PG8_WAIT_V(6); PG8_BAR; PG8_MMA(1, 1, At, B1); PG8_BAR;
            }
        }
        if constexpr (ALIGN_EPI) { if (wr == 0) PG8_BAR; }
        E(acc, cur, wr, wc, fr, fq);
        if (!has_next) break;
#pragma unroll
        for (int a = 0; a < 2; ++a)
#pragma unroll
            for (int b = 0; b < 2; ++b)
#pragma unroll
                for (int m = 0; m < 4; ++m)
#pragma unroll
                    for (int n = 0; n < 2; ++n) acc[a][b][m][n] = (f32x4){0.f, 0.f, 0.f, 0.f};
        cur = nxt; cA = nA; cB = nB; ++ui;
        if constexpr (ALIGN_EPI) { if (wr == 1) PG8_BAR; }
    }
    PG8_WAIT_V(0);
    if constexpr (!ALIGN_EPI) { if (wr == 0) PG8_BAR; }
    PG8_BAR;
#undef PG8_SA
#undef PG8_AOFF
#undef PG8_STASH
#undef PG8_SB
#undef PG8_STAGE
#undef PG8_LDA
#undef PG8_LDB
#undef PG8_MMA
#undef PG8_WAIT_V
#undef PG8_WAIT_L
#undef PG8_BAR
#undef PG8_SCHED
}
}

constexpr size_t TSTEP = (size_t)256 * D * 2;
struct SchedQKV {
    static constexpr bool GATHER = false;
    const char *H, *Wqk, *Wv; int G, c;
    __device__ __forceinline__ bool next(int i, pg8::Unit& u) const {
        const int L = i * G + c;
        if (L < 576) { pg8::tile_order(L, 72, 8, u.pm, u.pn); u.kind = 0; u.a = H + (size_t)u.pm * TSTEP; u.b = Wqk + (size_t)u.pn * TSTEP; return true; }
        if (L < 576 + 288) { pg8::tile_order(L - 576, 4, 72, u.pm, u.pn); u.kind = 1; u.a = Wv + (size_t)u.pm * TSTEP; u.b = H + (size_t)u.pn * TSTEP; return true; }
        return false;
    }
    __device__ __forceinline__ unsigned a_off(const pg8::Unit&, int h, int R, int C, int K) const { return (unsigned)((h * 128 + R) * K + C) * 2u; }
};
struct SchedDense {
    static constexpr bool GATHER = false;
    const char *A, *Bt; int nM, nN, G, c;
    __device__ __forceinline__ bool next(int i, pg8::Unit& u) const {
        const int L = i * G + c; if (L >= nM * nN) return false;
        pg8::tile_order(L, nM, nN, u.pm, u.pn); u.kind = 0; u.a = A + (size_t)u.pm * TSTEP; u.b = Bt + (size_t)u.pn * TSTEP; return true;
    }
    __device__ __forceinline__ unsigned a_off(const pg8::Unit&, int h, int R, int C, int K) const { return (unsigned)((h * 128 + R) * K + C) * 2u; }
};
template <bool GATHERT> struct SchedMoe {
    static constexpr bool GATHER = GATHERT;
    const char* A;
    const char* W;
    const int* list; const LAS unsigned* tab; int ntile, nN, G, c; size_t wofs;
    __device__ __forceinline__ bool next(int i, pg8::Unit& u) const {
        const int L = i * G + c; if (L >= ntile * nN) return false;
        const int mt = L / nN; u.pn = L % nN; u.pm = mt; u.kind = 0;
        const unsigned t0 = __builtin_amdgcn_readfirstlane(tab[2 * mt]), t1 = __builtin_amdgcn_readfirstlane(tab[2 * mt + 1]);
        const int e = (int)(t0 >> 20), first = (int)(t0 & 0xfffff);
        u.aux = e; u.valid = (int)t1; u.lst = list + (size_t)e * NTOK + first;
        u.a = GATHERT ? A : A + (size_t)mt * TSTEP;
        u.b = W + (size_t)e * WE_BYTES + wofs + (size_t)u.pn * TSTEP;
        return true;
    }
    __device__ __forceinline__ unsigned a_off(const pg8::Unit& u, int h, int R, int C, int K) const {
        const int rr = h * 128 + R;
        if (!GATHERT) return (unsigned)(rr * K + C) * 2u;
        const int tok = (rr < u.valid) ? u.lst[rr] : 0;
        return (unsigned)(tok * K + C) * 2u;
    }
};

struct EpiQKV {
    static constexpr bool PERM = true;
    bf16_t* QK; bf16_t* VT; const float* rcos; const float* rsin; bool rope;
    __device__ __forceinline__ void operator()(const f32x4 (&acc)[2][2][4][2], const pg8::Unit& u, int wr, int wc, int fr, int fq) const {
        if (u.kind == 0) {
            const float sc = (u.pn < 4) ? QSCALE : 1.f;
            const bool do_rope = rope && (u.pm * 256 < NLAT);
#pragma unroll
            for (int ai = 0; ai < 2; ++ai)
#pragma unroll
                for (int m = 0; m < 4; ++m) {
                    const int row = u.pm * 256 + ai * 128 + wr * 64 + m * 16 + fr;
                    f32x4 v[2][2];
#pragma unroll
                    for (int bj = 0; bj < 2; ++bj)
#pragma unroll
                        for (int n = 0; n < 2; ++n) v[bj][n] = acc[ai][bj][m][n] * sc;
                    if (do_rope) {
                        const int t = row & (SEQ - 1);
#pragma unroll
                        for (int n = 0; n < 2; ++n) {
                            const f32x4 cs = *(const f32x4*)(rcos + t * 32 + 8 * fq + 4 * n), sn = *(const f32x4*)(rsin + t * 32 + 8 * fq + 4 * n);
                            const f32x4 x1 = v[0][n], x2 = v[1][n];
                            v[0][n] = x1 * cs - x2 * sn; v[1][n] = x1 * sn + x2 * cs;
                        }
                    }
                    bf16_t* rowp = QK + (size_t)row * 2048 + u.pn * 256 + wc * 64 + 8 * fq;
#pragma unroll
                    for (int bj = 0; bj < 2; ++bj) {
                        u32x4 o; o.x = cvt_pk_bf16(v[bj][0][0], v[bj][0][1]); o.y = cvt_pk_bf16(v[bj][0][2], v[bj][0][3]); o.z = cvt_pk_bf16(v[bj][1][0], v[bj][1][1]); o.w = cvt_pk_bf16(v[bj][1][2], v[bj][1][3]);
                        *(u32x4*)(rowp + bj * 32) = o;
                    }
                }
        } else {
#pragma unroll
            for (int ai = 0; ai < 2; ++ai)
#pragma unroll
                for (int m = 0; m < 4; ++m) {
                    const int row = u.pm * 256 + ai * 128 + wr * 64 + m * 16 + fr;
                    bf16_t* rowp = VT + (size_t)row * NTOK + u.pn * 256 + wc * 32 + 8 * fq;
#pragma unroll
                    for (int bj = 0; bj < 2; ++bj) {
                        const f32x4 v0 = acc[ai][bj][m][0], v1 = acc[ai][bj][m][1];
                        u32x4 o; o.x = cvt_pk_bf16(v0[0], v0[1]); o.y = cvt_pk_bf16(v0[2], v0[3]); o.z = cvt_pk_bf16(v1[0], v1[1]); o.w = cvt_pk_bf16(v1[2], v1[3]);
                        *(u32x4*)(rowp + bj * 128) = o;
                    }
                }
        }
    }
};
struct EpiWO {
    static constexpr bool PERM = false;
    const float* xin; const float* cin; float* X; const float* gate  ; bool from_input;
    __device__ __forceinline__ void operator()(const f32x4 (&acc)[2][2][4][2], const pg8::Unit& u, int wr, int wc, int fr, int fq) const {
        const int r = (u.pm * 256 < NLAT) ? (u.pm * 256) / SEQ : NB;
        const int col0 = u.pn * 256 + wc * 32 + 4 * fq;
        f32x4 g[2][2];
#pragma unroll
        for (int bj = 0; bj < 2; ++bj)
#pragma unroll
            for (int n = 0; n < 2; ++n) g[bj][n] = *(const f32x4*)(gate + (size_t)r * (NMOD * D) + col0 + bj * 128 + n * 16);
#pragma unroll
        for (int ai = 0; ai < 2; ++ai) {
            f32x4 bs[4][2][2];
#pragma unroll
            for (int m = 0; m < 4; ++m) {
                const int row = u.pm * 256 + ai * 128 + wr * 64 + m * 16 + fr;
                const float* base = from_input ? (row < NLAT ? xin + (size_t)row * D : cin + (size_t)(row - NLAT) * D) : X + (size_t)row * D;
#pragma unroll
                for (int bj = 0; bj < 2; ++bj)
#pragma unroll
                    for (int n = 0; n < 2; ++n) bs[m][bj][n] = *(const f32x4*)(base + col0 + bj * 128 + n * 16);
            }
#pragma unroll
            for (int m = 0; m < 4; ++m) {
                const int row = u.pm * 256 + ai * 128 + wr * 64 + m * 16 + fr;
                float* outp = X + (size_t)row * D;
#pragma unroll
                for (int bj = 0; bj < 2; ++bj)
#pragma unroll
                    for (int n = 0; n < 2; ++n) *(f32x4*)(outp + col0 + bj * 128 + n * 16) = bs[m][bj][n] + g[bj][n] * acc[ai][bj][m][n];
            }
            asm volatile("" ::: "memory");
        }
    }
};
struct EpiGLU {
    static constexpr bool PERM = true;
    bf16_t* ACT;
    __device__ __forceinline__ void operator()(const f32x4 (&acc)[2][2][4][2], const pg8::Unit& u, int wr, int wc, int fr, int fq) const {
#pragma unroll
        for (int ai = 0; ai < 2; ++ai)
#pragma unroll
            for (int m = 0; m < 4; ++m) {
                const int row = u.pm * 256 + ai * 128 + wr * 64 + m * 16 + fr;
                float t[8];
#pragma unroll
                for (int n = 0; n < 2; ++n)
#pragma unroll
                    for (int q = 0; q < 4; ++q) { const float a = acc[ai][0][m][n][q], b = acc[ai][1][m][n][q]; t[4 * n + q] = a * __builtin_amdgcn_rcpf(1.f + __builtin_amdgcn_exp2f(-a * LOG2E)) * b; }
                u32x4 o; o.x = cvt_pk_bf16(t[0], t[1]); o.y = cvt_pk_bf16(t[2], t[3]); o.z = cvt_pk_bf16(t[4], t[5]); o.w = cvt_pk_bf16(t[6], t[7]);
                *(u32x4*)(ACT + (size_t)row * D + u.pn * 128 + wc * 32 + 8 * fq) = o;
            }
    }
};
struct EpiDown {
    static constexpr bool PERM = true;
    bf16_t* Y;
    __device__ __forceinline__ void operator()(const f32x4 (&acc)[2][2][4][2], const pg8::Unit& u, int wr, int wc, int fr, int fq) const {
#pragma unroll
        for (int ai = 0; ai < 2; ++ai)
#pragma unroll
            for (int m = 0; m < 4; ++m) {
                const int row = u.pm * 256 + ai * 128 + wr * 64 + m * 16 + fr;
                bf16_t* rowp = Y + (size_t)row * D + u.pn * 256 + wc * 32 + 8 * fq;
#pragma unroll
                for (int bj = 0; bj < 2; ++bj) {
                    const f32x4 v0 = acc[ai][bj][m][0], v1 = acc[ai][bj][m][1];
                    u32x4 o; o.x = cvt_pk_bf16(v0[0], v0[1]); o.y = cvt_pk_bf16(v0[2], v0[3]); o.z = cvt_pk_bf16(v1[0], v1[1]); o.w = cvt_pk_bf16(v1[2], v1[3]);
                    *(u32x4*)(rowp + bj * 128) = o;
                }
            }
    }
};

__device__ __forceinline__ unsigned pk2_rne(float lo, float hi) { return (unsigned)f2bf(lo) | ((unsigned)f2bf(hi) << 16); }
__device__ __forceinline__ void conv_item(const float* W, int ldw, int k0, int n0, bf16_t* WT, int drow0, LAS float* scr, int lane) {
    float t[32];
    const float* src = W + (size_t)(k0 + (lane >> 5)) * ldw + n0 + (lane & 31);
#pragma unroll
    for (int i = 0; i < 32; ++i) t[i] = src[(size_t)(2 * i) * ldw];
#pragma unroll
    for (int i = 0; i < 32; ++i) scr[(2 * i + (lane >> 5)) * 33 + (lane & 31)] = t[i];
    asm volatile("s_waitcnt lgkmcnt(0)" ::: "memory");
    const int c = lane & 7;
#pragma unroll
    for (int j = 0; j < 4; ++j) { const int n = (lane >> 3) + 8 * j; const LAS float* s = scr + (8 * c) * 33 + n;
        u32x4 o; o.x = pk2_rne(s[0 * 33], s[1 * 33]); o.y = pk2_rne(s[2 * 33], s[3 * 33]); o.z = pk2_rne(s[4 * 33], s[5 * 33]); o.w = pk2_rne(s[6 * 33], s[7 * 33]);
        *(u32x4*)(WT + (size_t)(drow0 + n) * D + k0 + 8 * c) = o; }
    asm volatile("s_waitcnt lgkmcnt(0)" ::: "memory");
}
constexpr int CONV_QKV = 16 * 96, CONV_O = 16 * 32, CONV_E = 16 * 32, CONV_LAYER = CONV_QKV + CONV_O + NE * 3 * CONV_E;
__device__ __forceinline__ void conv_layer_item(const Params& p, unsigned char* ws, int l, int r, LAS float* scr, int lane) {
    unsigned char* wl = ws + WS_W + (size_t)l * WL_BYTES;
    if (r < CONV_QKV) {
        const int kb = r / 96, nb = r % 96, n0 = nb * 32;
        if (n0 < 2048) { const int pn = n0 >> 8, a = n0 & 255, hd = a >> 6, half = (a >> 5) & 1;
            conv_item(p.w_qkv + (size_t)l * D * 3072, 3072, kb * 64, n0, (bf16_t*)(wl + WO_QK), pn * 256 + half * 128 + hd * 32, scr, lane); }
        else conv_item(p.w_qkv + (size_t)l * D * 3072, 3072, kb * 64, n0, (bf16_t*)(wl + WO_V), n0 - 2048, scr, lane);
        return;
    }
    r -= CONV_QKV;
    if (r < CONV_O) { const int kb = r / 32, nb = r % 32; conv_item(p.w_o + (size_t)l * D * D, D, kb * 64, nb * 32, (bf16_t*)(wl + WO_O), nb * 32, scr, lane); return; }
    r -= CONV_O;
    const int e = r / (3 * CONV_E), r2 = r % (3 * CONV_E), which = r2 / CONV_E, r3 = r2 % CONV_E, kb = r3 / 32, nb = r3 % 32, n0 = nb * 32;
    unsigned char* we = wl + WO_E + (size_t)e * WE_BYTES;
    const size_t eo = ((size_t)l * NE + e) * D * D;
    if (which == 0) conv_item(p.wg + eo, D, kb * 64, n0, (bf16_t*)we, (n0 >> 7) * 256 + (n0 & 127), scr, lane);
    else if (which == 1) conv_item(p.wu + eo, D, kb * 64, n0, (bf16_t*)we, (n0 >> 7) * 256 + 128 + (n0 & 127), scr, lane);
    else conv_item(p.wd + eo, D, kb * 64, n0, (bf16_t*)(we + WE_2), n0, scr, lane);
}
__device__ __forceinline__ void phase_convert(const Params& p, unsigned char* ws, LAS unsigned char* lds, int layer_lo, int layer_hi) {
    const int tid = tidx(), lane = tid & 63, wave = tid >> 6;
    LAS float* scr = (LAS float*)(lds + wave * 16384);
    const int gw = bidx() * NWAVE + wave, ngw = gridDim.x * NWAVE;
    for (int it = layer_lo * CONV_LAYER + gw; it < layer_hi * CONV_LAYER; it += ngw) conv_layer_item(p, ws, it / CONV_LAYER, it % CONV_LAYER, scr, lane);
}
constexpr int CONV_CHUNK = 4, CW_CONVQ = 6144;
__device__ __forceinline__ void convert_pull(const Params& p, unsigned char* ws, LAS unsigned char* lds, int l, int budget) {
    if (l >= DEPTH) return;
    const int tid = tidx(), lane = tid & 63, wave = tid >> 6;
    LAS float* scr = (LAS float*)(lds + wave * 16384);
    volatile LAS unsigned* slot = (volatile LAS unsigned*)(lds + MISC_OFF + 96);
    unsigned* q = (unsigned*)(ws + WS_CTL) + CW_CONVQ + 64 * l;
    for (int c = 0; budget < 0 || c < budget; ++c) {
        if (tid == 0) *slot = __hip_atomic_fetch_add(q, (unsigned)(CONV_CHUNK * NWAVE), __ATOMIC_RELAXED, __HIP_MEMORY_SCOPE_AGENT);
        __syncthreads();
        const unsigned base = *slot;
        __syncthreads();
        if (base >= (unsigned)CONV_LAYER) break;
        for (int k = 0; k < CONV_CHUNK; ++k) conv_layer_item(p, ws, l, (int)base + wave * CONV_CHUNK + k, scr, lane);
    }
}

__device__ __forceinline__ int build_tile_table(const Ws& w, int layer, LAS unsigned* tab) {
    int cnt[NE], off[NE + 1];
    expert_offsets(w, layer, cnt, off);
    const int tid = tidx();
    if (tid < 256) {
        int e = -1;
#pragma unroll
        for (int q = 0; q < NE; ++q) if (tid * 256 >= off[q] && tid * 256 < off[q + 1]) e = q;
        int oe = 0, ce = 0;
#pragma unroll
        for (int q = 0; q < NE; ++q) if (q == e) { oe = off[q]; ce = cnt[q]; }
        if (e >= 0) { const int first = tid * 256 - oe; const int valid = min(256, ce - first);
            tab[2 * tid] = ((unsigned)e << 20) | (unsigned)first; tab[2 * tid + 1] = (unsigned)valid; }
    }
    __syncthreads();
    return off[NE] / 256;
}

namespace att {
typedef float f32x16 __attribute__((ext_vector_type(16)));
constexpr int STAGE_B = 32768, K_OFF = 0, V_OFF = 16384, RPB_OFF = 65536, RPB_W = 144, XCH_OFF = 0;
__device__ __forceinline__ int swz(int row, int chunk) { return row * 128 + ((chunk ^ ((row >> 1) & 7)) << 4); }
__device__ __forceinline__ int pi64(int r) { return (r & ~12) | ((r & 4) << 1) | ((r & 8) >> 1); }

template <int DV, int NKSUB> struct Stage { u32x4 k[NKSUB]; u32x4 v[DV / 64]; };

template <int DV, int NKSUB>
__device__ __forceinline__ void stage_load(Stage<DV, NKSUB>& st, const bf16_t* QK, const bf16_t* VT, int tok0, int kcolbase, int vch0, int tid) {
#pragma unroll
    for (int i = 0; i < NKSUB; ++i) { const int idx = tid + NTHR * i, row = idx / (8 * NKSUB), cc = idx % (8 * NKSUB);
        st.k[i] = *(const u32x4*)(QK + (size_t)(tok0 + row) * 2048 + 1024 + kcolbase + cc * 8); }
#pragma unroll
    for (int i = 0; i < DV / 64; ++i) { const int idx = tid + NTHR * i, row = idx >> 3, ch = idx & 7;
        st.v[i] = *(const u32x4*)(VT + (size_t)(vch0 + row) * NTOK + tok0 + ch * 8); }
}
template <int DV, int NKSUB>
__device__ __forceinline__ void stage_store(const Stage<DV, NKSUB>& st, LAS unsigned char* buf, int tid) {
#pragma unroll
    for (int i = 0; i < NKSUB; ++i) { const int idx = tid + NTHR * i, row = idx / (8 * NKSUB), cc = idx % (8 * NKSUB), sub = cc >> 3, ch = cc & 7;
        *(LAS u32x4*)(buf + K_OFF + sub * 8192 + swz(pi64(row), ch)) = st.k[i]; }
#pragma unroll
    for (int i = 0; i < DV / 64; ++i) { const int idx = tid + NTHR * i, row = idx >> 3, ch = idx & 7;
        *(LAS u32x4*)(buf + V_OFF + swz(row, ch)) = st.v[i]; }
}

__device__ __forceinline__ void stage_store_nat(const Stage<64, 1>& st, LAS unsigned char* buf, int tid) {
    { const int row = tid >> 3, ch = tid & 7; *(LAS u32x4*)(buf + K_OFF + swz(row, ch)) = st.k[0]; }
    { const int row = tid >> 3, ch = tid & 7; *(LAS u32x4*)(buf + V_OFF + swz(row, ch)) = st.v[0]; }
}
constexpr float ATT_THR = 8.f;
#ifndef ATT_PRIO
#define ATT_PRIO 1
#endif
template <int DV, bool BIAS>
__device__ __forceinline__ void qk_softmax(const LAS unsigned char* kb, const bf16x8 (&qf)[4], f32x16 (&o)[DV / 32], float& mref, float& l, bool& started,
                                           const float (&pen)[32], const LAS float* brow, int r, int h, bf16x8 (&pb)[4]) {
    f32x16 p0, p1;
#pragma unroll
    for (int i = 0; i < 16; ++i) { p0[i] = -mref; p1[i] = -mref; }
    bf16x8 kfa[4], kfb[4];
#pragma unroll
    for (int s = 0; s < 2; ++s) { kfa[2 * s] = *(const LAS bf16x8*)(kb + swz(r, 2 * s + h)); kfa[2 * s + 1] = *(const LAS bf16x8*)(kb + swz(32 + r, 2 * s + h)); }
#pragma unroll
    for (int s = 2; s < 4; ++s) { kfb[2 * (s - 2)] = *(const LAS bf16x8*)(kb + swz(r, 2 * s + h)); kfb[2 * (s - 2) + 1] = *(const LAS bf16x8*)(kb + swz(32 + r, 2 * s + h)); }
    __builtin_amdgcn_sched_barrier(0);
    if (ATT_PRIO) __builtin_amdgcn_s_setprio(1);
#pragma unroll
    for (int s = 0; s < 2; ++s) { p0 = __builtin_amdgcn_mfma_f32_32x32x16_bf16(kfa[2 * s], qf[s], p0, 0, 0, 0); p1 = __builtin_amdgcn_mfma_f32_32x32x16_bf16(kfa[2 * s + 1], qf[s], p1, 0, 0, 0); }
#pragma unroll
    for (int s = 2; s < 4; ++s) { p0 = __builtin_amdgcn_mfma_f32_32x32x16_bf16(kfb[2 * (s - 2)], qf[s], p0, 0, 0, 0); p1 = __builtin_amdgcn_mfma_f32_32x32x16_bf16(kfb[2 * (s - 2) + 1], qf[s], p1, 0, 0, 0); }
    if (ATT_PRIO) __builtin_amdgcn_s_setprio(0);
    __builtin_amdgcn_sched_barrier(0);
    if (BIAS) {
#pragma unroll
        for (int i = 0; i < 16; ++i) { const int kcl = 16 * (i >> 3) + (i & 7);
            p0[i] = (p0[i] + pen[i]) + brow[kcl]; p1[i] = (p1[i] + pen[16 + i]) + brow[32 + kcl]; }
    }
    float ma = fmaxf(fmaxf(p0[0], p0[1]), p1[0]), mb = fmaxf(fmaxf(p0[2], p0[3]), p1[1]);
    ma = fmaxf(fmaxf(ma, p1[2]), p1[3]);
#pragma unroll
    for (int i = 4; i < 16; i += 4) { ma = fmaxf(fmaxf(ma, p0[i]), p0[i + 1]); mb = fmaxf(fmaxf(mb, p0[i + 2]), p0[i + 3]); ma = fmaxf(fmaxf(ma, p1[i]), p1[i + 1]); mb = fmaxf(fmaxf(mb, p1[i + 2]), p1[i + 3]); }
    float mx = fmaxf(ma, mb);
    mx = fmaxf(mx, __shfl_xor(mx, 32));
    const bool need = (!started && mx > -INFINITY) || (mx > ATT_THR);
    if (__any(need)) {
        const float delta = need ? (started ? fmaxf(mx, 0.f) : mx) : 0.f;
        const float alpha = started ? __builtin_amdgcn_exp2f(-delta) : 1.f;
        started = started || need;
        mref += delta;
#pragma unroll
        for (int i = 0; i < 16; ++i) { p0[i] -= delta; p1[i] -= delta; }
        l *= alpha;
#pragma unroll
        for (int b = 0; b < DV / 32; ++b)
#pragma unroll
            for (int i = 0; i < 16; ++i) o[b][i] *= alpha;
    }
    float rs = 0.f;
#pragma unroll
    for (int i = 0; i < 16; ++i) { p0[i] = __builtin_amdgcn_exp2f(p0[i]); p1[i] = __builtin_amdgcn_exp2f(p1[i]); rs += p0[i] + p1[i]; }
    l += rs;
#pragma unroll
    for (int ks = 0; ks < 4; ++ks) {
        u32x4 t;
        if (ks < 2) { t.x = cvt_pk_bf16(p0[8 * ks + 0], p0[8 * ks + 1]); t.y = cvt_pk_bf16(p0[8 * ks + 2], p0[8 * ks + 3]); t.z = cvt_pk_bf16(p0[8 * ks + 4], p0[8 * ks + 5]); t.w = cvt_pk_bf16(p0[8 * ks + 6], p0[8 * ks + 7]); }
        else { const int q = ks - 2; t.x = cvt_pk_bf16(p1[8 * q + 0], p1[8 * q + 1]); t.y = cvt_pk_bf16(p1[8 * q + 2], p1[8 * q + 3]); t.z = cvt_pk_bf16(p1[8 * q + 4], p1[8 * q + 5]); t.w = cvt_pk_bf16(p1[8 * q + 6], p1[8 * q + 7]); }
        pb[ks] = __builtin_bit_cast(bf16x8, t);
    }
}
template <int DV>
__device__ __forceinline__ void pv_accum(const LAS unsigned char* vb, const bf16x8 (&pb)[4], f32x16 (&o)[DV / 32], int r, int h) {
    bf16x8 vfa[4], vfb[4];
#pragma unroll
    for (int ks = 0; ks < 4; ++ks) vfa[ks] = *(const LAS bf16x8*)(vb + swz(r, 2 * ks + h));
#pragma unroll
    for (int b = 0; b < DV / 32; b += 2) {
        if (b + 1 < DV / 32) {
#pragma unroll
            for (int ks = 0; ks < 4; ++ks) vfb[ks] = *(const LAS bf16x8*)(vb + swz(32 * (b + 1) + r, 2 * ks + h));
        }
        __builtin_amdgcn_sched_barrier(0);
        if (ATT_PRIO) __builtin_amdgcn_s_setprio(1);
#pragma unroll
        for (int ks = 0; ks < 4; ++ks) o[b] = __builtin_amdgcn_mfma_f32_32x32x16_bf16(vfa[ks], pb[ks], o[b], 0, 0, 0);
        if (ATT_PRIO) __builtin_amdgcn_s_setprio(0);
        if (b + 2 < DV / 32) {
#pragma unroll
            for (int ks = 0; ks < 4; ++ks) vfa[ks] = *(const LAS bf16x8*)(vb + swz(32 * (b + 2) + r, 2 * ks + h));
        }
        __builtin_amdgcn_sched_barrier(0);
        if (b + 1 < DV / 32) {
            if (ATT_PRIO) __builtin_amdgcn_s_setprio(1);
#pragma unroll
            for (int ks = 0; ks < 4; ++ks) o[b + 1] = __builtin_amdgcn_mfma_f32_32x32x16_bf16(vfb[ks], pb[ks], o[b + 1], 0, 0, 0);
            if (ATT_PRIO) __builtin_amdgcn_s_setprio(0);
        }
    }
}
template <int DV, bool BIAS>
__device__ __forceinline__ void tile_compute(const LAS unsigned char* buf, int ksub, const bf16x8 (&qf)[4], f32x16 (&o)[DV / 32], float& mref, float& l, bool& started,
                                             const float (&pen)[32], const LAS float* brow, int r, int h) {
    bf16x8 pb[4];
    qk_softmax<DV, BIAS>(buf + K_OFF + ksub * 8192, qf, o, mref, l, started, pen, brow, r, h, pb);
    __builtin_amdgcn_sched_barrier(0);
    pv_accum<DV>(buf + V_OFF, pb, o, r, h);
}

__device__ __forceinline__ void band_tile32(const LAS unsigned char* buf, int x0, const bf16x8 (&qf)[4], f32x16 (&o)[2], float& mref, float& l, bool& started,
                                            const float (&pen16)[16], const LAS float* brow, int r, int h) {
    f32x16 p0;
#pragma unroll
    for (int i = 0; i < 16; ++i) p0[i] = -mref;
    const LAS unsigned char* kb = buf + K_OFF; const LAS unsigned char* vb = buf + V_OFF;
    const int krow = x0 + pi64(r);
    bf16x8 kf[4];
#pragma unroll
    for (int s = 0; s < 4; ++s) kf[s] = *(const LAS bf16x8*)(kb + swz(krow, 2 * s + h));
    __builtin_amdgcn_sched_barrier(0);
    if (ATT_PRIO) __builtin_amdgcn_s_setprio(1);
#pragma unroll
    for (int s = 0; s < 4; ++s) p0 = __builtin_amdgcn_mfma_f32_32x32x16_bf16(kf[s], qf[s], p0, 0, 0, 0);
    if (ATT_PRIO) __builtin_amdgcn_s_setprio(0);
    const int vch = (x0 >> 3) + h;
    bf16x8 vf[4];
#pragma unroll
    for (int b = 0; b < 2; ++b)
#pragma unroll
        for (int ks = 0; ks < 2; ++ks) vf[2 * b + ks] = *(const LAS bf16x8*)(vb + swz(32 * b + r, vch + 2 * ks));
    __builtin_amdgcn_sched_barrier(0);
#pragma unroll
    for (int i = 0; i < 16; ++i) p0[i] = (p0[i] + pen16[i]) + brow[16 * (i >> 3) + (i & 7)];
    float ma = fmaxf(fmaxf(p0[0], p0[1]), p0[2]), mb = fmaxf(fmaxf(p0[3], p0[4]), p0[5]);
#pragma unroll
    for (int i = 6; i < 16; i += 2) { ma = fmaxf(ma, p0[i]); mb = fmaxf(mb, p0[i + 1]); }
    float mx = fmaxf(ma, mb);
    mx = fmaxf(mx, __shfl_xor(mx, 32));
    const bool need = (!started && mx > -INFINITY) || (mx > ATT_THR);
    if (__any(need)) {
        const float delta = need ? (started ? fmaxf(mx, 0.f) : mx) : 0.f;
        const float alpha = started ? __builtin_amdgcn_exp2f(-delta) : 1.f;
        started = started || need;
        mref += delta;
#pragma unroll
        for (int i = 0; i < 16; ++i) p0[i] -= delta;
        l *= alpha;
#pragma unroll
        for (int b = 0; b < 2; ++b)
#pragma unroll
            for (int i = 0; i < 16; ++i) o[b][i] *= alpha;
    }
    float rs = 0.f;
#pragma unroll
    for (int i = 0; i < 16; ++i) { p0[i] = __builtin_amdgcn_exp2f(p0[i]); rs += p0[i]; }
    l += rs;
    bf16x8 pb[2];
#pragma unroll
    for (int ks = 0; ks < 2; ++ks) { u32x4 t; t.x = cvt_pk_bf16(p0[8 * ks + 0], p0[8 * ks + 1]); t.y = cvt_pk_bf16(p0[8 * ks + 2], p0[8 * ks + 3]); t.z = cvt_pk_bf16(p0[8 * ks + 4], p0[8 * ks + 5]); t.w = cvt_pk_bf16(p0[8 * ks + 6], p0[8 * ks + 7]);
        pb[ks] = __builtin_bit_cast(bf16x8, t); }
    __builtin_amdgcn_sched_barrier(0);
    if (ATT_PRIO) __builtin_amdgcn_s_setprio(1);
#pragma unroll
    for (int b = 0; b < 2; ++b)
#pragma unroll
        for (int ks = 0; ks < 2; ++ks) o[b] = __builtin_amdgcn_mfma_f32_32x32x16_bf16(vf[2 * b + ks], pb[ks], o[b], 0, 0, 0);
    if (ATT_PRIO) __builtin_amdgcn_s_setprio(0);
}

__device__ __forceinline__ void natten_phase(const Params& P, const Ws& w, LAS unsigned char* lds, int layer) {
    const bool last = (layer == DEPTH - 1);
    const float* rpb = P.na_rpb + (size_t)(layer / 2) * 16 * 15 * 31;
    LAS float* rtab = (LAS float*)(lds + RPB_OFF);
    const int nlat = NB * 16 * 8, nctx = last ? 0 : NB * 16;
    int tab_head = -1;
    for (int u = bidx(); u < nlat + nctx; u += gridDim.x) {
        const int tid = tidx(), lane = tid & 63, wave = __builtin_amdgcn_readfirstlane(tid >> 6), r = lane & 31, h = lane >> 5;
        const bool isctx = (u >= nlat);
        int b, head, rg = 0;
        if (!isctx) { rg = u & 7; head = (u >> 3) & 15; b = u >> 7; } else { const int u2 = u - nlat; head = u2 & 15; b = u2 >> 4; }
        const int cg = wave & 3, rp = wave >> 2;
        const int qr = 4 * rg + 2 * rp + (r >> 4), qc = 16 * cg + (r & 15);
        const int qtok = isctx ? NLAT + b * CL + 32 * wave + r : b * SEQ + qr * GW + qc;
        const int x0 = (cg == 0) ? 0 : (cg == 1) ? 8 : (cg == 2) ? 24 : 32;
        const int c0 = min(max(qc - 8, 0), 48), r0l = min(max(qr - 4, 0), 24);
        const int rfirst = min(max(4 * rg - 4, 0), 24), rlast = min(max(4 * rg + 3 - 4, 0), 24) + 7;
        const int nband = isctx ? 0 : rlast - rfirst + 1, NT = nband + 4;
        const int wlo = min(max(4 * rg + 2 * rp - 4, 0), 24), whi = min(max(4 * rg + 2 * rp + 1 - 4, 0), 24) + 7;
        auto tile_tok = [&](int t) -> int { return (t < nband) ? b * SEQ + (rfirst + t) * GW : NLAT + b * CL + (t - nband) * 64; };
        Stage<64, 1> st;
        stage_load<64, 1>(st, w.QK, w.VT, tile_tok(0), head * 64, head * 64, tid);
        bf16x8 qf[4];
#pragma unroll
        for (int s = 0; s < 4; ++s) qf[s] = *(const bf16x8*)(w.QK + (size_t)qtok * 2048 + head * 64 + 16 * s + 8 * h);
        if (!isctx && head != tab_head) {
            for (int i = tid; i < 16 * RPB_W; i += NTHR) { const int dr = i / RPB_W, d = i % RPB_W - 63;
                rtab[i] = (dr == 15) ? -INFINITY : (d >= -15 && d <= 15) ? rpb[(head * 15 + dr) * 31 + d + 15] * LOG2E : 0.f; }
            tab_head = head;
        }
        float pen16[16];
#pragma unroll
        for (int i = 0; i < 16; ++i) { const int kc = x0 + 16 * (i >> 3) + 8 * h + (i & 7); pen16[i] = ((unsigned)(kc - c0) < 16u) ? 0.f : -INFINITY; }
        float pen[32];
#pragma unroll
        for (int i = 0; i < 32; ++i) pen[i] = 0.f;
        f32x16 o[2];
#pragma unroll
        for (int i = 0; i < 16; ++i) { o[0][i] = 0.f; o[1][i] = 0.f; }
        float m = 0.f, l = 0.f; bool started = false;
        if (0 < nband) stage_store_nat(st, lds, tid); else stage_store<64, 1>(st, lds, tid);
        __syncthreads();
        for (int t = 0; t < NT; ++t) {
            if (t + 1 < NT) stage_load<64, 1>(st, w.QK, w.VT, tile_tok(t + 1), head * 64, head * 64, tid);
            const LAS unsigned char* buf = lds + (t & 1) * STAGE_B;
            if (t < nband) {
                const int kr = rfirst + t;
                if (kr >= wlo && kr <= whi) {
                    const bool rowok = (kr >= r0l) && (kr < r0l + 8);
                    const LAS float* brow = rtab + (rowok ? (kr - qr + 7) : 15) * RPB_W + 63 - qc + x0 + 8 * h;
                    band_tile32(buf, x0, qf, o, m, l, started, pen16, brow, r, h);
                }
            } else tile_compute<64, false>(buf, 0, qf, o, m, l, started, pen, rtab, r, h);
            if (t + 1 < NT) { if (t + 1 < nband) stage_store_nat(st, lds + ((t + 1) & 1) * STAGE_B, tid); else stage_store<64, 1>(st, lds + ((t + 1) & 1) * STAGE_B, tid); }
            __syncthreads();
        }
        l += __shfl_xor(l, 32);
        const float il = 1.f / l;
        bf16_t* op = w.O + (size_t)qtok * D + head * 64;
#pragma unroll
        for (int bb = 0; bb < 2; ++bb)
#pragma unroll
            for (int g = 0; g < 4; ++g) {
                u32x2 v; v.x = cvt_pk_bf16(o[bb][4 * g] * il, o[bb][4 * g + 1] * il); v.y = cvt_pk_bf16(o[bb][4 * g + 2] * il, o[bb][4 * g + 3] * il);
                *(u32x2*)(op + 32 * bb + 8 * g + 4 * h) = v;
            }
    }
}

__device__ __forceinline__ void diff_phase(const Params& P, const Ws& w, LAS unsigned char* lds, int layer) {
    const int tid = tidx(), lane = tid & 63, wave = __builtin_amdgcn_readfirstlane(tid >> 6), r = lane & 31, h = lane >> 5;
    const bool last = (layer == DEPTH - 1);
    const int j = layer / 2;
    const float* lam = P.diff_lambda + (size_t)j * 4 * 64; const float* sg = P.diff_subln + (size_t)j * 128;
    float d01 = 0.f, d23 = 0.f;
    for (int i = 0; i < 64; ++i) { d01 += lam[i] * lam[64 + i]; d23 += lam[128 + i] * lam[192 + i]; }
    const float li = lam_init_of(layer);
    const float lam_full = expf(d01) - expf(d23) + li;
    const int nlat = NB * 8 * 16, nctx = last ? 0 : NB * 8 * 2;
    const int map = wave >> 2, wq = wave & 3;
    for (int u = bidx(); u < nlat + nctx; u += gridDim.x) {
        const bool isctx = (u >= nlat);
        int b, head, qb;
        if (!isctx) { qb = u & 15; head = (u >> 4) & 7; b = u >> 7; } else { const int u2 = u - nlat; qb = u2 & 1; head = (u2 >> 1) & 7; b = u2 >> 4; }
        const int qtok = (isctx ? NLAT + b * CL : b * SEQ) + 128 * qb + 32 * wq + r;
        const int NT = isctx ? 4 : 36;
        bf16x8 qf[4];
#pragma unroll
        for (int s = 0; s < 4; ++s) qf[s] = *(const bf16x8*)(w.QK + (size_t)qtok * 2048 + head * 128 + map * 64 + 16 * s + 8 * h);
        f32x16 o[4];
#pragma unroll
        for (int bb = 0; bb < 4; ++bb)
#pragma unroll
            for (int i = 0; i < 16; ++i) o[bb][i] = 0.f;
        float m = 0.f, l = 0.f; bool started = false;
        float pen[32];
#pragma unroll
        for (int i = 0; i < 32; ++i) pen[i] = 0.f;
        auto tile_tok = [&](int t) -> int { return (!isctx && t < 32) ? b * SEQ + t * 64 : NLAT + b * CL + (isctx ? t : t - 32) * 64; };
        Stage<128, 2> st;
        stage_load<128, 2>(st, w.QK, w.VT, tile_tok(0), head * 128, head * 128, tid);
        stage_store<128, 2>(st, lds, tid);
        __syncthreads();
        for (int t = 0; t < NT; ++t) {
            if (t + 1 < NT) stage_load<128, 2>(st, w.QK, w.VT, tile_tok(t + 1), head * 128, head * 128, tid);
            tile_compute<128, false>(lds + (t & 1) * STAGE_B, map, qf, o, m, l, started, pen, (const LAS float*)lds, r, h);
            if (t + 1 < NT) stage_store<128, 2>(st, lds + ((t + 1) & 1) * STAGE_B, tid);
            __syncthreads();
        }
        l += __shfl_xor(l, 32);
        const float il = 1.f / l;
        LAS float* xch = (LAS float*)(lds + XCH_OFF) + wq * (128 * 32);
        if (map == 1) {
#pragma unroll
            for (int bb = 0; bb < 4; ++bb)
#pragma unroll
                for (int i = 0; i < 16; ++i) { const int dv = 32 * bb + (i & 3) + 8 * (i >> 2) + 4 * h; xch[dv * 32 + r] = o[bb][i] * il; }
        }
        __syncthreads();
        if (map == 0) {
            f32x4 gg[4][4];
#pragma unroll
            for (int bb = 0; bb < 4; ++bb)
#pragma unroll
                for (int g = 0; g < 4; ++g) gg[bb][g] = *(const f32x4*)(sg + 32 * bb + 8 * g + 4 * h);
            float xv[4][16];
#pragma unroll
            for (int bb = 0; bb < 4; ++bb)
#pragma unroll
                for (int i = 0; i < 16; ++i) xv[bb][i] = xch[(32 * bb + (i & 3) + 8 * (i >> 2) + 4 * h) * 32 + r];
            float ss = 0.f;
#pragma unroll
            for (int bb = 0; bb < 4; ++bb)
#pragma unroll
                for (int i = 0; i < 16; ++i) { const float v = o[bb][i] * il - lam_full * xv[bb][i]; o[bb][i] = v; ss += v * v; }
            ss += __shfl_xor(ss, 32);
            const float rinv = rsqrtf(ss * (1.f / 128.f) + EPS) * (1.f - li);
            bf16_t* op = w.O + (size_t)qtok * D + head * 128;
#pragma unroll
            for (int bb = 0; bb < 4; ++bb)
#pragma unroll
                for (int g = 0; g < 4; ++g) {
                    const int dv = 32 * bb + 8 * g + 4 * h;
                    const f32x4 gw = gg[bb][g];
                    u32x2 v; v.x = cvt_pk_bf16(o[bb][4 * g] * rinv * gw[0], o[bb][4 * g + 1] * rinv * gw[1]); v.y = cvt_pk_bf16(o[bb][4 * g + 2] * rinv * gw[2], o[bb][4 * g + 3] * rinv * gw[3]);
                    *(u32x2*)(op + dv) = v;
                }
        }
        __syncthreads();
    }
}
}

#define XB_TMO      128
#define XB_XCNT(j)  (256  + 64 * (j))
#define XB_XSUB(j)  (1280 + 64 * (j))
#define XB_XGEN(j)  (2304 + 64 * (j))
#define XB_TOP      3328
#define XB_TOPGEN   3392
#define XCD_BAR_WORDS 3456
#define XB_SPIN_CAP (1u << 22)
constexpr int CW_BAR = 8192;
__device__ __forceinline__ unsigned xb_ld(unsigned* p)              { return __hip_atomic_load(p, __ATOMIC_RELAXED, __HIP_MEMORY_SCOPE_AGENT); }
__device__ __forceinline__ unsigned xb_add(unsigned* p, unsigned v) { return __hip_atomic_fetch_add(p, v, __ATOMIC_RELAXED, __HIP_MEMORY_SCOPE_AGENT); }
__device__ __forceinline__ unsigned xb_xcc_id() { return (unsigned)__builtin_amdgcn_s_getreg((3 << 11) | 20) & 0xFu; }
#define XB_SPIN(cond, bar) do { unsigned _sp = 0; while (cond) { __builtin_amdgcn_s_sleep(1); \
    if ((++_sp & 255u) == 0u) { if (xb_ld(&(bar)[XB_TMO])) break; if (_sp > XB_SPIN_CAP) { atomicAdd(&(bar)[XB_TMO], 1u); break; } } } } while (0)
struct XcdBarrier { unsigned* bar; unsigned x; volatile LAS unsigned* st; };
__device__ __forceinline__ XcdBarrier xcd_barrier_post(unsigned* bar, volatile LAS unsigned* st) {
    XcdBarrier b; b.bar = bar; b.x = xb_xcc_id(); b.st = st;
    if (tidx() == 0) (void)xb_add(&bar[XB_XCNT(b.x)], 1u);
    return b;
}
__device__ __forceinline__ void xcd_barrier_complete(unsigned* bar, unsigned x, unsigned& nloc, unsigned& nx) {
    const unsigned G = gridDim.x * gridDim.y * gridDim.z;
    unsigned sum, cnt, mine, sp = 0u;
    for (;;) {
        sum = 0u; cnt = 0u; mine = 0u;
#pragma unroll
        for (unsigned j = 0; j < 16; ++j) { const unsigned c = xb_ld(&bar[XB_XCNT(j)]); sum += c; cnt += (c > 0u) ? 1u : 0u; mine = (j == x) ? c : mine; }
        if (sum == G) break;
        __builtin_amdgcn_s_sleep(1);
        if ((++sp & 255u) == 0u) { if (xb_ld(&bar[XB_TMO])) break; if (sp > XB_SPIN_CAP) { atomicAdd(&bar[XB_TMO], 1u); break; } }
    }
    nloc = mine > 0u ? mine : 1u; nx = cnt > 0u ? cnt : 1u;
}
__device__ __forceinline__ void xcd_barrier(const XcdBarrier& b) {
    asm volatile("s_waitcnt vmcnt(0)" ::: "memory");
    __syncthreads();
    if (tidx() == 0) {
        unsigned* bar = b.bar;
        __builtin_amdgcn_s_waitcnt(0);
        unsigned nloc = b.st[0], nx = b.st[1];
        if (nloc == 0u) { xcd_barrier_complete(bar, b.x, nloc, nx); b.st[0] = nloc; b.st[1] = nx; }
        const unsigned old = xb_add(&bar[XB_XSUB(b.x)], 1u);
        const unsigned gen = old / nloc;
        if (old + 1u == (gen + 1u) * nloc) {
            __builtin_amdgcn_fence(__ATOMIC_RELEASE, "agent");
            asm volatile("s_waitcnt vmcnt(0)" ::: "memory");
            const unsigned og = xb_add(&bar[XB_TOP], 1u);
            const unsigned tg = og / nx;
            if (og + 1u == (tg + 1u) * nx) xb_add(&bar[XB_TOPGEN], 1u);
            else XB_SPIN(xb_ld(&bar[XB_TOPGEN]) == tg, bar);
            __builtin_amdgcn_fence(__ATOMIC_ACQUIRE, "agent");
            xb_add(&bar[XB_XGEN(b.x)], 1u);
            asm volatile("s_waitcnt vmcnt(0)" ::: "memory");
        } else {
            XB_SPIN(xb_ld(&bar[XB_XGEN(b.x)]) == gen, bar);
            __builtin_amdgcn_fence(__ATOMIC_ACQUIRE, "agent");
            asm volatile("s_waitcnt vmcnt(0)" ::: "memory");
        }
    }
    __syncthreads();
}

constexpr int MK_NSTEPS = 2 + 7 * DEPTH;
#ifndef CONV_BUDGET
#define CONV_BUDGET 2
#endif
__global__ void __launch_bounds__(NTHR, 2) mk_fwd(Params p) {
    extern __shared__ __attribute__((aligned(16))) unsigned char lds_raw[];
    LAS unsigned char* lds = (LAS unsigned char*)lds_raw;
    const int tid = tidx();
    for (int u = tid; u < (LDS_BYTES - LDSCTL_OFF) / 4; u += NTHR) ((LAS unsigned*)(lds + LDSCTL_OFF))[u] = 0u;
    __syncthreads();
    volatile LAS unsigned* MISC = (volatile LAS unsigned*)(lds + MISC_OFF);
    XcdBarrier bar = xcd_barrier_post((unsigned*)(p.ws + WS_CTL) + CW_BAR, MISC + 8);
    const int G = gridDim.x, c = bidx();
    for (int s = p.step_lo; s < p.step_hi; ++s) {
        if (s > p.step_lo) {
            if (p.step_hi > 1000000) cg::this_grid().sync();
            xcd_barrier(bar);
        }
#if defined(__HIP_DEVICE_COMPILE__)
        const __attribute__((address_space(4))) Params* pp4 = (const __attribute__((address_space(4))) Params*)__builtin_amdgcn_kernarg_segment_ptr();
        asm volatile("" : "+s"(pp4));
        const Params P = *pp4;
#else
        const Params P = p;
#endif
        unsigned char* wsb = P.ws;
        const Ws w = make_ws(wsb);
        if (s == 0) {
            phase_convert(P, wsb, lds, 0, 1); __syncthreads();
            phase_prologue(P, w, (float*)lds_raw); __syncthreads();
            continue;
        }
        if (s == MK_NSTEPS - 1) { phase_norm(P, w, DEPTH - 1, 2, lds); continue; }
        const int l = (s - 1) / 7, ph = (s - 1) % 7;
        const char* wl = (const char*)(wsb + WS_W + (size_t)l * WL_BYTES);
        if (ph == 0) { phase_norm(P, w, l, 0, lds);
            if (l > 0) { __syncthreads(); convert_pull(P, wsb, lds, l, -1); } }
        else if (ph == 1) {
            SchedQKV S{(const char*)w.H, wl + WO_QK, wl + WO_V, G, c};
            EpiQKV E{w.QK, w.VT, w.rope_cos, w.rope_sin, (l & 1) != 0};
            pg8::gemm_phase<EpiQKV, SchedQKV, true, true>(lds, D, S, E); __syncthreads();
            if (864 % G != 0 && c >= 864 % G) convert_pull(P, wsb, lds, l + 1, CONV_BUDGET);
        } else if (ph == 2) {
            if (l & 1) att::diff_phase(P, w, lds, l); else att::natten_phase(P, w, lds, l);
        } else if (ph == 3) {
            SchedDense S{(const char*)w.O, wl + WO_O, (l == DEPTH - 1) ? NLAT / 256 : NTOK / 256, 4, G, c};
            EpiWO E{P.x, P.ctx, w.X, w.mods + (size_t)l * 9 * (NMOD * D) + 2 * D, l == 0};
            pg8::gemm_phase<EpiWO, SchedDense, true, true>(lds, D, S, E);
            __syncthreads();
            if (l < DEPTH - 1 && 288 % G != 0 && c >= 288 % G) convert_pull(P, wsb, lds, l + 1, CONV_BUDGET);
        } else if (ph == 4) phase_norm(P, w, l, 1, lds);
        else if (ph == 5) {
            LAS unsigned* tab = (LAS unsigned*)(lds + TILETAB_OFF);
            const int ntile = build_tile_table(w, l, tab);
            SchedMoe<true> S{(const char*)w.H, wl + WO_E, w.list, tab, ntile, 8, G, c, 0};
            EpiGLU E{w.ACT};
            pg8::gemm_phase<EpiGLU, SchedMoe<true>, true, true>(lds, D, S, E);
        } else {
            LAS unsigned* tab = (LAS unsigned*)(lds + TILETAB_OFF);
            const int ntile = build_tile_table(w, l, tab);
            SchedMoe<false> S{(const char*)w.ACT, wl + WO_E, w.list, tab, ntile, 4, G, c, WE_2};
            EpiDown E{w.Y};
            pg8::gemm_phase<EpiDown, SchedMoe<false>, true, true>(lds, D, S, E); __syncthreads();
            if ((ntile * 4) % G != 0 && c >= (ntile * 4) % G) convert_pull(P, wsb, lds, l + 1, CONV_BUDGET);
        }
    }
}

extern "C" void kernel_launch(void* const* d_in, const int* in_sizes, int n_in, void* d_out, int out_size, void* d_ws, size_t ws_size, hipStream_t stream) {
    static int grid = 0;
    if (grid == 0) {
        int dev = 0, cus = 0, per_cu = 0;
        (void)hipGetDevice(&dev);
        (void)hipDeviceGetAttribute(&cus, hipDeviceAttributeMultiprocessorCount, dev);
        if (hipFuncSetAttribute((const void*)mk_fwd, hipFuncAttributeMaxDynamicSharedMemorySize, LDS_BYTES) != hipSuccess) { fprintf(stderr, "kernel_launch: hipFuncSetAttribute failed\n"); grid = -1; }
        if (hipOccupancyMaxActiveBlocksPerMultiprocessor(&per_cu, (const void*)mk_fwd, NTHR, LDS_BYTES) != hipSuccess || per_cu < 1) { fprintf(stderr, "kernel_launch: occupancy query says %d blocks per CU\n", per_cu); if (grid == 0) grid = -1; }
        (void)hipGetLastError();
        if (grid == 0) grid = cus;
        if (grid > 0 && grid < 144) { fprintf(stderr, "kernel_launch: built for >= 144 CUs (got %d)\n", grid); grid = -1; }
        if (ws_size < WS_END) { fprintf(stderr, "kernel_launch: workspace too small (%zu < %zu)\n", ws_size, (size_t)WS_END); grid = -1; }
    }
    if (grid < 0) return;
    (void)hipMemsetAsync((char*)d_ws + WS_CTL, 0, CTL_BYTES, stream);
    Params p{};
    const float** pp = (const float**)&p;
    for (int i = 0; i < 19; ++i) pp[i] = (const float*)d_in[i];
    p.out = (float*)d_out; p.ws = (unsigned char*)d_ws;
    const dim3 blk(NTHR);
    p.step_lo = 0; p.step_hi = MK_NSTEPS;
    void* args[] = {&p};
    hipError_t e = hipLaunchCooperativeKernel((const void*)mk_fwd, dim3(grid), blk, args, LDS_BYTES, stream);
    if (e != hipSuccess) fprintf(stderr, "cooperative launch failed: %s (grid %d)\n", hipGetErrorString(e), grid);
}
```

```cpp
#include <hip/hip_runtime.h>
#include <hip/hip_cooperative_groups.h>
#include <cstdio>
#include <cstdint>
namespace cg = cooperative_groups;


typedef unsigned short bf16_t;
typedef float v4f __attribute__((ext_vector_type(4)));
constexpr int D = 1024, NB = 8, SEQ = 2048, CL = 256, NLAT = NB * SEQ, NCTX = NB * CL, NTOK = NLAT + NCTX;
constexpr int DEPTH = 4, NE = 16, NMOD = 6, GW = 64;
constexpr float EPS = 1e-6f, LOG2E = 1.4426950408889634f, QSCALE = 0.125f * 1.4426950408889634f;
constexpr int NTHR = 512, NWAVE = 8;
constexpr int SLOTS = 40960;

constexpr size_t MiB = 1u << 20;
constexpr size_t WS_CTL = 0, CTL_BYTES = 1 * MiB;
constexpr size_t WS_MODS = 1 * MiB;
constexpr size_t WS_ROPE = 2 * MiB;
constexpr size_t WS_TOKI = 3 * MiB;
constexpr size_t WS_LIST = 4 * MiB;
constexpr size_t WS_X = 6 * MiB;
constexpr size_t WS_H = 78 * MiB;
constexpr size_t WS_QK = 114 * MiB;
constexpr size_t WS_VT = 186 * MiB;
constexpr size_t WS_O = 222 * MiB;
constexpr size_t WS_ACT = 258 * MiB;
constexpr size_t WS_Y = 338 * MiB;
constexpr size_t WS_W = 418 * MiB;
constexpr size_t WL_BYTES = 104 * MiB, WO_QK = 0, WO_V = 4 * MiB, WO_O = 6 * MiB, WO_E = 8 * MiB, WE_BYTES = 6 * MiB, WE_2 = 4 * MiB;
constexpr size_t WS_END = WS_W + 4 * WL_BYTES;
constexpr int CW_CNT = 1024;

struct Params {
    const float *x, *c, *ctx, *c_ctx, *mod_w, *mod_b, *norm_mix, *norm_ffn, *w_qkv, *w_o, *na_rpb, *diff_lambda, *diff_subln,
        *router_w, *router_b, *wg, *wu, *wd, *final_norm;
    float* out;
    unsigned char* ws;
    int step_lo, step_hi;
};

__device__ __forceinline__ int tidx() { int t = threadIdx.x; asm volatile("" : "+v"(t)); return t; }
__device__ __forceinline__ int bidx() { int t = blockIdx.x; asm volatile("" : "+s"(t)); return t; }
__device__ __forceinline__ float bf2f(bf16_t v) { return __uint_as_float(((unsigned)v) << 16); }
__device__ __forceinline__ bf16_t f2bf(float f) { unsigned u = __float_as_uint(f); return (bf16_t)((u + 0x7fffu + ((u >> 16) & 1u)) >> 16); }
__device__ __forceinline__ float wave_sum(float v) {
#pragma unroll
    for (int o = 1; o < 64; o <<= 1) v += __shfl_xor(v, o);
    return v;
}
__device__ __forceinline__ float silu_f(float v) { return v / (1.f + __expf(-v)); }
__device__ __forceinline__ int mod_row(int row) { return row < NLAT ? row / SEQ : NB; }
__device__ __forceinline__ float lam_init_of(int layer) { return 0.8f - 0.6f * expf(-0.3f * (float)layer); }

struct Ws {
    unsigned* ctl; float* mods; float* rope_cos; float* rope_sin; int4* toki; float2* tokw; int* list;
    float* X; bf16_t *H, *QK, *VT, *O, *ACT, *Y;
};
__device__ __forceinline__ Ws make_ws(unsigned char* ws) {
    Ws w;
    w.ctl = (unsigned*)(ws + WS_CTL); w.mods = (float*)(ws + WS_MODS); w.rope_cos = (float*)(ws + WS_ROPE); w.rope_sin = w.rope_cos + SEQ * 32;
    w.toki = (int4*)(ws + WS_TOKI); w.tokw = (float2*)(ws + WS_TOKI + (size_t)NTOK * 16); w.list = (int*)(ws + WS_LIST);
    w.X = (float*)(ws + WS_X); w.H = (bf16_t*)(ws + WS_H); w.QK = (bf16_t*)(ws + WS_QK); w.VT = (bf16_t*)(ws + WS_VT); w.O = (bf16_t*)(ws + WS_O);
    w.ACT = (bf16_t*)(ws + WS_ACT); w.Y = (bf16_t*)(ws + WS_Y);
    return w;
}
__device__ __forceinline__ void expert_offsets(const Ws& w, int layer, int* cnt, int* off) {
    int acc = 0;
#pragma unroll
    for (int e = 0; e < NE; ++e) {
        const int c = (int)__hip_atomic_load(w.ctl + CW_CNT + (layer * NE + e) * 64, __ATOMIC_RELAXED, __HIP_MEMORY_SCOPE_AGENT);
        cnt[e] = c; off[e] = acc; acc += (c + 255) & ~255;
    }
    off[NE] = acc;
}

__device__ __forceinline__ void phase_prologue(const Params& p, const Ws& w, float* smem) {
    const int tid = tidx(), bid = bidx(), nb = gridDim.x;
    float* sact = smem;
    float* part = smem + 9 * 1024;
    for (int i = tid; i < 9 * 1024; i += NTHR) { const int r = i >> 10, k = i & 1023; const float v = r < NB ? p.c[r * D + k] : p.c_ctx[k]; sact[i] = silu_f(v); }
    __syncthreads();
    const int col = tid & 127, ks = tid >> 7;
    for (int u = bid; u < DEPTH * (NMOD * D / 128); u += nb) {
        const int layer = u / (NMOD * D / 128), col0 = (u % (NMOD * D / 128)) * 128;
        float acc[9];
#pragma unroll
        for (int r = 0; r < 9; ++r) acc[r] = 0.f;
        const float* wp = p.mod_w + ((size_t)layer * D + ks * 256) * (NMOD * D) + col0 + col;
#pragma unroll 4
        for (int k = 0; k < 256; ++k) {
            const float wv = wp[(size_t)k * (NMOD * D)];
#pragma unroll
            for (int r = 0; r < 9; ++r) acc[r] += sact[r * 1024 + ks * 256 + k] * wv;
        }
#pragma unroll
        for (int r = 0; r < 9; ++r) part[(ks * 9 + r) * 128 + col] = acc[r];
        __syncthreads();
        for (int i = tid; i < 9 * 128; i += NTHR) {
            const int r = i >> 7, cc = i & 127;
            const float v = part[(0 * 9 + r) * 128 + cc] + part[(1 * 9 + r) * 128 + cc] + part[(2 * 9 + r) * 128 + cc] + part[(3 * 9 + r) * 128 + cc];
            w.mods[((size_t)layer * 9 + r) * (NMOD * D) + col0 + cc] = v + p.mod_b[layer * (NMOD * D) + col0 + cc];
        }
        __syncthreads();
    }
    for (int i = bid * NTHR + tid; i < SEQ * 32; i += nb * NTHR) {
        const int t = i >> 5, j = i & 31, f = j & 15;
        const float pos = (float)(j < 16 ? t / GW : t % GW);
        const float inv = powf(10000.0f, -(float)f / 16.0f);
        const float ang = pos * inv;
        w.rope_cos[i] = cosf(ang); w.rope_sin[i] = sinf(ang);
    }
}

__device__ __forceinline__ void phase_norm(const Params& p, const Ws& w, int layer, int mode, __attribute__((address_space(3))) unsigned char* lds) {
#define NLAS __attribute__((address_space(3)))
    const int tid = tidx(), lane = tid & 63, wave = tid >> 6;
    const int gw = bidx() * NWAVE + wave, ngw = gridDim.x * NWAVE;
    const bool combine = (mode == 0 && layer > 0) || mode == 2;
    const int clayer = (mode == 2) ? DEPTH - 1 : layer - 1;
    int cnt[NE], off[NE + 1];
    if (combine) expert_offsets(w, clayer, cnt, off);
    int nrows = NTOK;
    if (mode == 2) nrows = NLAT;
    if (mode == 1 && layer == DEPTH - 1) nrows = NLAT;
    NLAS unsigned* lcnt = (NLAS unsigned*)lds;
    NLAS v4f* lgb = (NLAS v4f*)(lds + 1024);
    const NLAS v4f* rwl = (const NLAS v4f*)(lds + 16384);
    const int rpb = (nrows + (int)gridDim.x - 1) / (int)gridDim.x;
    const int chunk0 = bidx() * rpb;
    if (mode == 1) {
        if (tid < 32) lcnt[tid] = 0u;
        for (int c = tid; c < D * 4; c += NTHR) { const int k = c >> 2, e4 = c & 3, j = k >> 8, ln = (k & 255) >> 2, q = k & 3;
            ((NLAS v4f*)(lds + 16384))[((j * 4 + q) * 4 + e4) * 64 + ln] = ((const v4f*)p.router_w)[c]; }
        __syncthreads();
    }
    const bool from_input = (layer == 0 && mode == 0);
    const int row0 = (mode == 1) ? chunk0 + wave : gw, rstep = (mode == 1) ? NWAVE : ngw;
    const int rend = (mode == 1) ? min(nrows, chunk0 + rpb) : nrows;
    v4f vn[4]; int4 tin = make_int4(0, 0, 0, 0); float2 twn = make_float2(0.f, 0.f);
    if (row0 < rend) {
        const float* src = from_input ? (row0 < NLAT ? p.x + (size_t)row0 * D : p.ctx + (size_t)(row0 - NLAT) * D) : w.X + (size_t)row0 * D;
#pragma unroll
        for (int j = 0; j < 4; ++j) vn[j] = ((const v4f*)src)[64 * j + lane];
        if (combine) { tin = w.toki[row0]; twn = w.tokw[row0]; }
    }
    for (int row = row0; row < rend; row += rstep) {
        const int r = mod_row(row);
        v4f v[4];
#pragma unroll
        for (int j = 0; j < 4; ++j) v[j] = vn[j];
        const int4 ti = tin; const float2 tw = twn;
        {
            const int nrow = row + rstep;
            if (nrow < rend) {
                const float* src = from_input ? (nrow < NLAT ? p.x + (size_t)nrow * D : p.ctx + (size_t)(nrow - NLAT) * D) : w.X + (size_t)nrow * D;
#pragma unroll
                for (int j = 0; j < 4; ++j) vn[j] = ((const v4f*)src)[64 * j + lane];
                if (combine) { tin = w.toki[nrow]; twn = w.tokw[nrow]; }
            }
        }
        if (combine) {
            int o0 = 0, o1 = 0;
#pragma unroll
            for (int e = 0; e < NE; ++e) { if (e == ti.x) o0 = off[e]; if (e == ti.z) o1 = off[e]; }
            const bf16_t* y0 = w.Y + (size_t)(o0 + ti.y) * D; const bf16_t* y1 = w.Y + (size_t)(o1 + ti.w) * D;
            const float* g5 = w.mods + ((size_t)clayer * 9 + r) * (NMOD * D) + 5 * D;
#pragma unroll
            for (int j = 0; j < 4; ++j) {
                const int k = 4 * (64 * j + lane);
                const uint2 a = *(const uint2*)(y0 + k), b = *(const uint2*)(y1 + k);
                const v4f g = *(const v4f*)(g5 + k);
                v[j][0] += g[0] * (tw.x * bf2f((bf16_t)(a.x & 0xffff)) + tw.y * bf2f((bf16_t)(b.x & 0xffff)));
                v[j][1] += g[1] * (tw.x * bf2f((bf16_t)(a.x >> 16)) + tw.y * bf2f((bf16_t)(b.x >> 16)));
                v[j][2] += g[2] * (tw.x * bf2f((bf16_t)(a.y & 0xffff)) + tw.y * bf2f((bf16_t)(b.y & 0xffff)));
                v[j][3] += g[3] * (tw.x * bf2f((bf16_t)(a.y >> 16)) + tw.y * bf2f((bf16_t)(b.y >> 16)));
            }
            if (mode != 2) {
                float* xdst = w.X;
#pragma unroll
                for (int j = 0; j < 4; ++j) ((v4f*)(xdst + (size_t)row * D))[64 * j + lane] = v[j];
            }
        }
        float ss = 0.f;
#pragma unroll
        for (int j = 0; j < 4; ++j) ss += v[j][0] * v[j][0] + v[j][1] * v[j][1] + v[j][2] * v[j][2] + v[j][3] * v[j][3];
        ss = wave_sum(ss);
        const float rinv = rsqrtf(ss * (1.f / D) + EPS);
        if (mode == 2) {
#pragma unroll
            for (int j = 0; j < 4; ++j) {
                const int k = 4 * (64 * j + lane); const v4f g = *(const v4f*)(p.final_norm + k);
                ((v4f*)(p.out + (size_t)row * D))[64 * j + lane] = v[j] * rinv * g;
            }
            continue;
        }
        const float* gn = (mode == 0 ? p.norm_mix : p.norm_ffn) + layer * D;
        const float* mv = w.mods + ((size_t)layer * 9 + r) * (NMOD * D) + (mode == 0 ? 0 : 3 * D);
        float hv[16];
#pragma unroll
        for (int j = 0; j < 4; ++j) {
            const int k = 4 * (64 * j + lane);
            const v4f g = *(const v4f*)(gn + k), sh = *(const v4f*)(mv + k), sc = *(const v4f*)(mv + D + k);
            const v4f hh = v[j] * rinv * g * (1.f + sc) + sh;
            hv[4 * j + 0] = hh[0]; hv[4 * j + 1] = hh[1]; hv[4 * j + 2] = hh[2]; hv[4 * j + 3] = hh[3];
            uint2 o; o.x = (unsigned)f2bf(hv[4 * j]) | ((unsigned)f2bf(hv[4 * j + 1]) << 16); o.y = (unsigned)f2bf(hv[4 * j + 2]) | ((unsigned)f2bf(hv[4 * j + 3]) << 16);
            *(uint2*)(w.H + (size_t)row * D + k) = o;
        }
        if (mode == 1) {
            float lg[NE];
#pragma unroll
            for (int e = 0; e < NE; ++e) lg[e] = 0.f;
#pragma unroll
            for (int j = 0; j < 4; ++j) {
                v4f tw[16];
#pragma unroll
                for (int qe = 0; qe < 16; ++qe) tw[qe] = rwl[(j * 16 + qe) * 64 + lane];
                __builtin_amdgcn_sched_barrier(0);
#pragma unroll
                for (int q = 0; q < 4; ++q) {
                    const float hh = hv[4 * j + q];
#pragma unroll
                    for (int e4 = 0; e4 < 4; ++e4) { const v4f t = tw[q * 4 + e4]; lg[4 * e4] += hh * t[0]; lg[4 * e4 + 1] += hh * t[1]; lg[4 * e4 + 2] += hh * t[2]; lg[4 * e4 + 3] += hh * t[3]; }
                }
            }
            {
                const bool b5 = (lane & 32) != 0, b4 = (lane & 16) != 0, b3 = (lane & 8) != 0, b2 = (lane & 4) != 0;
                float a8[8], a4[4], a2[2];
#pragma unroll
                for (int j = 0; j < 8; ++j) { const float keep = b5 ? lg[j + 8] : lg[j], send = b5 ? lg[j] : lg[j + 8]; a8[j] = keep + __shfl_xor(send, 32); }
#pragma unroll
                for (int j = 0; j < 4; ++j) { const float keep = b4 ? a8[j + 4] : a8[j], send = b4 ? a8[j] : a8[j + 4]; a4[j] = keep + __shfl_xor(send, 16); }
#pragma unroll
                for (int j = 0; j < 2; ++j) { const float keep = b3 ? a4[j + 2] : a4[j], send = b3 ? a4[j] : a4[j + 2]; a2[j] = keep + __shfl_xor(send, 8); }
                float a1 = (b2 ? a2[1] : a2[0]) + __shfl_xor(b2 ? a2[0] : a2[1], 4);
                a1 += __shfl_xor(a1, 2); a1 += __shfl_xor(a1, 1);
                if ((lane & 3) == 0) ((NLAS float*)lgb)[(row - chunk0) * 16 + (lane >> 2)] = a1;
            }
        }
    }
    if (mode == 1) {
        __syncthreads();
        const int row = chunk0 + tid; const bool act = (tid < rpb && row < nrows);
        int i1 = 0, i2 = 0; unsigned lp1 = 0, lp2 = 0; float w1 = 0.f, w2 = 0.f;
        if (act) {
            float sc[NE], sel[NE];
#pragma unroll
            for (int e4 = 0; e4 < 4; ++e4) { const v4f t = lgb[tid * 4 + e4];
#pragma unroll
                for (int q = 0; q < 4; ++q) { const int e = 4 * e4 + q; sc[e] = 1.f / (1.f + expf(-t[q])); sel[e] = sc[e] + p.router_b[e]; } }
            int bg = 0; float bgs = -INFINITY;
#pragma unroll
            for (int g = 0; g < 4; ++g) {
                float m1 = -INFINITY, m2 = -INFINITY;
#pragma unroll
                for (int q = 0; q < 4; ++q) { const float t = sel[4 * g + q]; if (t > m1) { m2 = m1; m1 = t; } else if (t > m2) m2 = t; }
                const float gs = m1 + m2;
                if (gs > bgs) { bgs = gs; bg = g; }
            }
            float m1 = -INFINITY, m2 = -INFINITY;
#pragma unroll
            for (int g = 0; g < 4; ++g) {
                if (g == bg) {
#pragma unroll
                    for (int q = 0; q < 4; ++q) { const float t = sel[4 * g + q]; if (t > m1) { m2 = m1; i2 = i1; m1 = t; i1 = 4 * g + q; } else if (t > m2) { m2 = t; i2 = 4 * g + q; } }
                }
            }
            float s1 = 0.f, s2 = 0.f;
#pragma unroll
            for (int e = 0; e < NE; ++e) { if (e == i1) s1 = sc[e]; if (e == i2) s2 = sc[e]; }
            const float inv = 1.f / (s1 + s2); w1 = s1 * inv; w2 = s2 * inv;
            lp1 = __hip_atomic_fetch_add(lcnt + i1, 1u, __ATOMIC_RELAXED, __HIP_MEMORY_SCOPE_WORKGROUP);
            lp2 = __hip_atomic_fetch_add(lcnt + i2, 1u, __ATOMIC_RELAXED, __HIP_MEMORY_SCOPE_WORKGROUP);
        }
        __syncthreads();
        if (tid < NE) lcnt[16 + tid] = atomicAdd(w.ctl + CW_CNT + (layer * NE + tid) * 64, lcnt[tid]);
        __syncthreads();
        if (act) {
            const int p1 = (int)(lcnt[16 + i1] + lp1), p2 = (int)(lcnt[16 + i2] + lp2);
            w.list[(size_t)i1 * NTOK + p1] = row; w.list[(size_t)i2 * NTOK + p2] = row;
            w.toki[row] = make_int4(i1, p1, i2, p2); w.tokw[row] = make_float2(w1, w2);
        }
        __syncthreads();
    }
#undef NLAS
}

#define LAS __attribute__((address_space(3)))
#define GAS __attribute__((address_space(1)))
typedef short bf16x8 __attribute__((ext_vector_type(8)));
typedef float f32x4 __attribute__((ext_vector_type(4)));
typedef unsigned u32x4 __attribute__((ext_vector_type(4)));
typedef unsigned u32x2 __attribute__((ext_vector_type(2)));

constexpr int RING_BYTES = 131072;
constexpr int LDSCTL_OFF = RING_BYTES, MISC_OFF = LDSCTL_OFF + 320, TILETAB_OFF = LDSCTL_OFF + 1024, STASH_OFF = LDSCTL_OFF + 4096;
constexpr int LDS_BYTES = 147456;

__device__ __forceinline__ unsigned cvt_pk_bf16(float lo, float hi) { unsigned r; asm volatile("v_cvt_pk_bf16_f32 %0, %1, %2" : "=v"(r) : "v"(lo), "v"(hi)); return r; }

namespace pg8 {
constexpr int BM = 256, BK = 64, HALF = 128, HTB = HALF * BK * 2, STAGE_BYTES = 8 * HTB, NXCD = 8, WGM = 8;
__host__ __device__ __forceinline__ int lds_byte(int r, int c) { const int st = (r >> 4) * 2 + (c >> 5), rr = r & 15, cc = c & 31, ob = rr * 64 + cc * 2; return st * 1024 + (ob ^ (((ob >> 9) & 1) << 5)); }
__host__ __device__ __forceinline__ void stage_rc(int b, int& R, int& C) { const int st = b / 1024, sb = b % 1024, swz = sb ^ (((sb >> 9) & 1) << 5); R = (st >> 1) * 16 + swz / 64; C = (st & 1) * 32 + (swz % 64) / 2; }
__host__ __device__ __forceinline__ int perm32(int rho) { const int n = rho >> 4, i = rho & 15; return 8 * (i >> 2) + 4 * n + (i & 3); }

struct Unit { int pm, pn, kind, aux; const char* a; const char* b; const int* lst; int valid; };
__device__ __forceinline__ void tile_order(int L, int nM, int nN, int& pm, int& pn) {
    const int nwg = nM * nN; int wgid = L;
    { const int q = nwg / NXCD, r = nwg % NXCD, xcd = wgid % NXCD, off = wgid / NXCD; wgid = (xcd < r ? xcd * (q + 1) : r * (q + 1) + (xcd - r) * q) + off; }
    const int nig = WGM * nN, gid = wgid / nig, fm = gid * WGM, gsz = (nM - fm) < WGM ? (nM - fm) : WGM;
    pm = fm + ((wgid % nig) % gsz); pn = (wgid % nig) / gsz;
}

template <class Epi, class Sched, bool ALIGN_EPI, bool SP2>
__device__ __forceinline__ void gemm_phase(LAS unsigned char* lds, const int K, const Sched& S, const Epi& E) {
    const int tid = tidx(), wid = __builtin_amdgcn_readfirstlane(tid >> 6), lane = tid & 63, wr = wid >> 2, wc = wid & 3, fr = lane & 15, fq = lane >> 4;
    const int nt = K / BK;
    unsigned voffB[2];
#pragma unroll
    for (int i = 0; i < 2; ++i) { int R, C; stage_rc(tid * 16 + i * 8192, R, C); const int Rb = Epi::PERM ? ((R & ~31) + perm32(R & 31)) : R; voffB[i] = (unsigned)(Rb * K + C) * 2u; }
#define PG8_AOFF(u, h, i) ([&]() { int R_, C_; stage_rc(tid * 16 + (i) * 8192, R_, C_); return S.a_off((u), (h), R_, C_, K); }())
    const size_t kstep = (size_t)(BK * 2);
    const size_t hstep = (size_t)HALF * K * 2;
    const unsigned ldsw = (unsigned)wid * 1024u;
    const int aoff = lds_byte(wr * 64 + fr, fq * 8), boff = lds_byte(wc * 32 + fr, fq * 8);
#define PG8_SA(b, h) (((b) * 2 + (h)) * HTB)
#define PG8_SB(b, h) ((4 + (b) * 2 + (h)) * HTB)
#define PG8_STAGE(bufoff, gbase, voff) do { _Pragma("unroll") for (int _i = 0; _i < 2; ++_i) \
        __builtin_amdgcn_global_load_lds((const unsigned*)((const char*)(gbase) + (voff)[_i]), (LAS unsigned*)(lds + (bufoff) + ldsw + _i * 8192), 16, 0, 0); } while (0)
#define PG8_LDA(dst, b, h) do { _Pragma("unroll") for (int m = 0; m < 4; ++m) _Pragma("unroll") for (int k = 0; k < 2; ++k) dst[m][k] = *(const LAS bf16x8*)(lds + PG8_SA(b, h) + aoff + m * 2048 + k * 1024); } while (0)
#define PG8_LDB(dst, b, h) do { _Pragma("unroll") for (int n = 0; n < 2; ++n) _Pragma("unroll") for (int k = 0; k < 2; ++k) dst[n][k] = *(const LAS bf16x8*)(lds + PG8_SB(b, h) + boff + n * 2048 + k * 1024); } while (0)
#define PG8_MMA(ai, bj, At, Bt) do { __builtin_amdgcn_s_setprio(1); _Pragma("unroll") for (int m = 0; m < 4; ++m) _Pragma("unroll") for (int n = 0; n < 2; ++n) _Pragma("unroll") for (int k = 0; k < 2; ++k) \
        acc[ai][bj][m][n] = __builtin_amdgcn_mfma_f32_16x16x32_bf16(Bt[n][k], At[m][k], acc[ai][bj][m][n], 0, 0, 0); __builtin_amdgcn_s_setprio(0); } while (0)
#define PG8_WAIT_V(n) asm volatile("s_waitcnt vmcnt(" #n ")" ::: "memory")
#define PG8_WAIT_L(n) asm volatile("s_waitcnt lgkmcnt(" #n ")" ::: "memory")
#define PG8_BAR __builtin_amdgcn_s_barrier()
#define PG8_SCHED __builtin_amdgcn_sched_barrier(0)
    Unit cur, nxt; int ui = 0;
    if (!S.next(0, cur)) return;
    unsigned vAc[2][2];
#define PG8_STASH ((LAS u32x4*)(lds + (STASH_OFF - 0)) + tid)
#pragma unroll
    for (int h = 0; h < 2; ++h)
#pragma unroll
        for (int i = 0; i < 2; ++i) vAc[h][i] = PG8_AOFF(cur, h, i);
    f32x4 acc[2][2][4][2];
#pragma unroll
    for (int a = 0; a < 2; ++a)
#pragma unroll
        for (int b = 0; b < 2; ++b)
#pragma unroll
            for (int m = 0; m < 4; ++m)
#pragma unroll
                for (int n = 0; n < 2; ++n) acc[a][b][m][n] = (f32x4){0.f, 0.f, 0.f, 0.f};
    bf16x8 At[4][2], B0[2][2], B1[2][2];
    const char* cA = cur.a; const char* cB = cur.b;
    if constexpr (SP2) {
        PG8_STAGE(PG8_SB(0, 0), cB, voffB); PG8_STAGE(PG8_SB(0, 1), cB + hstep, voffB); PG8_STAGE(PG8_SA(0, 0), cA, vAc[0]); PG8_STAGE(PG8_SA(0, 1), cA, vAc[1]);
        if (wr == 1) PG8_BAR;
        PG8_WAIT_V(2); PG8_BAR;
        PG8_STAGE(PG8_SB(1, 0), cB + kstep, voffB); PG8_STAGE(PG8_SA(1, 0), cA + kstep, vAc[0]); PG8_STAGE(PG8_SB(1, 1), cB + hstep + kstep, voffB);
        PG8_WAIT_V(6); PG8_BAR;
    } else {
        PG8_STAGE(PG8_SB(0, 0), cB, voffB); PG8_STAGE(PG8_SA(0, 0), cA, vAc[0]); PG8_STAGE(PG8_SB(0, 1), cB + hstep, voffB); PG8_STAGE(PG8_SA(0, 1), cA, vAc[1]);
        if (wr == 1) PG8_BAR;
        PG8_WAIT_V(4); PG8_BAR;
        PG8_STAGE(PG8_SB(1, 0), cB + kstep, voffB); PG8_STAGE(PG8_SA(1, 0), cA + kstep, vAc[0]); PG8_STAGE(PG8_SB(1, 1), cB + hstep + kstep, voffB);
        PG8_WAIT_V(6); PG8_BAR;
    }
    for (;;) {
        const bool has_next = S.next(ui + 1, nxt);
        const char* nA = has_next ? nxt.a : cA; const char* nB = has_next ? nxt.b : cB;
        if (Sched::GATHER && has_next) { u32x4 t4; t4.x = PG8_AOFF(nxt, 0, 0); t4.y = PG8_AOFF(nxt, 0, 1); t4.z = PG8_AOFF(nxt, 1, 0); t4.w = PG8_AOFF(nxt, 1, 1); *PG8_STASH = t4; }
        for (int t = 0; t < nt; t += 2) {
            const bool last = (t == nt - 2);
            const char* a1 = cA + (size_t)(t + 1) * kstep;
            const char* a2 = last ? nA : cA + (size_t)(t + 2) * kstep; const char* b2 = last ? nB : cB + (size_t)(t + 2) * kstep;
            const char* a3 = a2 + kstep; const char* b3 = b2 + kstep;
            if constexpr (SP2) {
            PG8_LDB(B0, 0, 0); PG8_LDB(B1, 0, 1); PG8_SCHED; PG8_LDA(At, 0, 0); PG8_STAGE(PG8_SA(1, 1), a1, vAc[1]);
            if (Sched::GATHER && last && has_next) { const u32x4 t4 = *PG8_STASH; vAc[0][0] = t4.x; vAc[0][1] = t4.y; vAc[1][0] = t4.z; vAc[1][1] = t4.w; }
            PG8_WAIT_V(8); PG8_WAIT_L(0); PG8_BAR; PG8_MMA(0, 0, At, B0); PG8_MMA(0, 1, At, B1); PG8_BAR; PG8_SCHED;
            PG8_LDA(At, 0, 1); PG8_STAGE(PG8_SB(0, 0), b2, voffB); PG8_STAGE(PG8_SB(0, 1), b2 + hstep, voffB); PG8_STAGE(PG8_SA(0, 0), a2, vAc[0]);
            PG8_WAIT_V(8); PG8_WAIT_L(0); PG8_BAR; PG8_MMA(1, 0, At, B0); PG8_MMA(1, 1, At, B1); PG8_BAR; PG8_SCHED;
            PG8_LDB(B0, 1, 0); PG8_LDB(B1, 1, 1); PG8_SCHED; PG8_LDA(At, 1, 0); PG8_STAGE(PG8_SA(0, 1), a2, vAc[1]);
            PG8_WAIT_V(8); PG8_WAIT_L(0); PG8_BAR; PG8_MMA(0, 0, At, B0); PG8_MMA(0, 1, At, B1); PG8_BAR; PG8_SCHED;
            PG8_LDA(At, 1, 1); PG8_STAGE(PG8_SB(1, 0), b3, voffB); PG8_STAGE(PG8_SB(1, 1), b3 + hstep, voffB); PG8_STAGE(PG8_SA(1, 0), a3, vAc[0]);
            PG8_WAIT_V(8); PG8_WAIT_L(0); PG8_BAR; PG8_MMA(1, 0, At, B0); PG8_MMA(1, 1, At, B1); PG8_BAR; PG8_SCHED;
            } else {
            PG8_LDB(B0, 0, 0); PG8_SCHED; PG8_LDA(At, 0, 0); PG8_STAGE(PG8_SA(1, 1), a1, vAc[1]);
            if (Sched::GATHER && last && has_next) { const u32x4 t4 = *PG8_STASH; vAc[0][0] = t4.x; vAc[0][1] = t4.y; vAc[1][0] = t4.z; vAc[1][1] = t4.w; }
            PG8_WAIT_L(8); PG8_BAR; PG8_WAIT_L(0); PG8_MMA(0, 0, At, B0); PG8_BAR; PG8_SCHED;
            PG8_LDB(B1, 0, 1); PG8_STAGE(PG8_SB(0, 0), b2, voffB);
            PG8_BAR; PG8_WAIT_L(0); PG8_MMA(0, 1, At, B1); PG8_BAR;
            PG8_LDA(At, 0, 1); PG8_STAGE(PG8_SA(0, 0), a2, vAc[0]);
            PG8_BAR; PG8_WAIT_L(0); PG8_MMA(1, 0, At, B0); PG8_BAR; PG8_SCHED;
            PG8_STAGE(PG8_SB(0, 1), b2 + hstep, voffB);
            PG8_WAIT_V(6); PG8_BAR; PG8_MMA(1, 1, At, B1); PG8_BAR;
            PG8_LDB(B0, 1, 0); PG8_SCHED; PG8_LDA(At, 1, 0); PG8_STAGE(PG8_SA(0, 1), a2, vAc[1]);
            PG8_WAIT_L(8); PG8_BAR; PG8_WAIT_L(0); PG8_MMA(0, 0, At, B0); PG8_BAR; PG8_SCHED;
            PG8_LDB(B1, 1, 1); PG8_STAGE(PG8_SB(1, 0), b3, voffB);
            PG8_BAR; PG8_WAIT_L(0); PG8_MMA(0, 1, At, B1); PG8_BAR;
            PG8_LDA(At, 1, 1); PG8_STAGE(PG8_SA(1, 0), a3, vAc[0]);
            PG8_BAR; PG8_WAIT_L(0); PG8_MMA(1, 0, At, B0); PG8_BAR; PG8_SCHED;
            PG8_STAGE(PG8_SB(1, 1), b3 + hstep, voffB);
            PG8_WAIT_V(6); PG8_BAR; PG8_MMA(1, 1, At, B1); PG8_BAR;
            }
        }
        if constexpr (ALIGN_EPI) { if (wr == 0) PG8_BAR; }
        E(acc, cur, wr, wc, fr, fq);
        if (!has_next) break;
#pragma unroll
        for (int a = 0; a < 2; ++a)
#pragma unroll
            for (int b = 0; b < 2; ++b)
#pragma unroll
                for (int m = 0; m < 4; ++m)
#pragma unroll
                    for (int n = 0; n < 2; ++n) acc[a][b][m][n] = (f32x4){0.f, 0.f, 0.f, 0.f};
        cur = nxt; cA = nA; cB = nB; ++ui;
        if constexpr (ALIGN_EPI) { if (wr == 1) PG8_BAR; }
    }
    PG8_WAIT_V(0);
    if constexpr (!ALIGN_EPI) { if (wr == 0) PG8_BAR; }
    PG8_BAR;
#undef PG8_SA
#undef PG8_AOFF
#undef PG8_STASH
#undef PG8_SB
#undef PG8_STAGE
#undef PG8_LDA
#undef PG8_LDB
#undef PG8_MMA
#undef PG8_WAIT_V
#undef PG8_WAIT_L
#undef PG8_BAR
#undef PG8_SCHED
}
}

constexpr size_t TSTEP = (size_t)256 * D * 2;
struct SchedQKV {
    static constexpr bool GATHER = false;
    const char *H, *Wqk, *Wv; int G, c;
    __device__ __forceinline__ bool next(int i, pg8::Unit& u) const {
        const int L = i * G + c;
        if (L < 576) { pg8::tile_order(L, 72, 8, u.pm, u.pn); u.kind = 0; u.a = H + (size_t)u.pm * TSTEP; u.b = Wqk + (size_t)u.pn * TSTEP; return true; }
        if (L < 576 + 288) { pg8::tile_order(L - 576, 4, 72, u.pm, u.pn); u.kind = 1; u.a = Wv + (size_t)u.pm * TSTEP; u.b = H + (size_t)u.pn * TSTEP; return true; }
        return false;
    }
    __device__ __forceinline__ unsigned a_off(const pg8::Unit&, int h, int R, int C, int K) const { return (unsigned)((h * 128 + R) * K + C) * 2u; }
};
struct SchedDense {
    static constexpr bool GATHER = false;
    const char *A, *Bt; int nM, nN, G, c;
    __device__ __forceinline__ bool next(int i, pg8::Unit& u) const {
        const int L = i * G + c; if (L >= nM * nN) return false;
        pg8::tile_order(L, nM, nN, u.pm, u.pn); u.kind = 0; u.a = A + (size_t)u.pm * TSTEP; u.b = Bt + (size_t)u.pn * TSTEP; return true;
    }
    __device__ __forceinline__ unsigned a_off(const pg8::Unit&, int h, int R, int C, int K) const { return (unsigned)((h * 128 + R) * K + C) * 2u; }
};
template <bool GATHERT> struct SchedMoe {
    static constexpr bool GATHER = GATHERT;
    const char* A;
    const char* W;
    const int* list; const LAS unsigned* tab; int ntile, nN, G, c; size_t wofs;
    __device__ __forceinline__ bool next(int i, pg8::Unit& u) const {
        const int L = i * G + c; if (L >= ntile * nN) return false;
        const int mt = L / nN; u.pn = L % nN; u.pm = mt; u.kind = 0;
        const unsigned t0 = __builtin_amdgcn_readfirstlane(tab[2 * mt]), t1 = __builtin_amdgcn_readfirstlane(tab[2 * mt + 1]);
        const int e = (int)(t0 >> 20), first = (int)(t0 & 0xfffff);
        u.aux = e; u.valid = (int)t1; u.lst = list + (size_t)e * NTOK + first;
        u.a = GATHERT ? A : A + (size_t)mt * TSTEP;
        u.b = W + (size_t)e * WE_BYTES + wofs + (size_t)u.pn * TSTEP;
        return true;
    }
    __device__ __forceinline__ unsigned a_off(const pg8::Unit& u, int h, int R, int C, int K) const {
        const int rr = h * 128 + R;
        if (!GATHERT) return (unsigned)(rr * K + C) * 2u;
        const int tok = (rr < u.valid) ? u.lst[rr] : 0;
        return (unsigned)(tok * K + C) * 2u;
    }
};

struct EpiQKV {
    static constexpr bool PERM = true;
    bf16_t* QK; bf16_t* VT; const float* rcos; const float* rsin; bool rope;
    __device__ __forceinline__ void operator()(const f32x4 (&acc)[2][2][4][2], const pg8::Unit& u, int wr, int wc, int fr, int fq) const {
        if (u.kind == 0) {
            const float sc = (u.pn < 4) ? QSCALE : 1.f;
            const bool do_rope = rope && (u.pm * 256 < NLAT);
#pragma unroll
            for (int ai = 0; ai < 2; ++ai)
#pragma unroll
                for (int m = 0; m < 4; ++m) {
                    const int row = u.pm * 256 + ai * 128 + wr * 64 + m * 16 + fr;
                    f32x4 v[2][2];
#pragma unroll
                    for (int bj = 0; bj < 2; ++bj)
#pragma unroll
                        for (int n = 0; n < 2; ++n) v[bj][n] = acc[ai][bj][m][n] * sc;
                    if (do_rope) {
                        const int t = row & (SEQ - 1);
#pragma unroll
                        for (int n = 0; n < 2; ++n) {
                            const f32x4 cs = *(const f32x4*)(rcos + t * 32 + 8 * fq + 4 * n), sn = *(const f32x4*)(rsin + t * 32 + 8 * fq + 4 * n);
                            const f32x4 x1 = v[0][n], x2 = v[1][n];
                            v[0][n] = x1 * cs - x2 * sn; v[1][n] = x1 * sn + x2 * cs;
                        }
                    }
                    bf16_t* rowp = QK + (size_t)row * 2048 + u.pn * 256 + wc * 64 + 8 * fq;
#pragma unroll
                    for (int bj = 0; bj < 2; ++bj) {
                        u32x4 o; o.x = cvt_pk_bf16(v[bj][0][0], v[bj][0][1]); o.y = cvt_pk_bf16(v[bj][0][2], v[bj][0][3]); o.z = cvt_pk_bf16(v[bj][1][0], v[bj][1][1]); o.w = cvt_pk_bf16(v[bj][1][2], v[bj][1][3]);
                        *(u32x4*)(rowp + bj * 32) = o;
                    }
                }
        } else {
#pragma unroll
            for (int ai = 0; ai < 2; ++ai)
#pragma unroll
                for (int m = 0; m < 4; ++m) {
                    const int row = u.pm * 256 + ai * 128 + wr * 64 + m * 16 + fr;
                    bf16_t* rowp = VT + (size_t)row * NTOK + u.pn * 256 + wc * 32 + 8 * fq;
#pragma unroll
                    for (int bj = 0; bj < 2; ++bj) {
                        const f32x4 v0 = acc[ai][bj][m][0], v1 = acc[ai][bj][m][1];
                        u32x4 o; o.x = cvt_pk_bf16(v0[0], v0[1]); o.y = cvt_pk_bf16(v0[2], v0[3]); o.z = cvt_pk_bf16(v1[0], v1[1]); o.w = cvt_pk_bf16(v1[2], v1[3]);
                        *(u32x4*)(rowp + bj * 128) = o;
                    }
                }
        }
    }
};
struct EpiWO {
    static constexpr bool PERM = false;
    const float* xin; const float* cin; float* X; const float* gate  ; bool from_input;
    __device__ __forceinline__ void operator()(const f32x4 (&acc)[2][2][4][2], const pg8::Unit& u, int wr, int wc, int fr, int fq) const {
        const int r = (u.pm * 256 < NLAT) ? (u.pm * 256) / SEQ : NB;
        const int col0 = u.pn * 256 + wc * 32 + 4 * fq;
        f32x4 g[2][2];
#pragma unroll
        for (int bj = 0; bj < 2; ++bj)
#pragma unroll
            for (int n = 0; n < 2; ++n) g[bj][n] = *(const f32x4*)(gate + (size_t)r * (NMOD * D) + col0 + bj * 128 + n * 16);
#pragma unroll
        for (int ai = 0; ai < 2; ++ai) {
            f32x4 bs[4][2][2];
#pragma unroll
            for (int m = 0; m < 4; ++m) {
                const int row = u.pm * 256 + ai * 128 + wr * 64 + m * 16 + fr;
                const float* base = from_input ? (row < NLAT ? xin + (size_t)row * D : cin + (size_t)(row - NLAT) * D) : X + (size_t)row * D;
#pragma unroll
                for (int bj = 0; bj < 2; ++bj)
#pragma unroll
                    for (int n = 0; n < 2; ++n) bs[m][bj][n] = *(const f32x4*)(base + col0 + bj * 128 + n * 16);
            }
#pragma unroll
            for (int m = 0; m < 4; ++m) {
                const int row = u.pm * 256 + ai * 128 + wr * 64 + m * 16 + fr;
                float* outp = X + (size_t)row * D;
#pragma unroll
                for (int bj = 0; bj < 2; ++bj)
#pragma unroll
                    for (int n = 0; n < 2; ++n) *(f32x4*)(outp + col0 + bj * 128 + n * 16) = bs[m][bj][n] + g[bj][n] * acc[ai][bj][m][n];
            }
            asm volatile("" ::: "memory");
        }
    }
};
struct EpiGLU {
    static constexpr bool PERM = true;
    bf16_t* ACT;
    __device__ __forceinline__ void operator()(const f32x4 (&acc)[2][2][4][2], const pg8::Unit& u, int wr, int wc, int fr, int fq) const {
#pragma unroll
        for (int ai = 0; ai < 2; ++ai)
#pragma unroll
            for (int m = 0; m < 4; ++m) {
                const int row = u.pm * 256 + ai * 128 + wr * 64 + m * 16 + fr;
                float t[8];
#pragma unroll
                for (int n = 0; n < 2; ++n)
#pragma unroll
                    for (int q = 0; q < 4; ++q) { const float a = acc[ai][0][m][n][q], b = acc[ai][1][m][n][q]; t[4 * n + q] = a * __builtin_amdgcn_rcpf(1.f + __builtin_amdgcn_exp2f(-a * LOG2E)) * b; }
                u32x4 o; o.x = cvt_pk_bf16(t[0], t[1]); o.y = cvt_pk_bf16(t[2], t[3]); o.z = cvt_pk_bf16(t[4], t[5]); o.w = cvt_pk_bf16(t[6], t[7]);
                *(u32x4*)(ACT + (size_t)row * D + u.pn * 128 + wc * 32 + 8 * fq) = o;
            }
    }
};
struct EpiDown {
    static constexpr bool PERM = true;
    bf16_t* Y;
    __device__ __forceinline__ void operator()(const f32x4 (&acc)[2][2][4][2], const pg8::Unit& u, int wr, int wc, int fr, int fq) const {
#pragma unroll
        for (int ai = 0; ai < 2; ++ai)
#pragma unroll
            for (int m = 0; m < 4; ++m) {
                const int row = u.pm * 256 + ai * 128 + wr * 64 + m * 16 + fr;
                bf16_t* rowp = Y + (size_t)row * D + u.pn * 256 + wc * 32 + 8 * fq;
#pragma unroll
                for (int bj = 0; bj < 2; ++bj) {
                    const f32x4 v0 = acc[ai][bj][m][0], v1 = acc[ai][bj][m][1];
                    u32x4 o; o.x = cvt_pk_bf16(v0[0], v0[1]); o.y = cvt_pk_bf16(v0[2], v0[3]); o.z = cvt_pk_bf16(v1[0], v1[1]); o.w = cvt_pk_bf16(v1[2], v1[3]);
                    *(u32x4*)(rowp + bj * 128) = o;
                }
            }
    }
};

__device__ __forceinline__ unsigned pk2_rne(float lo, float hi) { return (unsigned)f2bf(lo) | ((unsigned)f2bf(hi) << 16); }
__device__ __forceinline__ void conv_item(const float* W, int ldw, int k0, int n0, bf16_t* WT, int drow0, LAS float* scr, int lane) {
    float t[32];
    const float* src = W + (size_t)(k0 + (lane >> 5)) * ldw + n0 + (lane & 31);
#pragma unroll
    for (int i = 0; i < 32; ++i) t[i] = __builtin_nontemporal_load(src + (size_t)(2 * i) * ldw);
#pragma unroll
    for (int i = 0; i < 32; ++i) scr[(2 * i + (lane >> 5)) * 33 + (lane & 31)] = t[i];
    asm volatile("s_waitcnt lgkmcnt(0)" ::: "memory");
    const int c = lane & 7;
#pragma unroll
    for (int j = 0; j < 4; ++j) { const int n = (lane >> 3) + 8 * j; const LAS float* s = scr + (8 * c) * 33 + n;
        u32x4 o; o.x = pk2_rne(s[0 * 33], s[1 * 33]); o.y = pk2_rne(s[2 * 33], s[3 * 33]); o.z = pk2_rne(s[4 * 33], s[5 * 33]); o.w = pk2_rne(s[6 * 33], s[7 * 33]);
        *(u32x4*)(WT + (size_t)(drow0 + n) * D + k0 + 8 * c) = o; }
    asm volatile("s_waitcnt lgkmcnt(0)" ::: "memory");
}
constexpr int CONV_QKV = 16 * 96, CONV_O = 16 * 32, CONV_E = 16 * 32, CONV_LAYER = CONV_QKV + CONV_O + NE * 3 * CONV_E;
__device__ __forceinline__ void conv_layer_item(const Params& p, unsigned char* ws, int l, int r, LAS float* scr, int lane) {
    unsigned char* wl = ws + WS_W + (size_t)l * WL_BYTES;
    if (r < CONV_QKV) {
        const int kb = r / 96, nb = r % 96, n0 = nb * 32;
        if (n0 < 2048) { const int pn = n0 >> 8, a = n0 & 255, hd = a >> 6, half = (a >> 5) & 1;
            conv_item(p.w_qkv + (size_t)l * D * 3072, 3072, kb * 64, n0, (bf16_t*)(wl + WO_QK), pn * 256 + half * 128 + hd * 32, scr, lane); }
        else conv_item(p.w_qkv + (size_t)l * D * 3072, 3072, kb * 64, n0, (bf16_t*)(wl + WO_V), n0 - 2048, scr, lane);
        return;
    }
    r -= CONV_QKV;
    if (r < CONV_O) { const int kb = r / 32, nb = r % 32; conv_item(p.w_o + (size_t)l * D * D, D, kb * 64, nb * 32, (bf16_t*)(wl + WO_O), nb * 32, scr, lane); return; }
    r -= CONV_O;
    const int e = r / (3 * CONV_E), r2 = r % (3 * CONV_E), which = r2 / CONV_E, r3 = r2 % CONV_E, kb = r3 / 32, nb = r3 % 32, n0 = nb * 32;
    unsigned char* we = wl + WO_E + (size_t)e * WE_BYTES;
    const size_t eo = ((size_t)l * NE + e) * D * D;
    if (which == 0) conv_item(p.wg + eo, D, kb * 64, n0, (bf16_t*)we, (n0 >> 7) * 256 + (n0 & 127), scr, lane);
    else if (which == 1) conv_item(p.wu + eo, D, kb * 64, n0, (bf16_t*)we, (n0 >> 7) * 256 + 128 + (n0 & 127), scr, lane);
    else conv_item(p.wd + eo, D, kb * 64, n0, (bf16_t*)(we + WE_2), n0, scr, lane);
}
__device__ __forceinline__ void phase_convert(const Params& p, unsigned char* ws, LAS unsigned char* lds, int layer_lo, int layer_hi) {
    const int tid = tidx(), lane = tid & 63, wave = tid >> 6;
    LAS float* scr = (LAS float*)(lds + wave * 16384);
    const int gw = bidx() * NWAVE + wave, ngw = gridDim.x * NWAVE;
    for (int it = layer_lo * CONV_LAYER + gw; it < layer_hi * CONV_LAYER; it += ngw) conv_layer_item(p, ws, it / CONV_LAYER, it % CONV_LAYER, scr, lane);
}
constexpr int CONV_CHUNK = 4, CW_CONVQ = 6144;
__device__ __forceinline__ void convert_pull(const Params& p, unsigned char* ws, LAS unsigned char* lds, int l, int budget) {
    if (l >= DEPTH) return;
    const int tid = tidx(), lane = tid & 63, wave = tid >> 6;
    LAS float* scr = (LAS float*)(lds + wave * 16384);
    volatile LAS unsigned* slot = (volatile LAS unsigned*)(lds + MISC_OFF + 96);
    unsigned* q = (unsigned*)(ws + WS_CTL) + CW_CONVQ + 64 * l;
    for (int c = 0; budget < 0 || c < budget; ++c) {
        if (tid == 0) *slot = __hip_atomic_fetch_add(q, (unsigned)(CONV_CHUNK * NWAVE), __ATOMIC_RELAXED, __HIP_MEMORY_SCOPE_AGENT);
        __syncthreads();
        const unsigned base = *slot;
        __syncthreads();
        if (base >= (unsigned)CONV_LAYER) break;
        for (int k = 0; k < CONV_CHUNK; ++k) conv_layer_item(p, ws, l, (int)base + wave * CONV_CHUNK + k, scr, lane);
    }
}

__device__ __forceinline__ int build_tile_table(const Ws& w, int layer, LAS unsigned* tab) {
    int cnt[NE], off[NE + 1];
    expert_offsets(w, layer, cnt, off);
    const int tid = tidx();
    if (tid < 256) {
        int e = -1;
#pragma unroll
        for (int q = 0; q < NE; ++q) if (tid * 256 >= off[q] && tid * 256 < off[q + 1]) e = q;
        int oe = 0, ce = 0;
#pragma unroll
        for (int q = 0; q < NE; ++q) if (q == e) { oe = off[q]; ce = cnt[q]; }
        if (e >= 0) { const int first = tid * 256 - oe; const int valid = min(256, ce - first);
            tab[2 * tid] = ((unsigned)e << 20) | (unsigned)first; tab[2 * tid + 1] = (unsigned)valid; }
    }
    __syncthreads();
    return off[NE] / 256;
}

namespace att {
typedef float f32x16 __attribute__((ext_vector_type(16)));
constexpr int STAGE_B = 32768, K_OFF = 0, V_OFF = 16384, RPB_OFF = 65536, RPB_W = 144, XCH_OFF = 0;
__device__ __forceinline__ int swz(int row, int chunk) { return row * 128 + ((chunk ^ ((row >> 1) & 7)) << 4); }
__device__ __forceinline__ int pi64(int r) { return (r & ~12) | ((r & 4) << 1) | ((r & 8) >> 1); }

template <int DV, int NKSUB> struct Stage { u32x4 k[NKSUB]; u32x4 v[DV / 64]; };

template <int DV, int NKSUB>
__device__ __forceinline__ void stage_load(Stage<DV, NKSUB>& st, const bf16_t* QK, const bf16_t* VT, int tok0, int kcolbase, int vch0, int tid) {
#pragma unroll
    for (int i = 0; i < NKSUB; ++i) { const int idx = tid + NTHR * i, row = idx / (8 * NKSUB), cc = idx % (8 * NKSUB);
        st.k[i] = *(const u32x4*)(QK + (size_t)(tok0 + row) * 2048 + 1024 + kcolbase + cc * 8); }
#pragma unroll
    for (int i = 0; i < DV / 64; ++i) { const int idx = tid + NTHR * i, row = idx >> 3, ch = idx & 7;
        st.v[i] = *(const u32x4*)(VT + (size_t)(vch0 + row) * NTOK + tok0 + ch * 8); }
}
template <int DV, int NKSUB>
__device__ __forceinline__ void stage_store(const Stage<DV, NKSUB>& st, LAS unsigned char* buf, int tid) {
#pragma unroll
    for (int i = 0; i < NKSUB; ++i) { const int idx = tid + NTHR * i, row = idx / (8 * NKSUB), cc = idx % (8 * NKSUB), sub = cc >> 3, ch = cc & 7;
        *(LAS u32x4*)(buf + K_OFF + sub * 8192 + swz(pi64(row), ch)) = st.k[i]; }
#pragma unroll
    for (int i = 0; i < DV / 64; ++i) { const int idx = tid + NTHR * i, row = idx >> 3, ch = idx & 7;
        *(LAS u32x4*)(buf + V_OFF + swz(row, ch)) = st.v[i]; }
}

__device__ __forceinline__ void stage_store_nat(const Stage<64, 1>& st, LAS unsigned char* buf, int tid) {
    { const int row = tid >> 3, ch = tid & 7; *(LAS u32x4*)(buf + K_OFF + swz(row, ch)) = st.k[0]; }
    { const int row = tid >> 3, ch = tid & 7; *(LAS u32x4*)(buf + V_OFF + swz(row, ch)) = st.v[0]; }
}
constexpr float ATT_THR = 8.f;
#ifndef ATT_PRIO
#define ATT_PRIO 1
#endif
template <int DV, bool BIAS>
__device__ __forceinline__ void qk_softmax(const LAS unsigned char* kb, const bf16x8 (&qf)[4], f32x16 (&o)[DV / 32], float& mref, float& l, bool& started,
                                           const float (&pen)[32], const LAS float* brow, int r, int h, bf16x8 (&pb)[4]) {
    f32x16 p0, p1;
#pragma unroll
    for (int i = 0; i < 16; ++i) { p0[i] = -mref; p1[i] = -mref; }
    bf16x8 kfa[4], kfb[4];
#pragma unroll
    for (int s = 0; s < 2; ++s) { kfa[2 * s] = *(const LAS bf16x8*)(kb + swz(r, 2 * s + h)); kfa[2 * s + 1] = *(const LAS bf16x8*)(kb + swz(32 + r, 2 * s + h)); }
#pragma unroll
    for (int s = 2; s < 4; ++s) { kfb[2 * (s - 2)] = *(const LAS bf16x8*)(kb + swz(r, 2 * s + h)); kfb[2 * (s - 2) + 1] = *(const LAS bf16x8*)(kb + swz(32 + r, 2 * s + h)); }
    __builtin_amdgcn_sched_barrier(0);
    if (ATT_PRIO) __builtin_amdgcn_s_setprio(1);
#pragma unroll
    for (int s = 0; s < 2; ++s) { p0 = __builtin_amdgcn_mfma_f32_32x32x16_bf16(kfa[2 * s], qf[s], p0, 0, 0, 0); p1 = __builtin_amdgcn_mfma_f32_32x32x16_bf16(kfa[2 * s + 1], qf[s], p1, 0, 0, 0); }
#pragma unroll
    for (int s = 2; s < 4; ++s) { p0 = __builtin_amdgcn_mfma_f32_32x32x16_bf16(kfb[2 * (s - 2)], qf[s], p0, 0, 0, 0); p1 = __builtin_amdgcn_mfma_f32_32x32x16_bf16(kfb[2 * (s - 2) + 1], qf[s], p1, 0, 0, 0); }
    if (ATT_PRIO) __builtin_amdgcn_s_setprio(0);
    __builtin_amdgcn_sched_barrier(0);
    if (BIAS) {
#pragma unroll
        for (int i = 0; i < 16; ++i) { const int kcl = 16 * (i >> 3) + (i & 7);
            p0[i] = (p0[i] + pen[i]) + brow[kcl]; p1[i] = (p1[i] + pen[16 + i]) + brow[32 + kcl]; }
    }
    float ma = fmaxf(fmaxf(p0[0], p0[1]), p1[0]), mb = fmaxf(fmaxf(p0[2], p0[3]), p1[1]);
    ma = fmaxf(fmaxf(ma, p1[2]), p1[3]);
#pragma unroll
    for (int i = 4; i < 16; i += 4) { ma = fmaxf(fmaxf(ma, p0[i]), p0[i + 1]); mb = fmaxf(fmaxf(mb, p0[i + 2]), p0[i + 3]); ma = fmaxf(fmaxf(ma, p1[i]), p1[i + 1]); mb = fmaxf(fmaxf(mb, p1[i + 2]), p1[i + 3]); }
    float mx = fmaxf(ma, mb);
    mx = fmaxf(mx, __shfl_xor(mx, 32));
    const bool need = (!started && mx > -INFINITY) || (mx > ATT_THR);
    if (__any(need)) {
        const float delta = need ? (started ? fmaxf(mx, 0.f) : mx) : 0.f;
        const float alpha = started ? __builtin_amdgcn_exp2f(-delta) : 1.f;
        started = started || need;
        mref += delta;
#pragma unroll
        for (int i = 0; i < 16; ++i) { p0[i] -= delta; p1[i] -= delta; }
        l *= alpha;
#pragma unroll
        for (int b = 0; b < DV / 32; ++b)
#pragma unroll
            for (int i = 0; i < 16; ++i) o[b][i] *= alpha;
    }
    float rs = 0.f;
#pragma unroll
    for (int i = 0; i < 16; ++i) { p0[i] = __builtin_amdgcn_exp2f(p0[i]); p1[i] = __builtin_amdgcn_exp2f(p1[i]); rs += p0[i] + p1[i]; }
    l += rs;
#pragma unroll
    for (int ks = 0; ks < 4; ++ks) {
        u32x4 t;
        if (ks < 2) { t.x = cvt_pk_bf16(p0[8 * ks + 0], p0[8 * ks + 1]); t.y = cvt_pk_bf16(p0[8 * ks + 2], p0[8 * ks + 3]); t.z = cvt_pk_bf16(p0[8 * ks + 4], p0[8 * ks + 5]); t.w = cvt_pk_bf16(p0[8 * ks + 6], p0[8 * ks + 7]); }
        else { const int q = ks - 2; t.x = cvt_pk_bf16(p1[8 * q + 0], p1[8 * q + 1]); t.y = cvt_pk_bf16(p1[8 * q + 2], p1[8 * q + 3]); t.z = cvt_pk_bf16(p1[8 * q + 4], p1[8 * q + 5]); t.w = cvt_pk_bf16(p1[8 * q + 6], p1[8 * q + 7]); }
        pb[ks] = __builtin_bit_cast(bf16x8, t);
    }
}
template <int DV>
__device__ __forceinline__ void pv_accum(const LAS unsigned char* vb, const bf16x8 (&pb)[4], f32x16 (&o)[DV / 32], int r, int h) {
    bf16x8 vfa[4], vfb[4];
#pragma unroll
    for (int ks = 0; ks < 4; ++ks) vfa[ks] = *(const LAS bf16x8*)(vb + swz(r, 2 * ks + h));
#pragma unroll
    for (int b = 0; b < DV / 32; b += 2) {
        if (b + 1 < DV / 32) {
#pragma unroll
            for (int ks = 0; ks < 4; ++ks) vfb[ks] = *(const LAS bf16x8*)(vb + swz(32 * (b + 1) + r, 2 * ks + h));
        }
        __builtin_amdgcn_sched_barrier(0);
        if (ATT_PRIO) __builtin_amdgcn_s_setprio(1);
#pragma unroll
        for (int ks = 0; ks < 4; ++ks) o[b] = __builtin_amdgcn_mfma_f32_32x32x16_bf16(vfa[ks], pb[ks], o[b], 0, 0, 0);
        if (ATT_PRIO) __builtin_amdgcn_s_setprio(0);
        if (b + 2 < DV / 32) {
#pragma unroll
            for (int ks = 0; ks < 4; ++ks) vfa[ks] = *(const LAS bf16x8*)(vb + swz(32 * (b + 2) + r, 2 * ks + h));
        }
        __builtin_amdgcn_sched_barrier(0);
        if (b + 1 < DV / 32) {
            if (ATT_PRIO) __builtin_amdgcn_s_setprio(1);
#pragma unroll
            for (int ks = 0; ks < 4; ++ks) o[b + 1] = __builtin_amdgcn_mfma_f32_32x32x16_bf16(vfb[ks], pb[ks], o[b + 1], 0, 0, 0);
            if (ATT_PRIO) __builtin_amdgcn_s_setprio(0);
        }
    }
}
template <int DV, bool BIAS>
__device__ __forceinline__ void tile_compute(const LAS unsigned char* buf, int ksub, const bf16x8 (&qf)[4], f32x16 (&o)[DV / 32], float& mref, float& l, bool& started,
                                             const float (&pen)[32], const LAS float* brow, int r, int h) {
    bf16x8 pb[4];
    qk_softmax<DV, BIAS>(buf + K_OFF + ksub * 8192, qf, o, mref, l, started, pen, brow, r, h, pb);
    __builtin_amdgcn_sched_barrier(0);
    pv_accum<DV>(buf + V_OFF, pb, o, r, h);
}

__device__ __forceinline__ void band_tile32(const LAS unsigned char* buf, int x0, const bf16x8 (&qf)[4], f32x16 (&o)[2], float& mref, float& l, bool& started,
                                            const float (&pen16)[16], const LAS float* brow, int r, int h) {
    f32x16 p0;
#pragma unroll
    for (int i = 0; i < 16; ++i) p0[i] = -mref;
    const LAS unsigned char* kb = buf + K_OFF; const LAS unsigned char* vb = buf + V_OFF;
    const int krow = x0 + pi64(r);
    bf16x8 kf[4];
#pragma unroll
    for (int s = 0; s < 4; ++s) kf[s] = *(const LAS bf16x8*)(kb + swz(krow, 2 * s + h));
    __builtin_amdgcn_sched_barrier(0);
    if (ATT_PRIO) __builtin_amdgcn_s_setprio(1);
#pragma unroll
    for (int s = 0; s < 4; ++s) p0 = __builtin_amdgcn_mfma_f32_32x32x16_bf16(kf[s], qf[s], p0, 0, 0, 0);
    if (ATT_PRIO) __builtin_amdgcn_s_setprio(0);
    const int vch = (x0 >> 3) + h;
    bf16x8 vf[4];
#pragma unroll
    for (int b = 0; b < 2; ++b)
#pragma unroll
        for (int ks = 0; ks < 2; ++ks) vf[2 * b + ks] = *(const LAS bf16x8*)(vb + swz(32 * b + r, vch + 2 * ks));
    __builtin_amdgcn_sched_barrier(0);
#pragma unroll
    for (int i = 0; i < 16; ++i) p0[i] = (p0[i] + pen16[i]) + brow[16 * (i >> 3) + (i & 7)];
    float ma = fmaxf(fmaxf(p0[0], p0[1]), p0[2]), mb = fmaxf(fmaxf(p0[3], p0[4]), p0[5]);
#pragma unroll
    for (int i = 6; i < 16; i += 2) { ma = fmaxf(ma, p0[i]); mb = fmaxf(mb, p0[i + 1]); }
    float mx = fmaxf(ma, mb);
    mx = fmaxf(mx, __shfl_xor(mx, 32));
    const bool need = (!started && mx > -INFINITY) || (mx > ATT_THR);
    if (__any(need)) {
        const float delta = need ? (started ? fmaxf(mx, 0.f) : mx) : 0.f;
        const float alpha = started ? __builtin_amdgcn_exp2f(-delta) : 1.f;
        started = started || need;
        mref += delta;
#pragma unroll
        for (int i = 0; i < 16; ++i) p0[i] -= delta;
        l *= alpha;
#pragma unroll
        for (int b = 0; b < 2; ++b)
#pragma unroll
            for (int i = 0; i < 16; ++i) o[b][i] *= alpha;
    }
    float rs = 0.f;
#pragma unroll
    for (int i = 0; i < 16; ++i) { p0[i] = __builtin_amdgcn_exp2f(p0[i]); rs += p0[i]; }
    l += rs;
    bf16x8 pb[2];
#pragma unroll
    for (int ks = 0; ks < 2; ++ks) { u32x4 t; t.x = cvt_pk_bf16(p0[8 * ks + 0], p0[8 * ks + 1]); t.y = cvt_pk_bf16(p0[8 * ks + 2], p0[8 * ks + 3]); t.z = cvt_pk_bf16(p0[8 * ks + 4], p0[8 * ks + 5]); t.w = cvt_pk_bf16(p0[8 * ks + 6], p0[8 * ks + 7]);
        pb[ks] = __builtin_bit_cast(bf16x8, t); }
    __builtin_amdgcn_sched_barrier(0);
    if (ATT_PRIO) __builtin_amdgcn_s_setprio(1);
#pragma unroll
    for (int b = 0; b < 2; ++b)
#pragma unroll
        for (int ks = 0; ks < 2; ++ks) o[b] = __builtin_amdgcn_mfma_f32_32x32x16_bf16(vf[2 * b + ks], pb[ks], o[b], 0, 0, 0);
    if (ATT_PRIO) __builtin_amdgcn_s_setprio(0);
}

__device__ __forceinline__ void natten_phase(const Params& P, const Ws& w, LAS unsigned char* lds, int layer) {
    const bool last = (layer == DEPTH - 1);
    const float* rpb = P.na_rpb + (size_t)(layer / 2) * 16 * 15 * 31;
    LAS float* rtab = (LAS float*)(lds + RPB_OFF);
    const int nlat = NB * 16 * 8, nctx = last ? 0 : NB * 16;
    int tab_head = -1;
    for (int u = bidx(); u < nlat + nctx; u += gridDim.x) {
        const int tid = tidx(), lane = tid & 63, wave = __builtin_amdgcn_readfirstlane(tid >> 6), r = lane & 31, h = lane >> 5;
        const bool isctx = (u >= nlat);
        int b, head, rg = 0;
        if (!isctx) { rg = u & 7; head = (u >> 3) & 15; b = u >> 7; } else { const int u2 = u - nlat; head = u2 & 15; b = u2 >> 4; }
        const int cg = wave & 3, rp = wave >> 2;
        const int qr = 4 * rg + 2 * rp + (r >> 4), qc = 16 * cg + (r & 15);
        const int qtok = isctx ? NLAT + b * CL + 32 * wave + r : b * SEQ + qr * GW + qc;
        const int x0 = (cg == 0) ? 0 : (cg == 1) ? 8 : (cg == 2) ? 24 : 32;
        const int c0 = min(max(qc - 8, 0), 48), r0l = min(max(qr - 4, 0), 24);
        const int rfirst = min(max(4 * rg - 4, 0), 24), rlast = min(max(4 * rg + 3 - 4, 0), 24) + 7;
        const int nband = isctx ? 0 : rlast - rfirst + 1, NT = nband + 4;
        const int wlo = min(max(4 * rg + 2 * rp - 4, 0), 24), whi = min(max(4 * rg + 2 * rp + 1 - 4, 0), 24) + 7;
        auto tile_tok = [&](int t) -> int { return (t < nband) ? b * SEQ + (rfirst + t) * GW : NLAT + b * CL + (t - nband) * 64; };
        Stage<64, 1> st;
        stage_load<64, 1>(st, w.QK, w.VT, tile_tok(0), head * 64, head * 64, tid);
        bf16x8 qf[4];
#pragma unroll
        for (int s = 0; s < 4; ++s) qf[s] = *(const bf16x8*)(w.QK + (size_t)qtok * 2048 + head * 64 + 16 * s + 8 * h);
        if (!isctx && head != tab_head) {
            for (int i = tid; i < 16 * RPB_W; i += NTHR) { const int dr = i / RPB_W, d = i % RPB_W - 63;
                rtab[i] = (dr == 15) ? -INFINITY : (d >= -15 && d <= 15) ? rpb[(head * 15 + dr) * 31 + d + 15] * LOG2E : 0.f; }
            tab_head = head;
        }
        float pen16[16];
#pragma unroll
        for (int i = 0; i < 16; ++i) { const int kc = x0 + 16 * (i >> 3) + 8 * h + (i & 7); pen16[i] = ((unsigned)(kc - c0) < 16u) ? 0.f : -INFINITY; }
        float pen[32];
#pragma unroll
        for (int i = 0; i < 32; ++i) pen[i] = 0.f;
        f32x16 o[2];
#pragma unroll
        for (int i = 0; i < 16; ++i) { o[0][i] = 0.f; o[1][i] = 0.f; }
        float m = 0.f, l = 0.f; bool started = false;
        if (0 < nband) stage_store_nat(st, lds, tid); else stage_store<64, 1>(st, lds, tid);
        __syncthreads();
        for (int t = 0; t < NT; ++t) {
            if (t + 1 < NT) stage_load<64, 1>(st, w.QK, w.VT, tile_tok(t + 1), head * 64, head * 64, tid);
            const LAS unsigned char* buf = lds + (t & 1) * STAGE_B;
            if (t < nband) {
                const int kr = rfirst + t;
                if (kr >= wlo && kr <= whi) {
                    const bool rowok = (kr >= r0l) && (kr < r0l + 8);
                    const LAS float* brow = rtab + (rowok ? (kr - qr + 7) : 15) * RPB_W + 63 - qc + x0 + 8 * h;
                    band_tile32(buf, x0, qf, o, m, l, started, pen16, brow, r, h);
                }
            } else tile_compute<64, false>(buf, 0, qf, o, m, l, started, pen, rtab, r, h);
            if (t + 1 < NT) { if (t + 1 < nband) stage_store_nat(st, lds + ((t + 1) & 1) * STAGE_B, tid); else stage_store<64, 1>(st, lds + ((t + 1) & 1) * STAGE_B, tid); }
            __syncthreads();
        }
        l += __shfl_xor(l, 32);
        const float il = 1.f / l;
        bf16_t* op = w.O + (size_t)qtok * D + head * 64;
#pragma unroll
        for (int bb = 0; bb < 2; ++bb)
#pragma unroll
            for (int g = 0; g < 4; ++g) {
                u32x2 v; v.x = cvt_pk_bf16(o[bb][4 * g] * il, o[bb][4 * g + 1] * il); v.y = cvt_pk_bf16(o[bb][4 * g + 2] * il, o[bb][4 * g + 3] * il);
                *(u32x2*)(op + 32 * bb + 8 * g + 4 * h) = v;
            }
    }
}

__device__ __forceinline__ void diff_phase(const Params& P, const Ws& w, LAS unsigned char* lds, int layer) {
    const int tid = tidx(), lane = tid & 63, wave = __builtin_amdgcn_readfirstlane(tid >> 6), r = lane & 31, h = lane >> 5;
    const bool last = (layer == DEPTH - 1);
    const int j = layer / 2;
    const float* lam = P.diff_lambda + (size_t)j * 4 * 64; const float* sg = P.diff_subln + (size_t)j * 128;
    float d01 = 0.f, d23 = 0.f;
    for (int i = 0; i < 64; ++i) { d01 += lam[i] * lam[64 + i]; d23 += lam[128 + i] * lam[192 + i]; }
    const float li = lam_init_of(layer);
    const float lam_full = expf(d01) - expf(d23) + li;
    const int nlat = NB * 8 * 16, nctx = last ? 0 : NB * 8 * 2;
    const int map = wave >> 2, wq = wave & 3;
    for (int u = bidx(); u < nlat + nctx; u += gridDim.x) {
        const bool isctx = (u >= nlat);
        int b, head, qb;
        if (!isctx) { qb = u & 15; head = (u >> 4) & 7; b = u >> 7; } else { const int u2 = u - nlat; qb = u2 & 1; head = (u2 >> 1) & 7; b = u2 >> 4; }
        const int qtok = (isctx ? NLAT + b * CL : b * SEQ) + 128 * qb + 32 * wq + r;
        const int NT = isctx ? 4 : 36;
        bf16x8 qf[4];
#pragma unroll
        for (int s = 0; s < 4; ++s) qf[s] = *(const bf16x8*)(w.QK + (size_t)qtok * 2048 + head * 128 + map * 64 + 16 * s + 8 * h);
        f32x16 o[4];
#pragma unroll
        for (int bb = 0; bb < 4; ++bb)
#pragma unroll
            for (int i = 0; i < 16; ++i) o[bb][i] = 0.f;
        float m = 0.f, l = 0.f; bool started = false;
        float pen[32];
#pragma unroll
        for (int i = 0; i < 32; ++i) pen[i] = 0.f;
        auto tile_tok = [&](int t) -> int { return (!isctx && t < 32) ? b * SEQ + t * 64 : NLAT + b * CL + (isctx ? t : t - 32) * 64; };
        Stage<128, 2> st;
        stage_load<128, 2>(st, w.QK, w.VT, tile_tok(0), head * 128, head * 128, tid);
        stage_store<128, 2>(st, lds, tid);
        __syncthreads();
        for (int t = 0; t < NT; ++t) {
            if (t + 1 < NT) stage_load<128, 2>(st, w.QK, w.VT, tile_tok(t + 1), head * 128, head * 128, tid);
            tile_compute<128, false>(lds + (t & 1) * STAGE_B, map, qf, o, m, l, started, pen, (const LAS float*)lds, r, h);
            if (t + 1 < NT) stage_store<128, 2>(st, lds + ((t + 1) & 1) * STAGE_B, tid);
            __syncthreads();
        }
        l += __shfl_xor(l, 32);
        const float il = 1.f / l;
        LAS float* xch = (LAS float*)(lds + XCH_OFF) + wq * (128 * 32);
        if (map == 1) {
#pragma unroll
            for (int bb = 0; bb < 4; ++bb)
#pragma unroll
                for (int i = 0; i < 16; ++i) { const int dv = 32 * bb + (i & 3) + 8 * (i >> 2) + 4 * h; xch[dv * 32 + r] = o[bb][i] * il; }
        }
        __syncthreads();
        if (map == 0) {
            float ss = 0.f;
#pragma unroll
            for (int bb = 0; bb < 4; ++bb)
#pragma unroll
                for (int i = 0; i < 16; ++i) { const int dv = 32 * bb + (i & 3) + 8 * (i >> 2) + 4 * h; const float v = o[bb][i] * il - lam_full * xch[dv * 32 + r]; o[bb][i] = v; ss += v * v; }
            ss += __shfl_xor(ss, 32);
            const float rinv = rsqrtf(ss * (1.f / 128.f) + EPS) * (1.f - li);
            bf16_t* op = w.O + (size_t)qtok * D + head * 128;
#pragma unroll
            for (int bb = 0; bb < 4; ++bb)
#pragma unroll
                for (int g = 0; g < 4; ++g) {
                    const int dv = 32 * bb + 8 * g + 4 * h;
                    const f32x4 gg = *(const f32x4*)(sg + dv);
                    u32x2 v; v.x = cvt_pk_bf16(o[bb][4 * g] * rinv * gg[0], o[bb][4 * g + 1] * rinv * gg[1]); v.y = cvt_pk_bf16(o[bb][4 * g + 2] * rinv * gg[2], o[bb][4 * g + 3] * rinv * gg[3]);
                    *(u32x2*)(op + dv) = v;
                }
        }
        __syncthreads();
    }
}
}

#define XB_TMO      128
#define XB_XCNT(j)  (256  + 64 * (j))
#define XB_XSUB(j)  (1280 + 64 * (j))
#define XB_XGEN(j)  (2304 + 64 * (j))
#define XB_TOP      3328
#define XB_TOPGEN   3392
#define XCD_BAR_WORDS 3456
#define XB_SPIN_CAP (1u << 22)
constexpr int CW_BAR = 8192;
__device__ __forceinline__ unsigned xb_ld(unsigned* p)              { return __hip_atomic_load(p, __ATOMIC_RELAXED, __HIP_MEMORY_SCOPE_AGENT); }
__device__ __forceinline__ unsigned xb_add(unsigned* p, unsigned v) { return __hip_atomic_fetch_add(p, v, __ATOMIC_RELAXED, __HIP_MEMORY_SCOPE_AGENT); }
__device__ __forceinline__ unsigned xb_xcc_id() { return (unsigned)__builtin_amdgcn_s_getreg((3 << 11) | 20) & 0xFu; }
#define XB_SPIN(cond, bar) do { unsigned _sp = 0; while (cond) { __builtin_amdgcn_s_sleep(1); \
    if ((++_sp & 255u) == 0u) { if (xb_ld(&(bar)[XB_TMO])) break; if (_sp > XB_SPIN_CAP) { atomicAdd(&(bar)[XB_TMO], 1u); break; } } } } while (0)
struct XcdBarrier { unsigned* bar; unsigned x; volatile LAS unsigned* st; };
__device__ __forceinline__ XcdBarrier xcd_barrier_post(unsigned* bar, volatile LAS unsigned* st) {
    XcdBarrier b; b.bar = bar; b.x = xb_xcc_id(); b.st = st;
    if (tidx() == 0) (void)xb_add(&bar[XB_XCNT(b.x)], 1u);
    return b;
}
__device__ __forceinline__ void xcd_barrier_complete(unsigned* bar, unsigned x, unsigned& nloc, unsigned& nx) {
    const unsigned G = gridDim.x * gridDim.y * gridDim.z;
    unsigned sum, cnt, mine, sp = 0u;
    for (;;) {
        sum = 0u; cnt = 0u; mine = 0u;
#pragma unroll
        for (unsigned j = 0; j < 16; ++j) { const unsigned c = xb_ld(&bar[XB_XCNT(j)]); sum += c; cnt += (c > 0u) ? 1u : 0u; mine = (j == x) ? c : mine; }
        if (sum == G) break;
        __builtin_amdgcn_s_sleep(1);
        if ((++sp & 255u) == 0u) { if (xb_ld(&bar[XB_TMO])) break; if (sp > XB_SPIN_CAP) { atomicAdd(&bar[XB_TMO], 1u); break; } }
    }
    nloc = mine > 0u ? mine : 1u; nx = cnt > 0u ? cnt : 1u;
}
__device__ __forceinline__ void xcd_barrier(const XcdBarrier& b) {
    asm volatile("s_waitcnt vmcnt(0)" ::: "memory");
    __syncthreads();
    if (tidx() == 0) {
        unsigned* bar = b.bar;
        __builtin_amdgcn_s_waitcnt(0);
        unsigned nloc = b.st[0], nx = b.st[1];
        if (nloc == 0u) { xcd_barrier_complete(bar, b.x, nloc, nx); b.st[0] = nloc; b.st[1] = nx; }
        const unsigned old = xb_add(&bar[XB_XSUB(b.x)], 1u);
        const unsigned gen = old / nloc;
        if (old + 1u == (gen + 1u) * nloc) {
            __builtin_amdgcn_fence(__ATOMIC_RELEASE, "agent");
            asm volatile("s_waitcnt vmcnt(0)" ::: "memory");
            const unsigned og = xb_add(&bar[XB_TOP], 1u);
            const unsigned tg = og / nx;
            if (og + 1u == (tg + 1u) * nx) xb_add(&bar[XB_TOPGEN], 1u);
            else XB_SPIN(xb_ld(&bar[XB_TOPGEN]) == tg, bar);
            __builtin_amdgcn_fence(__ATOMIC_ACQUIRE, "agent");
            xb_add(&bar[XB_XGEN(b.x)], 1u);
            asm volatile("s_waitcnt vmcnt(0)" ::: "memory");
        } else {
            XB_SPIN(xb_ld(&bar[XB_XGEN(b.x)]) == gen, bar);
            __builtin_amdgcn_fence(__ATOMIC_ACQUIRE, "agent");
            asm volatile("s_waitcnt vmcnt(0)" ::: "memory");
        }
    }
    __syncthreads();
}

constexpr int MK_NSTEPS = 2 + 7 * DEPTH;
#ifndef CONV_BUDGET
#define CONV_BUDGET 2
#endif
__global__ void __launch_bounds__(NTHR, 2) mk_fwd(Params p) {
    extern __shared__ __attribute__((aligned(16))) unsigned char lds_raw[];
    LAS unsigned char* lds = (LAS unsigned char*)lds_raw;
    const int tid = tidx();
    for (int u = tid; u < (LDS_BYTES - LDSCTL_OFF) / 4; u += NTHR) ((LAS unsigned*)(lds + LDSCTL_OFF))[u] = 0u;
    __syncthreads();
    volatile LAS unsigned* MISC = (volatile LAS unsigned*)(lds + MISC_OFF);
    XcdBarrier bar = xcd_barrier_post((unsigned*)(p.ws + WS_CTL) + CW_BAR, MISC + 8);
    const int G = gridDim.x, c = bidx();
    for (int s = p.step_lo; s < p.step_hi; ++s) {
        if (s > p.step_lo) {
            if (p.step_hi > 1000000) cg::this_grid().sync();
            xcd_barrier(bar);
        }
#if defined(__HIP_DEVICE_COMPILE__)
        const __attribute__((address_space(4))) Params* pp4 = (const __attribute__((address_space(4))) Params*)__builtin_amdgcn_kernarg_segment_ptr();
        asm volatile("" : "+s"(pp4));
        const Params P = *pp4;
#else
        const Params P = p;
#endif
        unsigned char* wsb = P.ws;
        const Ws w = make_ws(wsb);
        if (s == 0) {
            phase_convert(P, wsb, lds, 0, 1); __syncthreads();
            phase_prologue(P, w, (float*)lds_raw); __syncthreads();
            continue;
        }
        if (s == MK_NSTEPS - 1) { phase_norm(P, w, DEPTH - 1, 2, lds); continue; }
        const int l = (s - 1) / 7, ph = (s - 1) % 7;
        const char* wl = (const char*)(wsb + WS_W + (size_t)l * WL_BYTES);
        if (ph == 0) { phase_norm(P, w, l, 0, lds);
            if (l > 0) { __syncthreads(); convert_pull(P, wsb, lds, l, -1); } }
        else if (ph == 1) {
            SchedQKV S{(const char*)w.H, wl + WO_QK, wl + WO_V, G, c};
            EpiQKV E{w.QK, w.VT, w.rope_cos, w.rope_sin, (l & 1) != 0};
            pg8::gemm_phase<EpiQKV, SchedQKV, true, true>(lds, D, S, E); __syncthreads();
            if (864 % G != 0 && c >= 864 % G) convert_pull(P, wsb, lds, l + 1, CONV_BUDGET);
        } else if (ph == 2) {
            if (l & 1) att::diff_phase(P, w, lds, l); else att::natten_phase(P, w, lds, l);
        } else if (ph == 3) {
            SchedDense S{(const char*)w.O, wl + WO_O, (l == DEPTH - 1) ? NLAT / 256 : NTOK / 256, 4, G, c};
            EpiWO E{P.x, P.ctx, w.X, w.mods + (size_t)l * 9 * (NMOD * D) + 2 * D, l == 0};
            pg8::gemm_phase<EpiWO, SchedDense, true, true>(lds, D, S, E);
            __syncthreads();
            if (l < DEPTH - 1 && 288 % G != 0 && c >= 288 % G) convert_pull(P, wsb, lds, l + 1, CONV_BUDGET);
        } else if (ph == 4) phase_norm(P, w, l, 1, lds);
        else if (ph == 5) {
            LAS unsigned* tab = (LAS unsigned*)(lds + TILETAB_OFF);
            const int ntile = build_tile_table(w, l, tab);
            SchedMoe<true> S{(const char*)w.H, wl + WO_E, w.list, tab, ntile, 8, G, c, 0};
            EpiGLU E{w.ACT};
            pg8::gemm_phase<EpiGLU, SchedMoe<true>, true, true>(lds, D, S, E);
        } else {
            LAS unsigned* tab = (LAS unsigned*)(lds + TILETAB_OFF);
            const int ntile = build_tile_table(w, l, tab);
            SchedMoe<false> S{(const char*)w.ACT, wl + WO_E, w.list, tab, ntile, 4, G, c, WE_2};
            EpiDown E{w.Y};
            pg8::gemm_phase<EpiDown, SchedMoe<false>, true, true>(lds, D, S, E); __syncthreads();
            if ((ntile * 4) % G != 0 && c >= (ntile * 4) % G) convert_pull(P, wsb, lds, l + 1, CONV_BUDGET);
        }
    }
}

extern "C" void kernel_launch(void* const* d_in, const int* in_sizes, int n_in, void* d_out, int out_size, void* d_ws, size_t ws_size, hipStream_t stream) {
    static int grid = 0;
    if (grid == 0) {
        int dev = 0, cus = 0, per_cu = 0;
        (void)hipGetDevice(&dev);
        (void)hipDeviceGetAttribute(&cus, hipDeviceAttributeMultiprocessorCount, dev);
        if (hipFuncSetAttribute((const void*)mk_fwd, hipFuncAttributeMaxDynamicSharedMemorySize, LDS_BYTES) != hipSuccess) { fprintf(stderr, "kernel_launch: hipFuncSetAttribute failed\n"); grid = -1; }
        if (hipOccupancyMaxActiveBlocksPerMultiprocessor(&per_cu, (const void*)mk_fwd, NTHR, LDS_BYTES) != hipSuccess || per_cu < 1) { fprintf(stderr, "kernel_launch: occupancy query says %d blocks per CU\n", per_cu); if (grid == 0) grid = -1; }
        (void)hipGetLastError();
        if (grid == 0) grid = cus;
        if (grid > 0 && grid < 144) { fprintf(stderr, "kernel_launch: built for >= 144 CUs (got %d)\n", grid); grid = -1; }
        if (ws_size < WS_END) { fprintf(stderr, "kernel_launch: workspace too small (%zu < %zu)\n", ws_size, (size_t)WS_END); grid = -1; }
    }
    if (grid < 0) return;
    (void)hipMemsetAsync((char*)d_ws + WS_CTL, 0, CTL_BYTES, stream);
    Params p{};
    const float** pp = (const float**)&p;
    for (int i = 0; i < 19; ++i) pp[i] = (const float*)d_in[i];
    p.out = (float*)d_out; p.ws = (unsigned char*)d_ws;
    const dim3 blk(NTHR);
    p.step_lo = 0; p.step_hi = MK_NSTEPS;
    void* args[] = {&p};
    hipError_t e = hipLaunchCooperativeKernel((const void*)mk_fwd, dim3(grid), blk, args, LDS_BYTES, stream);
    if (e != hipSuccess) fprintf(stderr, "cooperative launch failed: %s (grid %d)\n", hipGetErrorString(e), grid);
}
```

```cpp
#include <hip/hip_runtime.h>
#include <hip/hip_cooperative_groups.h>
#include <cstdio>
#include <cstdint>
namespace cg = cooperative_groups;


typedef unsigned short bf16_t;
typedef float v4f __attribute__((ext_vector_type(4)));
constexpr int D = 1024, NB = 8, SEQ = 2048, CL = 256, NLAT = NB * SEQ, NCTX = NB * CL, NTOK = NLAT + NCTX;
constexpr int DEPTH = 4, NE = 16, NMOD = 6, GW = 64;
constexpr float EPS = 1e-6f, LOG2E = 1.4426950408889634f, QSCALE = 0.125f * 1.4426950408889634f;
constexpr int NTHR = 512, NWAVE = 8;
constexpr int SLOTS = 40960;

constexpr size_t MiB = 1u << 20;
constexpr size_t WS_CTL = 0, CTL_BYTES = 1 * MiB;
constexpr size_t WS_MODS = 1 * MiB;
constexpr size_t WS_ROPE = 2 * MiB;
constexpr size_t WS_TOKI = 3 * MiB;
constexpr size_t WS_LIST = 4 * MiB;
constexpr size_t WS_X = 6 * MiB;
constexpr size_t WS_H = 78 * MiB;
constexpr size_t WS_QK = 114 * MiB;
constexpr size_t WS_VT = 186 * MiB;
constexpr size_t WS_O = 222 * MiB;
constexpr size_t WS_ACT = 258 * MiB;
constexpr size_t WS_Y = 338 * MiB;
constexpr size_t WS_W = 418 * MiB;
constexpr size_t WL_BYTES = 104 * MiB, WO_QK = 0, WO_V = 4 * MiB, WO_O = 6 * MiB, WO_E = 8 * MiB, WE_BYTES = 6 * MiB, WE_2 = 4 * MiB;
constexpr size_t WS_END = WS_W + 4 * WL_BYTES;
constexpr int CW_CNT = 1024;

struct Params {
    const float *x, *c, *ctx, *c_ctx, *mod_w, *mod_b, *norm_mix, *norm_ffn, *w_qkv, *w_o, *na_rpb, *diff_lambda, *diff_subln,
        *router_w, *router_b, *wg, *wu, *wd, *final_norm;
    float* out;
    unsigned char* ws;
    int step_lo, step_hi;
};

__device__ __forceinline__ int tidx() { int t = threadIdx.x; asm volatile("" : "+v"(t)); return t; }
__device__ __forceinline__ int bidx() { int t = blockIdx.x; asm volatile("" : "+s"(t)); return t; }
__device__ __forceinline__ float bf2f(bf16_t v) { return __uint_as_float(((unsigned)v) << 16); }
__device__ __forceinline__ bf16_t f2bf(float f) { unsigned u = __float_as_uint(f); return (bf16_t)((u + 0x7fffu + ((u >> 16) & 1u)) >> 16); }
__device__ __forceinline__ float wave_sum(float v) {
#pragma unroll
    for (int o = 1; o < 64; o <<= 1) v += __shfl_xor(v, o);
    return v;
}
__device__ __forceinline__ float silu_f(float v) { return v / (1.f + __expf(-v)); }
__device__ __forceinline__ int mod_row(int row) { return row < NLAT ? row / SEQ : NB; }
__device__ __forceinline__ float lam_init_of(int layer) { return 0.8f - 0.6f * expf(-0.3f * (float)layer); }

struct Ws {
    unsigned* ctl; float* mods; float* rope_cos; float* rope_sin; int4* toki; float2* tokw; int* list;
    float* X; bf16_t *H, *QK, *VT, *O, *ACT, *Y;
};
__device__ __forceinline__ Ws make_ws(unsigned char* ws) {
    Ws w;
    w.ctl = (unsigned*)(ws + WS_CTL); w.mods = (float*)(ws + WS_MODS); w.rope_cos = (float*)(ws + WS_ROPE); w.rope_sin = w.rope_cos + SEQ * 32;
    w.toki = (int4*)(ws + WS_TOKI); w.tokw = (float2*)(ws + WS_TOKI + (size_t)NTOK * 16); w.list = (int*)(ws + WS_LIST);
    w.X = (float*)(ws + WS_X); w.H = (bf16_t*)(ws + WS_H); w.QK = (bf16_t*)(ws + WS_QK); w.VT = (bf16_t*)(ws + WS_VT); w.O = (bf16_t*)(ws + WS_O);
    w.ACT = (bf16_t*)(ws + WS_ACT); w.Y = (bf16_t*)(ws + WS_Y);
    return w;
}
__device__ __forceinline__ void expert_offsets(const Ws& w, int layer, int* cnt, int* off) {
    int acc = 0;
#pragma unroll
    for (int e = 0; e < NE; ++e) {
        const int c = (int)__hip_atomic_load(w.ctl + CW_CNT + (layer * NE + e) * 64, __ATOMIC_RELAXED, __HIP_MEMORY_SCOPE_AGENT);
        cnt[e] = c; off[e] = acc; acc += (c + 255) & ~255;
    }
    off[NE] = acc;
}

__device__ __forceinline__ void phase_prologue(const Params& p, const Ws& w, float* smem) {
    const int tid = tidx(), bid = bidx(), nb = gridDim.x;
    float* sact = smem;
    float* part = smem + 9 * 1024;
    for (int i = tid; i < 9 * 1024; i += NTHR) { const int r = i >> 10, k = i & 1023; const float v = r < NB ? p.c[r * D + k] : p.c_ctx[k]; sact[i] = silu_f(v); }
    __syncthreads();
    const int col = tid & 127, ks = tid >> 7;
    for (int u = bid; u < DEPTH * (NMOD * D / 128); u += nb) {
        const int layer = u / (NMOD * D / 128), col0 = (u % (NMOD * D / 128)) * 128;
        float acc[9];
#pragma unroll
        for (int r = 0; r < 9; ++r) acc[r] = 0.f;
        const float* wp = p.mod_w + ((size_t)layer * D + ks * 256) * (NMOD * D) + col0 + col;
#pragma unroll 4
        for (int k = 0; k < 256; ++k) {
            const float wv = wp[(size_t)k * (NMOD * D)];
#pragma unroll
            for (int r = 0; r < 9; ++r) acc[r] += sact[r * 1024 + ks * 256 + k] * wv;
        }
#pragma unroll
        for (int r = 0; r < 9; ++r) part[(ks * 9 + r) * 128 + col] = acc[r];
        __syncthreads();
        for (int i = tid; i < 9 * 128; i += NTHR) {
            const int r = i >> 7, cc = i & 127;
            const float v = part[(0 * 9 + r) * 128 + cc] + part[(1 * 9 + r) * 128 + cc] + part[(2 * 9 + r) * 128 + cc] + part[(3 * 9 + r) * 128 + cc];
            w.mods[((size_t)layer * 9 + r) * (NMOD * D) + col0 + cc] = v + p.mod_b[layer * (NMOD * D) + col0 + cc];
        }
        __syncthreads();
    }
    for (int i = bid * NTHR + tid; i < SEQ * 32; i += nb * NTHR) {
        const int t = i >> 5, j = i & 31, f = j & 15;
        const float pos = (float)(j < 16 ? t / GW : t % GW);
        const float inv = powf(10000.0f, -(float)f / 16.0f);
        const float ang = pos * inv;
        w.rope_cos[i] = cosf(ang); w.rope_sin[i] = sinf(ang);
    }
}

__device__ __forceinline__ void phase_norm(const Params& p, const Ws& w, int layer, int mode, __attribute__((address_space(3))) unsigned char* lds) {
#define NLAS __attribute__((address_space(3)))
    const int tid = tidx(), lane = tid & 63, wave = tid >> 6;
    const int gw = bidx() * NWAVE + wave, ngw = gridDim.x * NWAVE;
    const bool combine = (mode == 0 && layer > 0) || mode == 2;
    const int clayer = (mode == 2) ? DEPTH - 1 : layer - 1;
    int cnt[NE], off[NE + 1];
    if (combine) expert_offsets(w, clayer, cnt, off);
    int nrows = NTOK;
    if (mode == 2) nrows = NLAT;
    if (mode == 1 && layer == DEPTH - 1) nrows = NLAT;
    NLAS unsigned* lcnt = (NLAS unsigned*)lds;
    NLAS v4f* lgb = (NLAS v4f*)(lds + 1024);
    const NLAS v4f* rwl = (const NLAS v4f*)(lds + 16384);
    const int rpb = (nrows + (int)gridDim.x - 1) / (int)gridDim.x;
    const int chunk0 = bidx() * rpb;
    if (mode == 1) {
        if (tid < 32) lcnt[tid] = 0u;
        for (int c = tid; c < D * 4; c += NTHR) { const int k = c >> 2, e4 = c & 3, j = k >> 8, ln = (k & 255) >> 2, q = k & 3;
            ((NLAS v4f*)(lds + 16384))[((j * 4 + q) * 4 + e4) * 64 + ln] = ((const v4f*)p.router_w)[c]; }
        __syncthreads();
    }
    const bool from_input = (layer == 0 && mode == 0);
    const int row0 = (mode == 1) ? chunk0 + wave : gw, rstep = (mode == 1) ? NWAVE : ngw;
    const int rend = (mode == 1) ? min(nrows, chunk0 + rpb) : nrows;
    v4f vn[4]; int4 tin = make_int4(0, 0, 0, 0); float2 twn = make_float2(0.f, 0.f);
    if (row0 < rend) {
        const float* src = from_input ? (row0 < NLAT ? p.x + (size_t)row0 * D : p.ctx + (size_t)(row0 - NLAT) * D) : w.X + (size_t)row0 * D;
#pragma unroll
        for (int j = 0; j < 4; ++j) vn[j] = __builtin_nontemporal_load((const v4f*)src + 64 * j + lane);
        if (combine) { tin = w.toki[row0]; twn = w.tokw[row0]; }
    }
    for (int row = row0; row < rend; row += rstep) {
        const int r = mod_row(row);
        v4f v[4];
#pragma unroll
        for (int j = 0; j < 4; ++j) v[j] = vn[j];
        const int4 ti = tin; const float2 tw = twn;
        {
            const int nrow = row + rstep;
            if (nrow < rend) {
                const float* src = from_input ? (nrow < NLAT ? p.x + (size_t)nrow * D : p.ctx + (size_t)(nrow - NLAT) * D) : w.X + (size_t)nrow * D;
#pragma unroll
                for (int j = 0; j < 4; ++j) vn[j] = __builtin_nontemporal_load((const v4f*)src + 64 * j + lane);
                if (combine) { tin = w.toki[nrow]; twn = w.tokw[nrow]; }
            }
        }
        if (combine) {
            int o0 = 0, o1 = 0;
#pragma unroll
            for (int e = 0; e < NE; ++e) { if (e == ti.x) o0 = off[e]; if (e == ti.z) o1 = off[e]; }
            const bf16_t* y0 = w.Y + (size_t)(o0 + ti.y) * D; const bf16_t* y1 = w.Y + (size_t)(o1 + ti.w) * D;
            const float* g5 = w.mods + ((size_t)clayer * 9 + r) * (NMOD * D) + 5 * D;
#pragma unroll
            for (int j = 0; j < 4; ++j) {
                const int k = 4 * (64 * j + lane);
                typedef unsigned v2u __attribute__((ext_vector_type(2)));
                const v2u a_ = __builtin_nontemporal_load((const v2u*)(y0 + k)), b_ = __builtin_nontemporal_load((const v2u*)(y1 + k));
                const uint2 a = make_uint2(a_[0], a_[1]), b = make_uint2(b_[0], b_[1]);
                const v4f g = *(const v4f*)(g5 + k);
                v[j][0] += g[0] * (tw.x * bf2f((bf16_t)(a.x & 0xffff)) + tw.y * bf2f((bf16_t)(b.x & 0xffff)));
                v[j][1] += g[1] * (tw.x * bf2f((bf16_t)(a.x >> 16)) + tw.y * bf2f((bf16_t)(b.x >> 16)));
                v[j][2] += g[2] * (tw.x * bf2f((bf16_t)(a.y & 0xffff)) + tw.y * bf2f((bf16_t)(b.y & 0xffff)));
                v[j][3] += g[3] * (tw.x * bf2f((bf16_t)(a.y >> 16)) + tw.y * bf2f((bf16_t)(b.y >> 16)));
            }
            if (mode != 2) {
                float* xdst = w.X;
#pragma unroll
                for (int j = 0; j < 4; ++j) ((v4f*)(xdst + (size_t)row * D))[64 * j + lane] = v[j];
            }
        }
        float ss = 0.f;
#pragma unroll
        for (int j = 0; j < 4; ++j) ss += v[j][0] * v[j][0] + v[j][1] * v[j][1] + v[j][2] * v[j][2] + v[j][3] * v[j][3];
        ss = wave_sum(ss);
        const float rinv = rsqrtf(ss * (1.f / D) + EPS);
        if (mode == 2) {
#pragma unroll
            for (int j = 0; j < 4; ++j) {
                const int k = 4 * (64 * j + lane); const v4f g = *(const v4f*)(p.final_norm + k);
                __builtin_nontemporal_store(v[j] * rinv * g, (v4f*)(p.out + (size_t)row * D) + 64 * j + lane);
            }
            continue;
        }
        const float* gn = (mode == 0 ? p.norm_mix : p.norm_ffn) + layer * D;
        const float* mv = w.mods + ((size_t)layer * 9 + r) * (NMOD * D) + (mode == 0 ? 0 : 3 * D);
        float hv[16];
#pragma unroll
        for (int j = 0; j < 4; ++j) {
            const int k = 4 * (64 * j + lane);
            const v4f g = *(const v4f*)(gn + k), sh = *(const v4f*)(mv + k), sc = *(const v4f*)(mv + D + k);
            const v4f hh = v[j] * rinv * g * (1.f + sc) + sh;
            hv[4 * j + 0] = hh[0]; hv[4 * j + 1] = hh[1]; hv[4 * j + 2] = hh[2]; hv[4 * j + 3] = hh[3];
            uint2 o; o.x = (unsigned)f2bf(hv[4 * j]) | ((unsigned)f2bf(hv[4 * j + 1]) << 16); o.y = (unsigned)f2bf(hv[4 * j + 2]) | ((unsigned)f2bf(hv[4 * j + 3]) << 16);
            *(uint2*)(w.H + (size_t)row * D + k) = o;
        }
        if (mode == 1) {
            float lg[NE];
#pragma unroll
            for (int e = 0; e < NE; ++e) lg[e] = 0.f;
#pragma unroll
            for (int j = 0; j < 4; ++j) {
                v4f tw[16];
#pragma unroll
                for (int qe = 0; qe < 16; ++qe) tw[qe] = rwl[(j * 16 + qe) * 64 + lane];
                __builtin_amdgcn_sched_barrier(0);
#pragma unroll
                for (int q = 0; q < 4; ++q) {
                    const float hh = hv[4 * j + q];
#pragma unroll
                    for (int e4 = 0; e4 < 4; ++e4) { const v4f t = tw[q * 4 + e4]; lg[4 * e4] += hh * t[0]; lg[4 * e4 + 1] += hh * t[1]; lg[4 * e4 + 2] += hh * t[2]; lg[4 * e4 + 3] += hh * t[3]; }
                }
            }
            {
                const bool b5 = (lane & 32) != 0, b4 = (lane & 16) != 0, b3 = (lane & 8) != 0, b2 = (lane & 4) != 0;
                float a8[8], a4[4], a2[2];
#pragma unroll
                for (int j = 0; j < 8; ++j) { const float keep = b5 ? lg[j + 8] : lg[j], send = b5 ? lg[j] : lg[j + 8]; a8[j] = keep + __shfl_xor(send, 32); }
#pragma unroll
                for (int j = 0; j < 4; ++j) { const float keep = b4 ? a8[j + 4] : a8[j], send = b4 ? a8[j] : a8[j + 4]; a4[j] = keep + __shfl_xor(send, 16); }
#pragma unroll
                for (int j = 0; j < 2; ++j) { const float keep = b3 ? a4[j + 2] : a4[j], send = b3 ? a4[j] : a4[j + 2]; a2[j] = keep + __shfl_xor(send, 8); }
                float a1 = (b2 ? a2[1] : a2[0]) + __shfl_xor(b2 ? a2[0] : a2[1], 4);
                a1 += __shfl_xor(a1, 2); a1 += __shfl_xor(a1, 1);
                if ((lane & 3) == 0) ((NLAS float*)lgb)[(row - chunk0) * 16 + (lane >> 2)] = a1;
            }
        }
    }
    if (mode == 1) {
        __syncthreads();
        const int row = chunk0 + tid; const bool act = (tid < rpb && row < nrows);
        int i1 = 0, i2 = 0; unsigned lp1 = 0, lp2 = 0; float w1 = 0.f, w2 = 0.f;
        if (act) {
            float sc[NE], sel[NE];
#pragma unroll
            for (int e4 = 0; e4 < 4; ++e4) { const v4f t = lgb[tid * 4 + e4];
#pragma unroll
                for (int q = 0; q < 4; ++q) { const int e = 4 * e4 + q; sc[e] = 1.f / (1.f + expf(-t[q])); sel[e] = sc[e] + p.router_b[e]; } }
            int bg = 0; float bgs = -INFINITY;
#pragma unroll
            for (int g = 0; g < 4; ++g) {
                float m1 = -INFINITY, m2 = -INFINITY;
#pragma unroll
                for (int q = 0; q < 4; ++q) { const float t = sel[4 * g + q]; if (t > m1) { m2 = m1; m1 = t; } else if (t > m2) m2 = t; }
                const float gs = m1 + m2;
                if (gs > bgs) { bgs = gs; bg = g; }
            }
            float m1 = -INFINITY, m2 = -INFINITY;
#pragma unroll
            for (int g = 0; g < 4; ++g) {
                if (g == bg) {
#pragma unroll
                    for (int q = 0; q < 4; ++q) { const float t = sel[4 * g + q]; if (t > m1) { m2 = m1; i2 = i1; m1 = t; i1 = 4 * g + q; } else if (t > m2) { m2 = t; i2 = 4 * g + q; } }
                }
            }
            float s1 = 0.f, s2 = 0.f;
#pragma unroll
            for (int e = 0; e < NE; ++e) { if (e == i1) s1 = sc[e]; if (e == i2) s2 = sc[e]; }
            const float inv = 1.f / (s1 + s2); w1 = s1 * inv; w2 = s2 * inv;
            lp1 = __hip_atomic_fetch_add(lcnt + i1, 1u, __ATOMIC_RELAXED, __HIP_MEMORY_SCOPE_WORKGROUP);
            lp2 = __hip_atomic_fetch_add(lcnt + i2, 1u, __ATOMIC_RELAXED, __HIP_MEMORY_SCOPE_WORKGROUP);
        }
        __syncthreads();
        if (tid < NE) lcnt[16 + tid] = atomicAdd(w.ctl + CW_CNT + (layer * NE + tid) * 64, lcnt[tid]);
        __syncthreads();
        if (act) {
            const int p1 = (int)(lcnt[16 + i1] + lp1), p2 = (int)(lcnt[16 + i2] + lp2);
            w.list[(size_t)i1 * NTOK + p1] = row; w.list[(size_t)i2 * NTOK + p2] = row;
            w.toki[row] = make_int4(i1, p1, i2, p2); w.tokw[row] = make_float2(w1, w2);
        }
        __syncthreads();
    }
#undef NLAS
}

#define LAS __attribute__((address_space(3)))
#define GAS __attribute__((address_space(1)))
typedef short bf16x8 __attribute__((ext_vector_type(8)));
typedef float f32x4 __attribute__((ext_vector_type(4)));
typedef unsigned u32x4 __attribute__((ext_vector_type(4)));
typedef unsigned u32x2 __attribute__((ext_vector_type(2)));

constexpr int RING_BYTES = 131072;
constexpr int LDSCTL_OFF = RING_BYTES, MISC_OFF = LDSCTL_OFF + 320, TILETAB_OFF = LDSCTL_OFF + 1024, STASH_OFF = LDSCTL_OFF + 4096;
constexpr int LDS_BYTES = 147456;

__device__ __forceinline__ unsigned cvt_pk_bf16(float lo, float hi) { unsigned r; asm volatile("v_cvt_pk_bf16_f32 %0, %1, %2" : "=v"(r) : "v"(lo), "v"(hi)); return r; }

namespace pg8 {
constexpr int BM = 256, BK = 64, HALF = 128, HTB = HALF * BK * 2, STAGE_BYTES = 8 * HTB, NXCD = 8, WGM = 8;
__host__ __device__ __forceinline__ int lds_byte(int r, int c) { const int st = (r >> 4) * 2 + (c >> 5), rr = r & 15, cc = c & 31, ob = rr * 64 + cc * 2; return st * 1024 + (ob ^ (((ob >> 9) & 1) << 5)); }
__host__ __device__ __forceinline__ void stage_rc(int b, int& R, int& C) { const int st = b / 1024, sb = b % 1024, swz = sb ^ (((sb >> 9) & 1) << 5); R = (st >> 1) * 16 + swz / 64; C = (st & 1) * 32 + (swz % 64) / 2; }
__host__ __device__ __forceinline__ int perm32(int rho) { const int n = rho >> 4, i = rho & 15; return 8 * (i >> 2) + 4 * n + (i & 3); }

struct Unit { int pm, pn, kind, aux; const char* a; const char* b; const int* lst; int valid; };
__device__ __forceinline__ void tile_order(int L, int nM, int nN, int& pm, int& pn) {
    const int nwg = nM * nN; int wgid = L;
    { const int q = nwg / NXCD, r = nwg % NXCD, xcd = wgid % NXCD, off = wgid / NXCD; wgid = (xcd < r ? xcd * (q + 1) : r * (q + 1) + (xcd - r) * q) + off; }
    const int nig = WGM * nN, gid = wgid / nig, fm = gid * WGM, gsz = (nM - fm) < WGM ? (nM - fm) : WGM;
    pm = fm + ((wgid % nig) % gsz); pn = (wgid % nig) / gsz;
}

template <class Epi, class Sched, bool ALIGN_EPI, bool SP2>
__device__ __forceinline__ void gemm_phase(LAS unsigned char* lds, const int K, const Sched& S, const Epi& E) {
    const int tid = tidx(), wid = __builtin_amdgcn_readfirstlane(tid >> 6), lane = tid & 63, wr = wid >> 2, wc = wid & 3, fr = lane & 15, fq = lane >> 4;
    const int nt = K / BK;
    unsigned voffB[2];
#pragma unroll
    for (int i = 0; i < 2; ++i) { int R, C; stage_rc(tid * 16 + i * 8192, R, C); const int Rb = Epi::PERM ? ((R & ~31) + perm32(R & 31)) : R; voffB[i] = (unsigned)(Rb * K + C) * 2u; }
#define PG8_AOFF(u, h, i) ([&]() { int R_, C_; stage_rc(tid * 16 + (i) * 8192, R_, C_); return S.a_off((u), (h), R_, C_, K); }())
    const size_t kstep = (size_t)(BK * 2);
    const size_t hstep = (size_t)HALF * K * 2;
    const unsigned ldsw = (unsigned)wid * 1024u;
    const int aoff = lds_byte(wr * 64 + fr, fq * 8), boff = lds_byte(wc * 32 + fr, fq * 8);
#define PG8_SA(b, h) (((b) * 2 + (h)) * HTB)
#define PG8_SB(b, h) ((4 + (b) * 2 + (h)) * HTB)
#define PG8_STAGE(bufoff, gbase, voff) do { _Pragma("unroll") for (int _i = 0; _i < 2; ++_i) \
        __builtin_amdgcn_global_load_lds((const unsigned*)((const char*)(gbase) + (voff)[_i]), (LAS unsigned*)(lds + (bufoff) + ldsw + _i * 8192), 16, 0, 0); } while (0)
#define PG8_LDA(dst, b, h) do { _Pragma("unroll") for (int m = 0; m < 4; ++m) _Pragma("unroll") for (int k = 0; k < 2; ++k) dst[m][k] = *(const LAS bf16x8*)(lds + PG8_SA(b, h) + aoff + m * 2048 + k * 1024); } while (0)
#define PG8_LDB(dst, b, h) do { _Pragma("unroll") for (int n = 0; n < 2; ++n) _Pragma("unroll") for (int k = 0; k < 2; ++k) dst[n][k] = *(const LAS bf16x8*)(lds + PG8_SB(b, h) + boff + n * 2048 + k * 1024); } while (0)
#define PG8_MMA(ai, bj, At, Bt) do { __builtin_amdgcn_s_setprio(1); _Pragma("unroll") for (int m = 0; m < 4; ++m) _Pragma("unroll") for (int n = 0; n < 2; ++n) _Pragma("unroll") for (int k = 0; k < 2; ++k) \
        acc[ai][bj][m][n] = __builtin_amdgcn_mfma_f32_16x16x32_bf16(Bt[n][k], At[m][k], acc[ai][bj][m][n], 0, 0, 0); __builtin_amdgcn_s_setprio(0); } while (0)
#define PG8_WAIT_V(n) asm volatile("s_waitcnt vmcnt(" #n ")" ::: "memory")
#define PG8_WAIT_L(n) asm volatile("s_waitcnt lgkmcnt(" #n ")" ::: "memory")
#define PG8_BAR __builtin_amdgcn_s_barrier()
#define PG8_SCHED __builtin_amdgcn_sched_barrier(0)
    Unit cur, nxt; int ui = 0;
    if (!S.next(0, cur)) return;
    unsigned vAc[2][2];
#define PG8_STASH ((LAS u32x4*)(lds + (STASH_OFF - 0)) + tid)
#pragma unroll
    for (int h = 0; h < 2; ++h)
#pragma unroll
        for (int i = 0; i < 2; ++i) vAc[h][i] = PG8_AOFF(cur, h, i);
    f32x4 acc[2][2][4][2];
#pragma unroll
    for (int a = 0; a < 2; ++a)
#pragma unroll
        for (int b = 0; b < 2; ++b)
#pragma unroll
            for (int m = 0; m < 4; ++m)
#pragma unroll
                for (int n = 0; n < 2; ++n) acc[a][b][m][n] = (f32x4){0.f, 0.f, 0.f, 0.f};
    bf16x8 At[4][2], B0[2][2], B1[2][2];
    const char* cA = cur.a; const char* cB = cur.b;
    if constexpr (SP2) {
        PG8_STAGE(PG8_SB(0, 0), cB, voffB); PG8_STAGE(PG8_SB(0, 1), cB + hstep, voffB); PG8_STAGE(PG8_SA(0, 0), cA, vAc[0]); PG8_STAGE(PG8_SA(0, 1), cA, vAc[1]);
        if (wr == 1) PG8_BAR;
        PG8_WAIT_V(2); PG8_BAR;
        PG8_STAGE(PG8_SB(1, 0), cB + kstep, voffB); PG8_STAGE(PG8_SA(1, 0), cA + kstep, vAc[0]); PG8_STAGE(PG8_SB(1, 1), cB + hstep + kstep, voffB);
        PG8_WAIT_V(6); PG8_BAR;
    } else {
        PG8_STAGE(PG8_SB(0, 0), cB, voffB); PG8_STAGE(PG8_SA(0, 0), cA, vAc[0]); PG8_STAGE(PG8_SB(0, 1), cB + hstep, voffB); PG8_STAGE(PG8_SA(0, 1), cA, vAc[1]);
        if (wr == 1) PG8_BAR;
        PG8_WAIT_V(4); PG8_BAR;
        PG8_STAGE(PG8_SB(1, 0), cB + kstep, voffB); PG8_STAGE(PG8_SA(1, 0), cA + kstep, vAc[0]); PG8_STAGE(PG8_SB(1, 1), cB + hstep + kstep, voffB);
        PG8_WAIT_V(6); PG8_BAR;
    }
    for (;;) {
        const bool has_next = S.next(ui + 1, nxt);
        const char* nA = has_next ? nxt.a : cA; const char* nB = has_next ? nxt.b : cB;
        if (Sched::GATHER && has_next) { u32x4 t4; t4.x = PG8_AOFF(nxt, 0, 0); t4.y = PG8_AOFF(nxt, 0, 1); t4.z = PG8_AOFF(nxt, 1, 0); t4.w = PG8_AOFF(nxt, 1, 1); *PG8_STASH = t4; }
        for (int t = 0; t < nt; t += 2) {
            const bool last = (t == nt - 2);
            const char* a1 = cA + (size_t)(t + 1) * kstep;
            const char* a2 = last ? nA : cA + (size_t)(t + 2) * kstep; const char* b2 = last ? nB : cB + (size_t)(t + 2) * kstep;
            const char* a3 = a2 + kstep; const char* b3 = b2 + kstep;
            if constexpr (SP2) {
            PG8_LDB(B0, 0, 0); PG8_LDB(B1, 0, 1); PG8_SCHED; PG8_LDA(At, 0, 0); PG8_STAGE(PG8_SA(1, 1), a1, vAc[1]);
            if (Sched::GATHER && last && has_next) { const u32x4 t4 = *PG8_STASH; vAc[0][0] = t4.x; vAc[0][1] = t4.y; vAc[1][0] = t4.z; vAc[1][1] = t4.w; }
            PG8_WAIT_V(8); PG8_WAIT_L(0); PG8_BAR; PG8_MMA(0, 0, At, B0); PG8_MMA(0, 1, At, B1); PG8_BAR; PG8_SCHED;
            PG8_LDA(At, 0, 1); PG8_STAGE(PG8_SB(0, 0), b2, voffB); PG8_STAGE(PG8_SB(0, 1), b2 + hstep, voffB); PG8_STAGE(PG8_SA(0, 0), a2, vAc[0]);
            PG8_WAIT_V(8); PG8_WAIT_L(0); PG8_BAR; PG8_MMA(1, 0, At, B0); PG8_MMA(1, 1, At, B1); PG8_BAR; PG8_SCHED;
            PG8_LDB(B0, 1, 0); PG8_LDB(B1, 1, 1); PG8_SCHED; PG8_LDA(At, 1, 0); PG8_STAGE(PG8_SA(0, 1), a2, vAc[1]);
            PG8_WAIT_V(8); PG8_WAIT_L(0); PG8_BAR; PG8_MMA(0, 0, At, B0); PG8_MMA(0, 1, At, B1); PG8_BAR; PG8_SCHED;
            PG8_LDA(At, 1, 1); PG8_STAGE(PG8_SB(1, 0), b3, voffB); PG8_STAGE(PG8_SB(1, 1), b3 + hstep, voffB); PG8_STAGE(PG8_SA(1, 0), a3, vAc[0]);
            PG8_WAIT_V(8); PG8_WAIT_L(0); PG8_BAR; PG8_MMA(1, 0, At, B0); PG8_MMA(1, 1, At, B1); PG8_BAR; PG8_SCHED;
            } else {
            PG8_LDB(B0, 0, 0); PG8_SCHED; PG8_LDA(At, 0, 0); PG8_STAGE(PG8_SA(1, 1), a1, vAc[1]);
            if (Sched::GATHER && last && has_next) { const u32x4 t4 = *PG8_STASH; vAc[0][0] = t4.x; vAc[0][1] = t4.y; vAc[1][0] = t4.z; vAc[1][1] = t4.w; }
            PG8_WAIT_L(8); PG8_BAR; PG8_WAIT_L(0); PG8_MMA(0, 0, At, B0); PG8_BAR; PG8_SCHED;
            PG8_LDB(B1, 0, 1); PG8_STAGE(PG8_SB(0, 0), b2, voffB);
            PG8_BAR; PG8_WAIT_L(0); PG8_MMA(0, 1, At, B1); PG8_BAR;
            PG8_LDA(At, 0, 1); PG8_STAGE(PG8_SA(0, 0), a2, vAc[0]);
            PG8_BAR; PG8_WAIT_L(0); PG8_MMA(1, 0, At, B0); PG8_BAR; PG8_SCHED;
            PG8_STAGE(PG8_SB(0, 1), b2 + hstep, voffB);
            PG8_WAIT_V(6); PG8_BAR; PG8_MMA(1, 1, At, B1); PG8_BAR;
            PG8_LDB(B0, 1, 0); PG8_SCHED; PG8_LDA(At, 1, 0); PG8_STAGE(PG8_SA(0, 1), a2, vAc[1]);
            PG8_WAIT_L(8); PG8_BAR; PG8_WAIT_L(0); PG8_MMA(0, 0, At, B0); PG8_BAR; PG8_SCHED;
            PG8_LDB(B1, 1, 1); PG8_STAGE(PG8_SB(1, 0), b3, voffB);
            PG8_BAR; PG8_WAIT_L(0); PG8_MMA(0, 1, At, B1); PG8_BAR;
            PG8_LDA(At, 1, 1); PG8_STAGE(PG8_SA(1, 0), a3, vAc[0]);
            PG8_BAR; PG8_WAIT_L(0); PG8_MMA(1, 0, At, B0); PG8_BAR; PG8_SCHED;
            PG8_STAGE(PG8_SB(1, 1), b3 + hstep, voffB);
            PG8_WAIT_V(6); PG8_BAR; PG8_MMA(1, 1, At, B1); PG8_BAR;
            }
        }
        if constexpr (ALIGN_EPI) { if (wr == 0) PG8_BAR; }
        E(acc, cur, wr, wc, fr, fq);
        if (!has_next) break;
#pragma unroll
        for (int a = 0; a < 2; ++a)
#pragma unroll
            for (int b = 0; b < 2; ++b)
#pragma unroll
                for (int m = 0; m < 4; ++m)
#pragma unroll
                    for (int n = 0; n < 2; ++n) acc[a][b][m][n] = (f32x4){0.f, 0.f, 0.f, 0.f};
        cur = nxt; cA = nA; cB = nB; ++ui;
        if constexpr (ALIGN_EPI) { if (wr == 1) PG8_BAR; }
    }
    PG8_WAIT_V(0);
    if constexpr (!ALIGN_EPI) { if (wr == 0) PG8_BAR; }
    PG8_BAR;
#undef PG8_SA
#undef PG8_AOFF
#undef PG8_STASH
#undef PG8_SB
#undef PG8_STAGE
#undef PG8_LDA
#undef PG8_LDB
#undef PG8_MMA
#undef PG8_WAIT_V
#undef PG8_WAIT_L
#undef PG8_BAR
#undef PG8_SCHED
}
}

constexpr size_t TSTEP = (size_t)256 * D * 2;
struct SchedQKV {
    static constexpr bool GATHER = false;
    const char *H, *Wqk, *Wv; int G, c;
    __device__ __forceinline__ bool next(int i, pg8::Unit& u) const {
        const int L = i * G + c;
        if (L < 576) { pg8::tile_order(L, 72, 8, u.pm, u.pn); u.kind = 0; u.a = H + (size_t)u.pm * TSTEP; u.b = Wqk + (size_t)u.pn * TSTEP; return true; }
        if (L < 576 + 288) { pg8::tile_order(L - 576, 4, 72, u.pm, u.pn); u.kind = 1; u.a = Wv + (size_t)u.pm * TSTEP; u.b = H + (size_t)u.pn * TSTEP; return true; }
        return false;
    }
    __device__ __forceinline__ unsigned a_off(const pg8::Unit&, int h, int R, int C, int K) const { return (unsigned)((h * 128 + R) * K + C) * 2u; }
};
struct SchedDense {
    static constexpr bool GATHER = false;
    const char *A, *Bt; int nM, nN, G, c;
    __device__ __forceinline__ bool next(int i, pg8::Unit& u) const {
        const int L = i * G + c; if (L >= nM * nN) return false;
        pg8::tile_order(L, nM, nN, u.pm, u.pn); u.kind = 0; u.a = A + (size_t)u.pm * TSTEP; u.b = Bt + (size_t)u.pn * TSTEP; return true;
    }
    __device__ __forceinline__ unsigned a_off(const pg8::Unit&, int h, int R, int C, int K) const { return (unsigned)((h * 128 + R) * K + C) * 2u; }
};
template <bool GATHERT> struct SchedMoe {
    static constexpr bool GATHER = GATHERT;
    const char* A;
    const char* W;
    const int* list; const LAS unsigned* tab; int ntile, nN, G, c; size_t wofs;
    __device__ __forceinline__ bool next(int i, pg8::Unit& u) const {
        const int L = i * G + c; if (L >= ntile * nN) return false;
        const int mt = L / nN; u.pn = L % nN; u.pm = mt; u.kind = 0;
        const unsigned t0 = __builtin_amdgcn_readfirstlane(tab[2 * mt]), t1 = __builtin_amdgcn_readfirstlane(tab[2 * mt + 1]);
        const int e = (int)(t0 >> 20), first = (int)(t0 & 0xfffff);
        u.aux = e; u.valid = (int)t1; u.lst = list + (size_t)e * NTOK + first;
        u.a = GATHERT ? A : A + (size_t)mt * TSTEP;
        u.b = W + (size_t)e * WE_BYTES + wofs + (size_t)u.pn * TSTEP;
        return true;
    }
    __device__ __forceinline__ unsigned a_off(const pg8::Unit& u, int h, int R, int C, int K) const {
        const int rr = h * 128 + R;
        if (!GATHERT) return (unsigned)(rr * K + C) * 2u;
        const int tok = (rr < u.valid) ? u.lst[rr] : 0;
        return (unsigned)(tok * K + C) * 2u;
    }
};

struct EpiQKV {
    static constexpr bool PERM = true;
    bf16_t* QK; bf16_t* VT; const float* rcos; const float* rsin; bool rope;
    __device__ __forceinline__ void operator()(const f32x4 (&acc)[2][2][4][2], const pg8::Unit& u, int wr, int wc, int fr, int fq) const {
        if (u.kind == 0) {
            const float sc = (u.pn < 4) ? QSCALE : 1.f;
            const bool do_rope = rope && (u.pm * 256 < NLAT);
#pragma unroll
            for (int ai = 0; ai < 2; ++ai)
#pragma unroll
                for (int m = 0; m < 4; ++m) {
                    const int row = u.pm * 256 + ai * 128 + wr * 64 + m * 16 + fr;
                    f32x4 v[2][2];
#pragma unroll
                    for (int bj = 0; bj < 2; ++bj)
#pragma unroll
                        for (int n = 0; n < 2; ++n) v[bj][n] = acc[ai][bj][m][n] * sc;
                    if (do_rope) {
                        const int t = row & (SEQ - 1);
#pragma unroll
                        for (int n = 0; n < 2; ++n) {
                            const f32x4 cs = *(const f32x4*)(rcos + t * 32 + 8 * fq + 4 * n), sn = *(const f32x4*)(rsin + t * 32 + 8 * fq + 4 * n);
                            const f32x4 x1 = v[0][n], x2 = v[1][n];
                            v[0][n] = x1 * cs - x2 * sn; v[1][n] = x1 * sn + x2 * cs;
                        }
                    }
                    bf16_t* rowp = QK + (size_t)row * 2048 + u.pn * 256 + wc * 64 + 8 * fq;
#pragma unroll
                    for (int bj = 0; bj < 2; ++bj) {
                        u32x4 o; o.x = cvt_pk_bf16(v[bj][0][0], v[bj][0][1]); o.y = cvt_pk_bf16(v[bj][0][2], v[bj][0][3]); o.z = cvt_pk_bf16(v[bj][1][0], v[bj][1][1]); o.w = cvt_pk_bf16(v[bj][1][2], v[bj][1][3]);
                        *(u32x4*)(rowp + bj * 32) = o;
                    }
                }
        } else {
#pragma unroll
            for (int ai = 0; ai < 2; ++ai)
#pragma unroll
                for (int m = 0; m < 4; ++m) {
                    const int row = u.pm * 256 + ai * 128 + wr * 64 + m * 16 + fr;
                    bf16_t* rowp = VT + (size_t)row * NTOK + u.pn * 256 + wc * 32 + 8 * fq;
#pragma unroll
                    for (int bj = 0; bj < 2; ++bj) {
                        const f32x4 v0 = acc[ai][bj][m][0], v1 = acc[ai][bj][m][1];
                        u32x4 o; o.x = cvt_pk_bf16(v0[0], v0[1]); o.y = cvt_pk_bf16(v0[2], v0[3]); o.z = cvt_pk_bf16(v1[0], v1[1]); o.w = cvt_pk_bf16(v1[2], v1[3]);
                        *(u32x4*)(rowp + bj * 128) = o;
                    }
                }
        }
    }
};
struct EpiWO {
    static constexpr bool PERM = false;
    const float* xin; const float* cin; float* X; const float* gate  ; bool from_input;
    __device__ __forceinline__ void operator()(const f32x4 (&acc)[2][2][4][2], const pg8::Unit& u, int wr, int wc, int fr, int fq) const {
        const int r = (u.pm * 256 < NLAT) ? (u.pm * 256) / SEQ : NB;
        const int col0 = u.pn * 256 + wc * 32 + 4 * fq;
        f32x4 g[2][2];
#pragma unroll
        for (int bj = 0; bj < 2; ++bj)
#pragma unroll
            for (int n = 0; n < 2; ++n) g[bj][n] = *(const f32x4*)(gate + (size_t)r * (NMOD * D) + col0 + bj * 128 + n * 16);
#pragma unroll
        for (int ai = 0; ai < 2; ++ai) {
            f32x4 bs[4][2][2];
#pragma unroll
            for (int m = 0; m < 4; ++m) {
                const int row = u.pm * 256 + ai * 128 + wr * 64 + m * 16 + fr;
                const float* base = from_input ? (row < NLAT ? xin + (size_t)row * D : cin + (size_t)(row - NLAT) * D) : X + (size_t)row * D;
#pragma unroll
                for (int bj = 0; bj < 2; ++bj)
#pragma unroll
                    for (int n = 0; n < 2; ++n) bs[m][bj][n] = *(const f32x4*)(base + col0 + bj * 128 + n * 16);
            }
#pragma unroll
            for (int m = 0; m < 4; ++m) {
                const int row = u.pm * 256 + ai * 128 + wr * 64 + m * 16 + fr;
                float* outp = X + (size_t)row * D;
#pragma unroll
                for (int bj = 0; bj < 2; ++bj)
#pragma unroll
                    for (int n = 0; n < 2; ++n) *(f32x4*)(outp + col0 + bj * 128 + n * 16) = bs[m][bj][n] + g[bj][n] * acc[ai][bj][m][n];
            }
            asm volatile("" ::: "memory");
        }
    }
};
struct EpiGLU {
    static constexpr bool PERM = true;
    bf16_t* ACT;
    __device__ __forceinline__ void operator()(const f32x4 (&acc)[2][2][4][2], const pg8::Unit& u, int wr, int wc, int fr, int fq) const {
#pragma unroll
        for (int ai = 0; ai < 2; ++ai)
#pragma unroll
            for (int m = 0; m < 4; ++m) {
                const int row = u.pm * 256 + ai * 128 + wr * 64 + m * 16 + fr;
                float t[8];
#pragma unroll
                for (int n = 0; n < 2; ++n)
#pragma unroll
                    for (int q = 0; q < 4; ++q) { const float a = acc[ai][0][m][n][q], b = acc[ai][1][m][n][q]; t[4 * n + q] = a * __builtin_amdgcn_rcpf(1.f + __builtin_amdgcn_exp2f(-a * LOG2E)) * b; }
                u32x4 o; o.x = cvt_pk_bf16(t[0], t[1]); o.y = cvt_pk_bf16(t[2], t[3]); o.z = cvt_pk_bf16(t[4], t[5]); o.w = cvt_pk_bf16(t[6], t[7]);
                *(u32x4*)(ACT + (size_t)row * D + u.pn * 128 + wc * 32 + 8 * fq) = o;
            }
    }
};
struct EpiDown {
    static constexpr bool PERM = true;
    bf16_t* Y;
    __device__ __forceinline__ void operator()(const f32x4 (&acc)[2][2][4][2], const pg8::Unit& u, int wr, int wc, int fr, int fq) const {
#pragma unroll
        for (int ai = 0; ai < 2; ++ai)
#pragma unroll
            for (int m = 0; m < 4; ++m) {
                const int row = u.pm * 256 + ai * 128 + wr * 64 + m * 16 + fr;
                bf16_t* rowp = Y + (size_t)row * D + u.pn * 256 + wc * 32 + 8 * fq;
#pragma unroll
                for (int bj = 0; bj < 2; ++bj) {
                    const f32x4 v0 = acc[ai][bj][m][0], v1 = acc[ai][bj][m][1];
                    u32x4 o; o.x = cvt_pk_bf16(v0[0], v0[1]); o.y = cvt_pk_bf16(v0[2], v0[3]); o.z = cvt_pk_bf16(v1[0], v1[1]); o.w = cvt_pk_bf16(v1[2], v1[3]);
                    *(u32x4*)(rowp + bj * 128) = o;
                }
            }
    }
};

__device__ __forceinline__ unsigned pk2_rne(float lo, float hi) { return (unsigned)f2bf(lo) | ((unsigned)f2bf(hi) << 16); }
__device__ __forceinline__ void conv_item(const float* W, int ldw, int k0, int n0, bf16_t* WT, int drow0, LAS float* scr, int lane) {
    float t[32];
    const float* src = W + (size_t)(k0 + (lane >> 5)) * ldw + n0 + (lane & 31);
#pragma unroll
    for (int i = 0; i < 32; ++i) t[i] = __builtin_nontemporal_load(src + (size_t)(2 * i) * ldw);
#pragma unroll
    for (int i = 0; i < 32; ++i) scr[(2 * i + (lane >> 5)) * 33 + (lane & 31)] = t[i];
    asm volatile("s_waitcnt lgkmcnt(0)" ::: "memory");
    const int c = lane & 7;
#pragma unroll
    for (int j = 0; j < 4; ++j) { const int n = (lane >> 3) + 8 * j; const LAS float* s = scr + (8 * c) * 33 + n;
        u32x4 o; o.x = pk2_rne(s[0 * 33], s[1 * 33]); o.y = pk2_rne(s[2 * 33], s[3 * 33]); o.z = pk2_rne(s[4 * 33], s[5 * 33]); o.w = pk2_rne(s[6 * 33], s[7 * 33]);
        __builtin_nontemporal_store(o, (u32x4*)(WT + (size_t)(drow0 + n) * D + k0 + 8 * c)); }
    asm volatile("s_waitcnt lgkmcnt(0)" ::: "memory");
}
constexpr int CONV_QKV = 16 * 96, CONV_O = 16 * 32, CONV_E = 16 * 32, CONV_LAYER = CONV_QKV + CONV_O + NE * 3 * CONV_E;
__device__ __forceinline__ void conv_layer_item(const Params& p, unsigned char* ws, int l, int r, LAS float* scr, int lane) {
    unsigned char* wl = ws + WS_W + (size_t)l * WL_BYTES;
    if (r < CONV_QKV) {
        const int kb = r / 96, nb = r % 96, n0 = nb * 32;
        if (n0 < 2048) { const int pn = n0 >> 8, a = n0 & 255, hd = a >> 6, half = (a >> 5) & 1;
            conv_item(p.w_qkv + (size_t)l * D * 3072, 3072, kb * 64, n0, (bf16_t*)(wl + WO_QK), pn * 256 + half * 128 + hd * 32, scr, lane); }
        else conv_item(p.w_qkv + (size_t)l * D * 3072, 3072, kb * 64, n0, (bf16_t*)(wl + WO_V), n0 - 2048, scr, lane);
        return;
    }
    r -= CONV_QKV;
    if (r < CONV_O) { const int kb = r / 32, nb = r % 32; conv_item(p.w_o + (size_t)l * D * D, D, kb * 64, nb * 32, (bf16_t*)(wl + WO_O), nb * 32, scr, lane); return; }
    r -= CONV_O;
    const int e = r / (3 * CONV_E), r2 = r % (3 * CONV_E), which = r2 / CONV_E, r3 = r2 % CONV_E, kb = r3 / 32, nb = r3 % 32, n0 = nb * 32;
    unsigned char* we = wl + WO_E + (size_t)e * WE_BYTES;
    const size_t eo = ((size_t)l * NE + e) * D * D;
    if (which == 0) conv_item(p.wg + eo, D, kb * 64, n0, (bf16_t*)we, (n0 >> 7) * 256 + (n0 & 127), scr, lane);
    else if (which == 1) conv_item(p.wu + eo, D, kb * 64, n0, (bf16_t*)we, (n0 >> 7) * 256 + 128 + (n0 & 127), scr, lane);
    else conv_item(p.wd + eo, D, kb * 64, n0, (bf16_t*)(we + WE_2), n0, scr, lane);
}
__device__ __forceinline__ void phase_convert(const Params& p, unsigned char* ws, LAS unsigned char* lds, int layer_lo, int layer_hi) {
    const int tid = tidx(), lane = tid & 63, wave = tid >> 6;
    LAS float* scr = (LAS float*)(lds + wave * 16384);
    const int gw = bidx() * NWAVE + wave, ngw = gridDim.x * NWAVE;
    for (int it = layer_lo * CONV_LAYER + gw; it < layer_hi * CONV_LAYER; it += ngw) conv_layer_item(p, ws, it / CONV_LAYER, it % CONV_LAYER, scr, lane);
}
constexpr int CONV_CHUNK = 4, CW_CONVQ = 6144;
__device__ __forceinline__ void convert_pull(const Params& p, unsigned char* ws, LAS unsigned char* lds, int l, int budget) {
    if (l >= DEPTH) return;
    const int tid = tidx(), lane = tid & 63, wave = tid >> 6;
    LAS float* scr = (LAS float*)(lds + wave * 16384);
    volatile LAS unsigned* slot = (volatile LAS unsigned*)(lds + MISC_OFF + 96);
    unsigned* q = (unsigned*)(ws + WS_CTL) + CW_CONVQ + 64 * l;
    for (int c = 0; budget < 0 || c < budget; ++c) {
        if (tid == 0) *slot = __hip_atomic_fetch_add(q, (unsigned)(CONV_CHUNK * NWAVE), __ATOMIC_RELAXED, __HIP_MEMORY_SCOPE_AGENT);
        __syncthreads();
        const unsigned base = *slot;
        __syncthreads();
        if (base >= (unsigned)CONV_LAYER) break;
        for (int k = 0; k < CONV_CHUNK; ++k) conv_layer_item(p, ws, l, (int)base + wave * CONV_CHUNK + k, scr, lane);
    }
}

__device__ __forceinline__ int build_tile_table(const Ws& w, int layer, LAS unsigned* tab) {
    int cnt[NE], off[NE + 1];
    expert_offsets(w, layer, cnt, off);
    const int tid = tidx();
    if (tid < 256) {
        int e = -1;
#pragma unroll
        for (int q = 0; q < NE; ++q) if (tid * 256 >= off[q] && tid * 256 < off[q + 1]) e = q;
        int oe = 0, ce = 0;
#pragma unroll
        for (int q = 0; q < NE; ++q) if (q == e) { oe = off[q]; ce = cnt[q]; }
        if (e >= 0) { const int first = tid * 256 - oe; const int valid = min(256, ce - first);
            tab[2 * tid] = ((unsigned)e << 20) | (unsigned)first; tab[2 * tid + 1] = (unsigned)valid; }
    }
    __syncthreads();
    return off[NE] / 256;
}

namespace att {
typedef float f32x16 __attribute__((ext_vector_type(16)));
constexpr int STAGE_B = 32768, K_OFF = 0, V_OFF = 16384, RPB_OFF = 65536, RPB_W = 144, XCH_OFF = 0;
__device__ __forceinline__ int swz(int row, int chunk) { return row * 128 + ((chunk ^ ((row >> 1) & 7)) << 4); }
__device__ __forceinline__ int pi64(int r) { return (r & ~12) | ((r & 4) << 1) | ((r & 8) >> 1); }

template <int DV, int NKSUB> struct Stage { u32x4 k[NKSUB]; u32x4 v[DV / 64]; };

template <int DV, int NKSUB>
__device__ __forceinline__ void stage_load(Stage<DV, NKSUB>& st, const bf16_t* QK, const bf16_t* VT, int tok0, int kcolbase, int vch0, int tid) {
#pragma unroll
    for (int i = 0; i < NKSUB; ++i) { const int idx = tid + NTHR * i, row = idx / (8 * NKSUB), cc = idx % (8 * NKSUB);
        st.k[i] = *(const u32x4*)(QK + (size_t)(tok0 + row) * 2048 + 1024 + kcolbase + cc * 8); }
#pragma unroll
    for (int i = 0; i < DV / 64; ++i) { const int idx = tid + NTHR * i, row = idx >> 3, ch = idx & 7;
        st.v[i] = *(const u32x4*)(VT + (size_t)(vch0 + row) * NTOK + tok0 + ch * 8); }
}
template <int DV, int NKSUB>
__device__ __forceinline__ void stage_store(const Stage<DV, NKSUB>& st, LAS unsigned char* buf, int tid) {
#pragma unroll
    for (int i = 0; i < NKSUB; ++i) { const int idx = tid + NTHR * i, row = idx / (8 * NKSUB), cc = idx % (8 * NKSUB), sub = cc >> 3, ch = cc & 7;
        *(LAS u32x4*)(buf + K_OFF + sub * 8192 + swz(pi64(row), ch)) = st.k[i]; }
#pragma unroll
    for (int i = 0; i < DV / 64; ++i) { const int idx = tid + NTHR * i, row = idx >> 3, ch = idx & 7;
        *(LAS u32x4*)(buf + V_OFF + swz(row, ch)) = st.v[i]; }
}

__device__ __forceinline__ void stage_store_nat(const Stage<64, 1>& st, LAS unsigned char* buf, int tid) {
    { const int row = tid >> 3, ch = tid & 7; *(LAS u32x4*)(buf + K_OFF + swz(row, ch)) = st.k[0]; }
    { const int row = tid >> 3, ch = tid & 7; *(LAS u32x4*)(buf + V_OFF + swz(row, ch)) = st.v[0]; }
}
constexpr float ATT_THR = 8.f;
#ifndef ATT_PRIO
#define ATT_PRIO 1
#endif
template <int DV, bool BIAS>
__device__ __forceinline__ void qk_softmax(const LAS unsigned char* kb, const bf16x8 (&qf)[4], f32x16 (&o)[DV / 32], float& mref, float& l, bool& started,
                                           const float (&pen)[32], const LAS float* brow, int r, int h, bf16x8 (&pb)[4]) {
    f32x16 p0, p1;
#pragma unroll
    for (int i = 0; i < 16; ++i) { p0[i] = -mref; p1[i] = -mref; }
    bf16x8 kfa[4], kfb[4];
#pragma unroll
    for (int s = 0; s < 2; ++s) { kfa[2 * s] = *(const LAS bf16x8*)(kb + swz(r, 2 * s + h)); kfa[2 * s + 1] = *(const LAS bf16x8*)(kb + swz(32 + r, 2 * s + h)); }
#pragma unroll
    for (int s = 2; s < 4; ++s) { kfb[2 * (s - 2)] = *(const LAS bf16x8*)(kb + swz(r, 2 * s + h)); kfb[2 * (s - 2) + 1] = *(const LAS bf16x8*)(kb + swz(32 + r, 2 * s + h)); }
    __builtin_amdgcn_sched_barrier(0);
    if (ATT_PRIO) __builtin_amdgcn_s_setprio(1);
#pragma unroll
    for (int s = 0; s < 2; ++s) { p0 = __builtin_amdgcn_mfma_f32_32x32x16_bf16(kfa[2 * s], qf[s], p0, 0, 0, 0); p1 = __builtin_amdgcn_mfma_f32_32x32x16_bf16(kfa[2 * s + 1], qf[s], p1, 0, 0, 0); }
#pragma unroll
    for (int s = 2; s < 4; ++s) { p0 = __builtin_amdgcn_mfma_f32_32x32x16_bf16(kfb[2 * (s - 2)], qf[s], p0, 0, 0, 0); p1 = __builtin_amdgcn_mfma_f32_32x32x16_bf16(kfb[2 * (s - 2) + 1], qf[s], p1, 0, 0, 0); }
    if (ATT_PRIO) __builtin_amdgcn_s_setprio(0);
    __builtin_amdgcn_sched_barrier(0);
    if (BIAS) {
#pragma unroll
        for (int i = 0; i < 16; ++i) { const int kcl = 16 * (i >> 3) + (i & 7);
            p0[i] = (p0[i] + pen[i]) + brow[kcl]; p1[i] = (p1[i] + pen[16 + i]) + brow[32 + kcl]; }
    }
    float ma = fmaxf(fmaxf(p0[0], p0[1]), p1[0]), mb = fmaxf(fmaxf(p0[2], p0[3]), p1[1]);
    ma = fmaxf(fmaxf(ma, p1[2]), p1[3]);
#pragma unroll
    for (int i = 4; i < 16; i += 4) { ma = fmaxf(fmaxf(ma, p0[i]), p0[i + 1]); mb = fmaxf(fmaxf(mb, p0[i + 2]), p0[i + 3]); ma = fmaxf(fmaxf(ma, p1[i]), p1[i + 1]); mb = fmaxf(fmaxf(mb, p1[i + 2]), p1[i + 3]); }
    float mx = fmaxf(ma, mb);
    mx = fmaxf(mx, __shfl_xor(mx, 32));
    const bool need = (!started && mx > -INFINITY) || (mx > ATT_THR);
    if (__any(need)) {
        const float delta = need ? (started ? fmaxf(mx, 0.f) : mx) : 0.f;
        const float alpha = started ? __builtin_amdgcn_exp2f(-delta) : 1.f;
        started = started || need;
        mref += delta;
#pragma unroll
        for (int i = 0; i < 16; ++i) { p0[i] -= delta; p1[i] -= delta; }
        l *= alpha;
#pragma unroll
        for (int b = 0; b < DV / 32; ++b)
#pragma unroll
            for (int i = 0; i < 16; ++i) o[b][i] *= alpha;
    }
    float rs = 0.f;
#pragma unroll
    for (int i = 0; i < 16; ++i) { p0[i] = __builtin_amdgcn_exp2f(p0[i]); p1[i] = __builtin_amdgcn_exp2f(p1[i]); rs += p0[i] + p1[i]; }
    l += rs;
#pragma unroll
    for (int ks = 0; ks < 4; ++ks) {
        u32x4 t;
        if (ks < 2) { t.x = cvt_pk_bf16(p0[8 * ks + 0], p0[8 * ks + 1]); t.y = cvt_pk_bf16(p0[8 * ks + 2], p0[8 * ks + 3]); t.z = cvt_pk_bf16(p0[8 * ks + 4], p0[8 * ks + 5]); t.w = cvt_pk_bf16(p0[8 * ks + 6], p0[8 * ks + 7]); }
        else { const int q = ks - 2; t.x = cvt_pk_bf16(p1[8 * q + 0], p1[8 * q + 1]); t.y = cvt_pk_bf16(p1[8 * q + 2], p1[8 * q + 3]); t.z = cvt_pk_bf16(p1[8 * q + 4], p1[8 * q + 5]); t.w = cvt_pk_bf16(p1[8 * q + 6], p1[8 * q + 7]); }
        pb[ks] = __builtin_bit_cast(bf16x8, t);
    }
}
template <int DV>
__device__ __forceinline__ void pv_accum(const LAS unsigned char* vb, const bf16x8 (&pb)[4], f32x16 (&o)[DV / 32], int r, int h) {
    bf16x8 vfa[4], vfb[4];
#pragma unroll
    for (int ks = 0; ks < 4; ++ks) vfa[ks] = *(const LAS bf16x8*)(vb + swz(r, 2 * ks + h));
#pragma unroll
    for (int b = 0; b < DV / 32; b += 2) {
        if (b + 1 < DV / 32) {
#pragma unroll
            for (int ks = 0; ks < 4; ++ks) vfb[ks] = *(const LAS bf16x8*)(vb + swz(32 * (b + 1) + r, 2 * ks + h));
        }
        __builtin_amdgcn_sched_barrier(0);
        if (ATT_PRIO) __builtin_amdgcn_s_setprio(1);
#pragma unroll
        for (int ks = 0; ks < 4; ++ks) o[b] = __builtin_amdgcn_mfma_f32_32x32x16_bf16(vfa[ks], pb[ks], o[b], 0, 0, 0);
        if (ATT_PRIO) __builtin_amdgcn_s_setprio(0);
        if (b + 2 < DV / 32) {
#pragma unroll
            for (int ks = 0; ks < 4; ++ks) vfa[ks] = *(const LAS bf16x8*)(vb + swz(32 * (b + 2) + r, 2 * ks + h));
        }
        __builtin_amdgcn_sched_barrier(0);
        if (b + 1 < DV / 32) {
            if (ATT_PRIO) __builtin_amdgcn_s_setprio(1);
#pragma unroll
            for (int ks = 0; ks < 4; ++ks) o[b + 1] = __builtin_amdgcn_mfma_f32_32x32x16_bf16(vfb[ks], pb[ks], o[b + 1], 0, 0, 0);
            if (ATT_PRIO) __builtin_amdgcn_s_setprio(0);
        }
    }
}
template <int DV, bool BIAS>
__device__ __forceinline__ void tile_compute(const LAS unsigned char* buf, int ksub, const bf16x8 (&qf)[4], f32x16 (&o)[DV / 32], float& mref, float& l, bool& started,
                                             const float (&pen)[32], const LAS float* brow, int r, int h) {
    bf16x8 pb[4];
    qk_softmax<DV, BIAS>(buf + K_OFF + ksub * 8192, qf, o, mref, l, started, pen, brow, r, h, pb);
    __builtin_amdgcn_sched_barrier(0);
    pv_accum<DV>(buf + V_OFF, pb, o, r, h);
}

__device__ __forceinline__ void band_tile32(const LAS unsigned char* buf, int x0, const bf16x8 (&qf)[4], f32x16 (&o)[2], float& mref, float& l, bool& started,
                                            const float (&pen16)[16], const LAS float* brow, int r, int h) {
    f32x16 p0;
#pragma unroll
    for (int i = 0; i < 16; ++i) p0[i] = -mref;
    const LAS unsigned char* kb = buf + K_OFF; const LAS unsigned char* vb = buf + V_OFF;
    const int krow = x0 + pi64(r);
    bf16x8 kf[4];
#pragma unroll
    for (int s = 0; s < 4; ++s) kf[s] = *(const LAS bf16x8*)(kb + swz(krow, 2 * s + h));
    __builtin_amdgcn_sched_barrier(0);
    if (ATT_PRIO) __builtin_amdgcn_s_setprio(1);
#pragma unroll
    for (int s = 0; s < 4; ++s) p0 = __builtin_amdgcn_mfma_f32_32x32x16_bf16(kf[s], qf[s], p0, 0, 0, 0);
    if (ATT_PRIO) __builtin_amdgcn_s_setprio(0);
    const int vch = (x0 >> 3) + h;
    bf16x8 vf[4];
#pragma unroll
    for (int b = 0; b < 2; ++b)
#pragma unroll
        for (int ks = 0; ks < 2; ++ks) vf[2 * b + ks] = *(const LAS bf16x8*)(vb + swz(32 * b + r, vch + 2 * ks));
    __builtin_amdgcn_sched_barrier(0);
#pragma unroll
    for (int i = 0; i < 16; ++i) p0[i] = (p0[i] + pen16[i]) + brow[16 * (i >> 3) + (i & 7)];
    float ma = fmaxf(fmaxf(p0[0], p0[1]), p0[2]), mb = fmaxf(fmaxf(p0[3], p0[4]), p0[5]);
#pragma unroll
    for (int i = 6; i < 16; i += 2) { ma = fmaxf(ma, p0[i]); mb = fmaxf(mb, p0[i + 1]); }
    float mx = fmaxf(ma, mb);
    mx = fmaxf(mx, __shfl_xor(mx, 32));
    const bool need = (!started && mx > -INFINITY) || (mx > ATT_THR);
    if (__any(need)) {
        const float delta = need ? (started ? fmaxf(mx, 0.f) : mx) : 0.f;
        const float alpha = started ? __builtin_amdgcn_exp2f(-delta) : 1.f;
        started = started || need;
        mref += delta;
#pragma unroll
        for (int i = 0; i < 16; ++i) p0[i] -= delta;
        l *= alpha;
#pragma unroll
        for (int b = 0; b < 2; ++b)
#pragma unroll
            for (int i = 0; i < 16; ++i) o[b][i] *= alpha;
    }
    float rs = 0.f;
#pragma unroll
    for (int i = 0; i < 16; ++i) { p0[i] = __builtin_amdgcn_exp2f(p0[i]); rs += p0[i]; }
    l += rs;
    bf16x8 pb[2];
#pragma unroll
    for (int ks = 0; ks < 2; ++ks) { u32x4 t; t.x = cvt_pk_bf16(p0[8 * ks + 0], p0[8 * ks + 1]); t.y = cvt_pk_bf16(p0[8 * ks + 2], p0[8 * ks + 3]); t.z = cvt_pk_bf16(p0[8 * ks + 4], p0[8 * ks + 5]); t.w = cvt_pk_bf16(p0[8 * ks + 6], p0[8 * ks + 7]);
        pb[ks] = __builtin_bit_cast(bf16x8, t); }
    __builtin_amdgcn_sched_barrier(0);
    if (ATT_PRIO) __builtin_amdgcn_s_setprio(1);
#pragma unroll
    for (int b = 0; b < 2; ++b)
#pragma unroll
        for (int ks = 0; ks < 2; ++ks) o[b] = __builtin_amdgcn_mfma_f32_32x32x16_bf16(vf[2 * b + ks], pb[ks], o[b], 0, 0, 0);
    if (ATT_PRIO) __builtin_amdgcn_s_setprio(0);
}

__device__ __forceinline__ void natten_phase(const Params& P, const Ws& w, LAS unsigned char* lds, int layer) {
    const bool last = (layer == DEPTH - 1);
    const float* rpb = P.na_rpb + (size_t)(layer / 2) * 16 * 15 * 31;
    LAS float* rtab = (LAS float*)(lds + RPB_OFF);
    const int nlat = NB * 16 * 8, nctx = last ? 0 : NB * 16;
    int tab_head = -1;
    for (int u = bidx(); u < nlat + nctx; u += gridDim.x) {
        const int tid = tidx(), lane = tid & 63, wave = __builtin_amdgcn_readfirstlane(tid >> 6), r = lane & 31, h = lane >> 5;
        const bool isctx = (u >= nlat);
        int b, head, rg = 0;
        if (!isctx) { rg = u & 7; head = (u >> 3) & 15; b = u >> 7; } else { const int u2 = u - nlat; head = u2 & 15; b = u2 >> 4; }
        const int cg = wave & 3, rp = wave >> 2;
        const int qr = 4 * rg + 2 * rp + (r >> 4), qc = 16 * cg + (r & 15);
        const int qtok = isctx ? NLAT + b * CL + 32 * wave + r : b * SEQ + qr * GW + qc;
        const int x0 = (cg == 0) ? 0 : (cg == 1) ? 8 : (cg == 2) ? 24 : 32;
        const int c0 = min(max(qc - 8, 0), 48), r0l = min(max(qr - 4, 0), 24);
        const int rfirst = min(max(4 * rg - 4, 0), 24), rlast = min(max(4 * rg + 3 - 4, 0), 24) + 7;
        const int nband = isctx ? 0 : rlast - rfirst + 1, NT = nband + 4;
        const int wlo = min(max(4 * rg + 2 * rp - 4, 0), 24), whi = min(max(4 * rg + 2 * rp + 1 - 4, 0), 24) + 7;
        auto tile_tok = [&](int t) -> int { return (t < nband) ? b * SEQ + (rfirst + t) * GW : NLAT + b * CL + (t - nband) * 64; };
        Stage<64, 1> st;
        stage_load<64, 1>(st, w.QK, w.VT, tile_tok(0), head * 64, head * 64, tid);
        bf16x8 qf[4];
#pragma unroll
        for (int s = 0; s < 4; ++s) qf[s] = *(const bf16x8*)(w.QK + (size_t)qtok * 2048 + head * 64 + 16 * s + 8 * h);
        if (!isctx && head != tab_head) {
            for (int i = tid; i < 16 * RPB_W; i += NTHR) { const int dr = i / RPB_W, d = i % RPB_W - 63;
                rtab[i] = (dr == 15) ? -INFINITY : (d >= -15 && d <= 15) ? rpb[(head * 15 + dr) * 31 + d + 15] * LOG2E : 0.f; }
            tab_head = head;
        }
        float pen16[16];
#pragma unroll
        for (int i = 0; i < 16; ++i) { const int kc = x0 + 16 * (i >> 3) + 8 * h + (i & 7); pen16[i] = ((unsigned)(kc - c0) < 16u) ? 0.f : -INFINITY; }
        float pen[32];
#pragma unroll
        for (int i = 0; i < 32; ++i) pen[i] = 0.f;
        f32x16 o[2];
#pragma unroll
        for (int i = 0; i < 16; ++i) { o[0][i] = 0.f; o[1][i] = 0.f; }
        float m = 0.f, l = 0.f; bool started = false;
        if (0 < nband) stage_store_nat(st, lds, tid); else stage_store<64, 1>(st, lds, tid);
        __syncthreads();
        for (int t = 0; t < NT; ++t) {
            if (t + 1 < NT) stage_load<64, 1>(st, w.QK, w.VT, tile_tok(t + 1), head * 64, head * 64, tid);
            const LAS unsigned char* buf = lds + (t & 1) * STAGE_B;
            if (t < nband) {
                const int kr = rfirst + t;
                if (kr >= wlo && kr <= whi) {
                    const bool rowok = (kr >= r0l) && (kr < r0l + 8);
                    const LAS float* brow = rtab + (rowok ? (kr - qr + 7) : 15) * RPB_W + 63 - qc + x0 + 8 * h;
                    band_tile32(buf, x0, qf, o, m, l, started, pen16, brow, r, h);
                }
            } else tile_compute<64, false>(buf, 0, qf, o, m, l, started, pen, rtab, r, h);
            if (t + 1 < NT) { if (t + 1 < nband) stage_store_nat(st, lds + ((t + 1) & 1) * STAGE_B, tid); else stage_store<64, 1>(st, lds + ((t + 1) & 1) * STAGE_B, tid); }
            __syncthreads();
        }
        l += __shfl_xor(l, 32);
        const float il = 1.f / l;
        bf16_t* op = w.O + (size_t)qtok * D + head * 64;
#pragma unroll
        for (int bb = 0; bb < 2; ++bb)
#pragma unroll
            for (int g = 0; g < 4; ++g) {
                u32x2 v; v.x = cvt_pk_bf16(o[bb][4 * g] * il, o[bb][4 * g + 1] * il); v.y = cvt_pk_bf16(o[bb][4 * g + 2] * il, o[bb][4 * g + 3] * il);
                *(u32x2*)(op + 32 * bb + 8 * g + 4 * h) = v;
            }
    }
}

__device__ __forceinline__ void diff_phase(const Params& P, const Ws& w, LAS unsigned char* lds, int layer) {
    const int tid = tidx(), lane = tid & 63, wave = __builtin_amdgcn_readfirstlane(tid >> 6), r = lane & 31, h = lane >> 5;
    const bool last = (layer == DEPTH - 1);
    const int j = layer / 2;
    const float* lam = P.diff_lambda + (size_t)j * 4 * 64; const float* sg = P.diff_subln + (size_t)j * 128;
    float d01 = 0.f, d23 = 0.f;
    for (int i = 0; i < 64; ++i) { d01 += lam[i] * lam[64 + i]; d23 += lam[128 + i] * lam[192 + i]; }
    const float li = lam_init_of(layer);
    const float lam_full = expf(d01) - expf(d23) + li;
    const int nlat = NB * 8 * 16, nctx = last ? 0 : NB * 8 * 2;
    const int map = wave >> 2, wq = wave & 3;
    for (int u = bidx(); u < nlat + nctx; u += gridDim.x) {
        const bool isctx = (u >= nlat);
        int b, head, qb;
        if (!isctx) { qb = u & 15; head = (u >> 4) & 7; b = u >> 7; } else { const int u2 = u - nlat; qb = u2 & 1; head = (u2 >> 1) & 7; b = u2 >> 4; }
        const int qtok = (isctx ? NLAT + b * CL : b * SEQ) + 128 * qb + 32 * wq + r;
        const int NT = isctx ? 4 : 36;
        bf16x8 qf[4];
#pragma unroll
        for (int s = 0; s < 4; ++s) qf[s] = *(const bf16x8*)(w.QK + (size_t)qtok * 2048 + head * 128 + map * 64 + 16 * s + 8 * h);
        f32x16 o[4];
#pragma unroll
        for (int bb = 0; bb < 4; ++bb)
#pragma unroll
            for (int i = 0; i < 16; ++i) o[bb][i] = 0.f;
        float m = 0.f, l = 0.f; bool started = false;
        float pen[32];
#pragma unroll
        for (int i = 0; i < 32; ++i) pen[i] = 0.f;
        auto tile_tok = [&](int t) -> int { return (!isctx && t < 32) ? b * SEQ + t * 64 : NLAT + b * CL + (isctx ? t : t - 32) * 64; };
        Stage<128, 2> st;
        stage_load<128, 2>(st, w.QK, w.VT, tile_tok(0), head * 128, head * 128, tid);
        stage_store<128, 2>(st, lds, tid);
        __syncthreads();
        for (int t = 0; t < NT; ++t) {
            if (t + 1 < NT) stage_load<128, 2>(st, w.QK, w.VT, tile_tok(t + 1), head * 128, head * 128, tid);
            tile_compute<128, false>(lds + (t & 1) * STAGE_B, map, qf, o, m, l, started, pen, (const LAS float*)lds, r, h);
            if (t + 1 < NT) stage_store<128, 2>(st, lds + ((t + 1) & 1) * STAGE_B, tid);
            __syncthreads();
        }
        l += __shfl_xor(l, 32);
        const float il = 1.f / l;
        LAS float* xch = (LAS float*)(lds + XCH_OFF) + wq * (128 * 32);
        if (map == 1) {
#pragma unroll
            for (int bb = 0; bb < 4; ++bb)
#pragma unroll
                for (int i = 0; i < 16; ++i) { const int dv = 32 * bb + (i & 3) + 8 * (i >> 2) + 4 * h; xch[dv * 32 + r] = o[bb][i] * il; }
        }
        __syncthreads();
        if (map == 0) {
            float ss = 0.f;
#pragma unroll
            for (int bb = 0; bb < 4; ++bb)
#pragma unroll
                for (int i = 0; i < 16; ++i) { const int dv = 32 * bb + (i & 3) + 8 * (i >> 2) + 4 * h; const float v = o[bb][i] * il - lam_full * xch[dv * 32 + r]; o[bb][i] = v; ss += v * v; }
            ss += __shfl_xor(ss, 32);
            const float rinv = rsqrtf(ss * (1.f / 128.f) + EPS) * (1.f - li);
            bf16_t* op = w.O + (size_t)qtok * D + head * 128;
#pragma unroll
            for (int bb = 0; bb < 4; ++bb)
#pragma unroll
                for (int g = 0; g < 4; ++g) {
                    const int dv = 32 * bb + 8 * g + 4 * h;
                    const f32x4 gg = *(const f32x4*)(sg + dv);
                    u32x2 v; v.x = cvt_pk_bf16(o[bb][4 * g] * rinv * gg[0], o[bb][4 * g + 1] * rinv * gg[1]); v.y = cvt_pk_bf16(o[bb][4 * g + 2] * rinv * gg[2], o[bb][4 * g + 3] * rinv * gg[3]);
                    *(u32x2*)(op + dv) = v;
                }
        }
        __syncthreads();
    }
}
}

#define XB_TMO      128
#define XB_XCNT(j)  (256  + 64 * (j))
#define XB_XSUB(j)  (1280 + 64 * (j))
#define XB_XGEN(j)  (2304 + 64 * (j))
#define XB_TOP      3328
#define XB_TOPGEN   3392
#define XCD_BAR_WORDS 3456
#define XB_SPIN_CAP (1u << 22)
constexpr int CW_BAR = 8192;
__device__ __forceinline__ unsigned xb_ld(unsigned* p)              { return __hip_atomic_load(p, __ATOMIC_RELAXED, __HIP_MEMORY_SCOPE_AGENT); }
__device__ __forceinline__ unsigned xb_add(unsigned* p, unsigned v) { return __hip_atomic_fetch_add(p, v, __ATOMIC_RELAXED, __HIP_MEMORY_SCOPE_AGENT); }
__device__ __forceinline__ unsigned xb_xcc_id() { return (unsigned)__builtin_amdgcn_s_getreg((3 << 11) | 20) & 0xFu; }
#define XB_SPIN(cond, bar) do { unsigned _sp = 0; while (cond) { __builtin_amdgcn_s_sleep(1); \
    if ((++_sp & 255u) == 0u) { if (xb_ld(&(bar)[XB_TMO])) break; if (_sp > XB_SPIN_CAP) { atomicAdd(&(bar)[XB_TMO], 1u); break; } } } } while (0)
struct XcdBarrier { unsigned* bar; unsigned x; volatile LAS unsigned* st; };
__device__ __forceinline__ XcdBarrier xcd_barrier_post(unsigned* bar, volatile LAS unsigned* st) {
    XcdBarrier b; b.bar = bar; b.x = xb_xcc_id(); b.st = st;
    if (tidx() == 0) (void)xb_add(&bar[XB_XCNT(b.x)], 1u);
    return b;
}
__device__ __forceinline__ void xcd_barrier_complete(unsigned* bar, unsigned x, unsigned& nloc, unsigned& nx) {
    const unsigned G = gridDim.x * gridDim.y * gridDim.z;
    unsigned sum, cnt, mine, sp = 0u;
    for (;;) {
        sum = 0u; cnt = 0u; mine = 0u;
#pragma unroll
        for (unsigned j = 0; j < 16; ++j) { const unsigned c = xb_ld(&bar[XB_XCNT(j)]); sum += c; cnt += (c > 0u) ? 1u : 0u; mine = (j == x) ? c : mine; }
        if (sum == G) break;
        __builtin_amdgcn_s_sleep(1);
        if ((++sp & 255u) == 0u) { if (xb_ld(&bar[XB_TMO])) break; if (sp > XB_SPIN_CAP) { atomicAdd(&bar[XB_TMO], 1u); break; } }
    }
    nloc = mine > 0u ? mine : 1u; nx = cnt > 0u ? cnt : 1u;
}
__device__ __forceinline__ void xcd_barrier(const XcdBarrier& b) {
    asm volatile("s_waitcnt vmcnt(0)" ::: "memory");
    __syncthreads();
    if (tidx() == 0) {
        unsigned* bar = b.bar;
        __builtin_amdgcn_s_waitcnt(0);
        unsigned nloc = b.st[0], nx = b.st[1];
        if (nloc == 0u) { xcd_barrier_complete(bar, b.x, nloc, nx); b.st[0] = nloc; b.st[1] = nx; }
        const unsigned old = xb_add(&bar[XB_XSUB(b.x)], 1u);
        const unsigned gen = old / nloc;
        if (old + 1u == (gen + 1u) * nloc) {
            __builtin_amdgcn_fence(__ATOMIC_RELEASE, "agent");
            asm volatile("s_waitcnt vmcnt(0)" ::: "memory");
            const unsigned og = xb_add(&bar[XB_TOP], 1u);
            const unsigned tg = og / nx;
            if (og + 1u == (tg + 1u) * nx) xb_add(&bar[XB_TOPGEN], 1u);
            else XB_SPIN(xb_ld(&bar[XB_TOPGEN]) == tg, bar);
            __builtin_amdgcn_fence(__ATOMIC_ACQUIRE, "agent");
            xb_add(&bar[XB_XGEN(b.x)], 1u);
            asm volatile("s_waitcnt vmcnt(0)" ::: "memory");
        } else {
            XB_SPIN(xb_ld(&bar[XB_XGEN(b.x)]) == gen, bar);
            __builtin_amdgcn_fence(__ATOMIC_ACQUIRE, "agent");
            asm volatile("s_waitcnt vmcnt(0)" ::: "memory");
        }
    }
    __syncthreads();
}

constexpr int MK_NSTEPS = 2 + 7 * DEPTH;
#ifndef CONV_BUDGET
#define CONV_BUDGET 2
#endif
__global__ void __launch_bounds__(NTHR, 2) mk_fwd(Params p) {
    extern __shared__ __attribute__((aligned(16))) unsigned char lds_raw[];
    LAS unsigned char* lds = (LAS unsigned char*)lds_raw;
    const int tid = tidx();
    for (int u = tid; u < (LDS_BYTES - LDSCTL_OFF) / 4; u += NTHR) ((LAS unsigned*)(lds + LDSCTL_OFF))[u] = 0u;
    __syncthreads();
    volatile LAS unsigned* MISC = (volatile LAS unsigned*)(lds + MISC_OFF);
    XcdBarrier bar = xcd_barrier_post((unsigned*)(p.ws + WS_CTL) + CW_BAR, MISC + 8);
    const int G = gridDim.x, c = bidx();
    for (int s = p.step_lo; s < p.step_hi; ++s) {
        if (s > p.step_lo) {
            if (p.step_hi > 1000000) cg::this_grid().sync();
            xcd_barrier(bar);
        }
#if defined(__HIP_DEVICE_COMPILE__)
        const __attribute__((address_space(4))) Params* pp4 = (const __attribute__((address_space(4))) Params*)__builtin_amdgcn_kernarg_segment_ptr();
        asm volatile("" : "+s"(pp4));
        const Params P = *pp4;
#else
        const Params P = p;
#endif
        unsigned char* wsb = P.ws;
        const Ws w = make_ws(wsb);
        if (s == 0) {
            phase_convert(P, wsb, lds, 0, 1); __syncthreads();
            phase_prologue(P, w, (float*)lds_raw); __syncthreads();
            continue;
        }
        if (s == MK_NSTEPS - 1) { phase_norm(P, w, DEPTH - 1, 2, lds); continue; }
        const int l = (s - 1) / 7, ph = (s - 1) % 7;
        const char* wl = (const char*)(wsb + WS_W + (size_t)l * WL_BYTES);
        if (ph == 0) { phase_norm(P, w, l, 0, lds);
            if (l > 0) { __syncthreads(); convert_pull(P, wsb, lds, l, -1); } }
        else if (ph == 1) {
            SchedQKV S{(const char*)w.H, wl + WO_QK, wl + WO_V, G, c};
            EpiQKV E{w.QK, w.VT, w.rope_cos, w.rope_sin, (l & 1) != 0};
            pg8::gemm_phase<EpiQKV, SchedQKV, true, true>(lds, D, S, E); __syncthreads();
            if (864 % G != 0 && c >= 864 % G) convert_pull(P, wsb, lds, l + 1, CONV_BUDGET);
        } else if (ph == 2) {
            if (l & 1) att::diff_phase(P, w, lds, l); else att::natten_phase(P, w, lds, l);
        } else if (ph == 3) {
            SchedDense S{(const char*)w.O, wl + WO_O, (l == DEPTH - 1) ? NLAT / 256 : NTOK / 256, 4, G, c};
            EpiWO E{P.x, P.ctx, w.X, w.mods + (size_t)l * 9 * (NMOD * D) + 2 * D, l == 0};
            pg8::gemm_phase<EpiWO, SchedDense, true, true>(lds, D, S, E);
            __syncthreads();
            if (l < DEPTH - 1 && 288 % G != 0 && c >= 288 % G) convert_pull(P, wsb, lds, l + 1, CONV_BUDGET);
        } else if (ph == 4) phase_norm(P, w, l, 1, lds);
        else if (ph == 5) {
            LAS unsigned* tab = (LAS unsigned*)(lds + TILETAB_OFF);
            const int ntile = build_tile_table(w, l, tab);
            SchedMoe<true> S{(const char*)w.H, wl + WO_E, w.list, tab, ntile, 8, G, c, 0};
            EpiGLU E{w.ACT};
            pg8::gemm_phase<EpiGLU, SchedMoe<true>, true, true>(lds, D, S, E);
        } else {
            LAS unsigned* tab = (LAS unsigned*)(lds + TILETAB_OFF);
            const int ntile = build_tile_table(w, l, tab);
            SchedMoe<false> S{(const char*)w.ACT, wl + WO_E, w.list, tab, ntile, 4, G, c, WE_2};
            EpiDown E{w.Y};
            pg8::gemm_phase<EpiDown, SchedMoe<false>, true, true>(lds, D, S, E); __syncthreads();
            if ((ntile * 4) % G != 0 && c >= (ntile * 4) % G) convert_pull(P, wsb, lds, l + 1, CONV_BUDGET);
        }
    }
}

extern "C" void kernel_launch(void* const* d_in, const int* in_sizes, int n_in, void* d_out, int out_size, void* d_ws, size_t ws_size, hipStream_t stream) {
    static int grid = 0;
    if (grid == 0) {
        int dev = 0, cus = 0, per_cu = 0;
        (void)hipGetDevice(&dev);
        (void)hipDeviceGetAttribute(&cus, hipDeviceAttributeMultiprocessorCount, dev);
        if (hipFuncSetAttribute((const void*)mk_fwd, hipFuncAttributeMaxDynamicSharedMemorySize, LDS_BYTES) != hipSuccess) { fprintf(stderr, "kernel_launch: hipFuncSetAttribute failed\n"); grid = -1; }
        if (hipOccupancyMaxActiveBlocksPerMultiprocessor(&per_cu, (const void*)mk_fwd, NTHR, LDS_BYTES) != hipSuccess || per_cu < 1) { fprintf(stderr, "kernel_launch: occupancy query says %d blocks per CU\n", per_cu); if (grid == 0) grid = -1; }
        (void)hipGetLastError();
        if (grid == 0) grid = cus;
        if (grid > 0 && grid < 144) { fprintf(stderr, "kernel_launch: built for >= 144 CUs (got %d)\n", grid); grid = -1; }
        if (ws_size < WS_END) { fprintf(stderr, "kernel_launch: workspace too small (%zu < %zu)\n", ws_size, (size_t)WS_END); grid = -1; }
    }
    if (grid < 0) return;
    (void)hipMemsetAsync((char*)d_ws + WS_CTL, 0, CTL_BYTES, stream);
    Params p{};
    const float** pp = (const float**)&p;
    for (int i = 0; i < 19; ++i) pp[i] = (const float*)d_in[i];
    p.out = (float*)d_out; p.ws = (unsigned char*)d_ws;
    const dim3 blk(NTHR);
    p.step_lo = 0; p.step_hi = MK_NSTEPS;
    void* args[] = {&p};
    hipError_t e = hipLaunchCooperativeKernel((const void*)mk_fwd, dim3(grid), blk, args, LDS_BYTES, stream);
    if (e != hipSuccess) fprintf(stderr, "cooperative launch failed: %s (grid %d)\n", hipGetErrorString(e), grid);
}
```

```cpp
#include <hip/hip_runtime.h>
#include <hip/hip_cooperative_groups.h>
#include <cstdio>
#include <cstdint>
namespace cg = cooperative_groups;


typedef unsigned short bf16_t;
typedef float v4f __attribute__((ext_vector_type(4)));
constexpr int D = 1024, NB = 8, SEQ = 2048, CL = 256, NLAT = NB * SEQ, NCTX = NB * CL, NTOK = NLAT + NCTX;
constexpr int DEPTH = 4, NE = 16, NMOD = 6, GW = 64;
constexpr float EPS = 1e-6f, LOG2E = 1.4426950408889634f, QSCALE = 0.125f * 1.4426950408889634f;
constexpr int NTHR = 512, NWAVE = 8;
constexpr int SLOTS = 40960;

constexpr size_t MiB = 1u << 20;
constexpr size_t WS_CTL = 0, CTL_BYTES = 1 * MiB;
constexpr size_t WS_MODS = 1 * MiB;
constexpr size_t WS_ROPE = 2 * MiB;
constexpr size_t WS_TOKI = 3 * MiB;
constexpr size_t WS_LIST = 4 * MiB;
constexpr size_t WS_X = 6 * MiB;
constexpr size_t WS_H = 78 * MiB;
constexpr size_t WS_QK = 114 * MiB;
constexpr size_t WS_VT = 186 * MiB;
constexpr size_t WS_O = 222 * MiB;
constexpr size_t WS_ACT = 258 * MiB;
constexpr size_t WS_Y = 338 * MiB;
constexpr size_t WS_W = 418 * MiB;
constexpr size_t WL_BYTES = 104 * MiB, WO_QK = 0, WO_V = 4 * MiB, WO_O = 6 * MiB, WO_E = 8 * MiB, WE_BYTES = 6 * MiB, WE_2 = 4 * MiB;
constexpr size_t WS_END = WS_W + 4 * WL_BYTES;
constexpr int CW_CNT = 1024;

struct Params {
    const float *x, *c, *ctx, *c_ctx, *mod_w, *mod_b, *norm_mix, *norm_ffn, *w_qkv, *w_o, *na_rpb, *diff_lambda, *diff_subln,
        *router_w, *router_b, *wg, *wu, *wd, *final_norm;
    float* out;
    unsigned char* ws;
    int step_lo, step_hi;
};

__device__ __forceinline__ int tidx() { int t = threadIdx.x; asm volatile("" : "+v"(t)); return t; }
__device__ __forceinline__ int bidx() { int t = blockIdx.x; asm volatile("" : "+s"(t)); return t; }
__device__ __forceinline__ float bf2f(bf16_t v) { return __uint_as_float(((unsigned)v) << 16); }
__device__ __forceinline__ bf16_t f2bf(float f) { unsigned u = __float_as_uint(f); return (bf16_t)((u + 0x7fffu + ((u >> 16) & 1u)) >> 16); }
__device__ __forceinline__ float wave_sum(float v) {
#pragma unroll
    for (int o = 1; o < 64; o <<= 1) v += __shfl_xor(v, o);
    return v;
}
__device__ __forceinline__ float silu_f(float v) { return v / (1.f + __expf(-v)); }
__device__ __forceinline__ int mod_row(int row) { return row < NLAT ? row / SEQ : NB; }
__device__ __forceinline__ float lam_init_of(int layer) { return 0.8f - 0.6f * expf(-0.3f * (float)layer); }

struct Ws {
    unsigned* ctl; float* mods; float* rope_cos; float* rope_sin; int4* toki; float2* tokw; int* list;
    float* X; bf16_t *H, *QK, *VT, *O, *ACT, *Y;
};
__device__ __forceinline__ Ws make_ws(unsigned char* ws) {
    Ws w;
    w.ctl = (unsigned*)(ws + WS_CTL); w.mods = (float*)(ws + WS_MODS); w.rope_cos = (float*)(ws + WS_ROPE); w.rope_sin = w.rope_cos + SEQ * 32;
    w.toki = (int4*)(ws + WS_TOKI); w.tokw = (float2*)(ws + WS_TOKI + (size_t)NTOK * 16); w.list = (int*)(ws + WS_LIST);
    w.X = (float*)(ws + WS_X); w.H = (bf16_t*)(ws + WS_H); w.QK = (bf16_t*)(ws + WS_QK); w.VT = (bf16_t*)(ws + WS_VT); w.O = (bf16_t*)(ws + WS_O);
    w.ACT = (bf16_t*)(ws + WS_ACT); w.Y = (bf16_t*)(ws + WS_Y);
    return w;
}
__device__ __forceinline__ void expert_offsets(const Ws& w, int layer, int* cnt, int* off) {
    int acc = 0;
#pragma unroll
    for (int e = 0; e < NE; ++e) {
        const int c = (int)__hip_atomic_load(w.ctl + CW_CNT + (layer * NE + e) * 64, __ATOMIC_RELAXED, __HIP_MEMORY_SCOPE_AGENT);
        cnt[e] = c; off[e] = acc; acc += (c + 255) & ~255;
    }
    off[NE] = acc;
}

__device__ __forceinline__ void phase_prologue(const Params& p, const Ws& w, float* smem) {
    const int tid = tidx(), bid = bidx(), nb = gridDim.x;
    float* sact = smem;
    float* part = smem + 9 * 1024;
    for (int i = tid; i < 9 * 1024; i += NTHR) { const int r = i >> 10, k = i & 1023; const float v = r < NB ? p.c[r * D + k] : p.c_ctx[k]; sact[i] = silu_f(v); }
    __syncthreads();
    const int col = tid & 127, ks = tid >> 7;
    for (int u = bid; u < DEPTH * (NMOD * D / 128); u += nb) {
        const int layer = u / (NMOD * D / 128), col0 = (u % (NMOD * D / 128)) * 128;
        float acc[9];
#pragma unroll
        for (int r = 0; r < 9; ++r) acc[r] = 0.f;
        const float* wp = p.mod_w + ((size_t)layer * D + ks * 256) * (NMOD * D) + col0 + col;
#pragma unroll 4
        for (int k = 0; k < 256; ++k) {
            const float wv = wp[(size_t)k * (NMOD * D)];
#pragma unroll
            for (int r = 0; r < 9; ++r) acc[r] += sact[r * 1024 + ks * 256 + k] * wv;
        }
#pragma unroll
        for (int r = 0; r < 9; ++r) part[(ks * 9 + r) * 128 + col] = acc[r];
        __syncthreads();
        for (int i = tid; i < 9 * 128; i += NTHR) {
            const int r = i >> 7, cc = i & 127;
            const float v = part[(0 * 9 + r) * 128 + cc] + part[(1 * 9 + r) * 128 + cc] + part[(2 * 9 + r) * 128 + cc] + part[(3 * 9 + r) * 128 + cc];
            w.mods[((size_t)layer * 9 + r) * (NMOD * D) + col0 + cc] = v + p.mod_b[layer * (NMOD * D) + col0 + cc];
        }
        __syncthreads();
    }
    for (int i = bid * NTHR + tid; i < SEQ * 32; i += nb * NTHR) {
        const int t = i >> 5, j = i & 31, f = j & 15;
        const float pos = (float)(j < 16 ? t / GW : t % GW);
        const float inv = powf(10000.0f, -(float)f / 16.0f);
        const float ang = pos * inv;
        w.rope_cos[i] = cosf(ang); w.rope_sin[i] = sinf(ang);
    }
}

__device__ __forceinline__ void phase_norm(const Params& p, const Ws& w, int layer, int mode, __attribute__((address_space(3))) unsigned char* lds) {
#define NLAS __attribute__((address_space(3)))
    const int tid = tidx(), lane = tid & 63, wave = tid >> 6;
    const int gw = bidx() * NWAVE + wave, ngw = gridDim.x * NWAVE;
    const bool combine = (mode == 0 && layer > 0) || mode == 2;
    const int clayer = (mode == 2) ? DEPTH - 1 : layer - 1;
    int cnt[NE], off[NE + 1];
    if (combine) expert_offsets(w, clayer, cnt, off);
    int nrows = NTOK;
    if (mode == 2) nrows = NLAT;
    if (mode == 1 && layer == DEPTH - 1) nrows = NLAT;
    NLAS unsigned* lcnt = (NLAS unsigned*)lds;
    NLAS v4f* lgb = (NLAS v4f*)(lds + 1024);
    const NLAS v4f* rwl = (const NLAS v4f*)(lds + 16384);
    const int rpb = (nrows + (int)gridDim.x - 1) / (int)gridDim.x;
    const int chunk0 = bidx() * rpb;
    if (mode == 1) {
        if (tid < 32) lcnt[tid] = 0u;
        for (int c = tid; c < D * 4; c += NTHR) { const int k = c >> 2, e4 = c & 3, j = k >> 8, ln = (k & 255) >> 2, q = k & 3;
            ((NLAS v4f*)(lds + 16384))[((j * 4 + q) * 4 + e4) * 64 + ln] = ((const v4f*)p.router_w)[c]; }
        __syncthreads();
    }
    const bool from_input = (layer == 0 && mode == 0);
    const int row0 = (mode == 1) ? chunk0 + wave : gw, rstep = (mode == 1) ? NWAVE : ngw;
    const int rend = (mode == 1) ? min(nrows, chunk0 + rpb) : nrows;
    v4f vn[4]; int4 tin = make_int4(0, 0, 0, 0); float2 twn = make_float2(0.f, 0.f);
    if (row0 < rend) {
        const float* src = from_input ? (row0 < NLAT ? p.x + (size_t)row0 * D : p.ctx + (size_t)(row0 - NLAT) * D) : w.X + (size_t)row0 * D;
#pragma unroll
        for (int j = 0; j < 4; ++j) vn[j] = __builtin_nontemporal_load((const v4f*)src + 64 * j + lane);
        if (combine) { tin = w.toki[row0]; twn = w.tokw[row0]; }
    }
    for (int row = row0; row < rend; row += rstep) {
        const int r = mod_row(row);
        v4f v[4];
#pragma unroll
        for (int j = 0; j < 4; ++j) v[j] = vn[j];
        const int4 ti = tin; const float2 tw = twn;
        {
            const int nrow = row + rstep;
            if (nrow < rend) {
                const float* src = from_input ? (nrow < NLAT ? p.x + (size_t)nrow * D : p.ctx + (size_t)(nrow - NLAT) * D) : w.X + (size_t)nrow * D;
#pragma unroll
                for (int j = 0; j < 4; ++j) vn[j] = __builtin_nontemporal_load((const v4f*)src + 64 * j + lane);
                if (combine) { tin = w.toki[nrow]; twn = w.tokw[nrow]; }
            }
        }
        if (combine) {
            int o0 = 0, o1 = 0;
#pragma unroll
            for (int e = 0; e < NE; ++e) { if (e == ti.x) o0 = off[e]; if (e == ti.z) o1 = off[e]; }
            const bf16_t* y0 = w.Y + (size_t)(o0 + ti.y) * D; const bf16_t* y1 = w.Y + (size_t)(o1 + ti.w) * D;
            const float* g5 = w.mods + ((size_t)clayer * 9 + r) * (NMOD * D) + 5 * D;
#pragma unroll
            for (int j = 0; j < 4; ++j) {
                const int k = 4 * (64 * j + lane);
                typedef unsigned v2u __attribute__((ext_vector_type(2)));
                const v2u a_ = __builtin_nontemporal_load((const v2u*)(y0 + k)), b_ = __builtin_nontemporal_load((const v2u*)(y1 + k));
                const uint2 a = make_uint2(a_[0], a_[1]), b = make_uint2(b_[0], b_[1]);
                const v4f g = *(const v4f*)(g5 + k);
                v[j][0] += g[0] * (tw.x * bf2f((bf16_t)(a.x & 0xffff)) + tw.y * bf2f((bf16_t)(b.x & 0xffff)));
                v[j][1] += g[1] * (tw.x * bf2f((bf16_t)(a.x >> 16)) + tw.y * bf2f((bf16_t)(b.x >> 16)));
                v[j][2] += g[2] * (tw.x * bf2f((bf16_t)(a.y & 0xffff)) + tw.y * bf2f((bf16_t)(b.y & 0xffff)));
                v[j][3] += g[3] * (tw.x * bf2f((bf16_t)(a.y >> 16)) + tw.y * bf2f((bf16_t)(b.y >> 16)));
            }
            if (mode != 2) {
                float* xdst = w.X;
#pragma unroll
                for (int j = 0; j < 4; ++j) ((v4f*)(xdst + (size_t)row * D))[64 * j + lane] = v[j];
            }
        }
        float ss = 0.f;
#pragma unroll
        for (int j = 0; j < 4; ++j) ss += v[j][0] * v[j][0] + v[j][1] * v[j][1] + v[j][2] * v[j][2] + v[j][3] * v[j][3];
        ss = wave_sum(ss);
        const float rinv = rsqrtf(ss * (1.f / D) + EPS);
        if (mode == 2) {
#pragma unroll
            for (int j = 0; j < 4; ++j) {
                const int k = 4 * (64 * j + lane); const v4f g = *(const v4f*)(p.final_norm + k);
                __builtin_nontemporal_store(v[j] * rinv * g, (v4f*)(p.out + (size_t)row * D) + 64 * j + lane);
            }
            continue;
        }
        const float* gn = (mode == 0 ? p.norm_mix : p.norm_ffn) + layer * D;
        const float* mv = w.mods + ((size_t)layer * 9 + r) * (NMOD * D) + (mode == 0 ? 0 : 3 * D);
        float hv[16];
#pragma unroll
        for (int j = 0; j < 4; ++j) {
            const int k = 4 * (64 * j + lane);
            const v4f g = *(const v4f*)(gn + k), sh = *(const v4f*)(mv + k), sc = *(const v4f*)(mv + D + k);
            const v4f hh = v[j] * rinv * g * (1.f + sc) + sh;
            hv[4 * j + 0] = hh[0]; hv[4 * j + 1] = hh[1]; hv[4 * j + 2] = hh[2]; hv[4 * j + 3] = hh[3];
            uint2 o; o.x = (unsigned)f2bf(hv[4 * j]) | ((unsigned)f2bf(hv[4 * j + 1]) << 16); o.y = (unsigned)f2bf(hv[4 * j + 2]) | ((unsigned)f2bf(hv[4 * j + 3]) << 16);
            *(uint2*)(w.H + (size_t)row * D + k) = o;
        }
        if (mode == 1) {
            float lg[NE];
#pragma unroll
            for (int e = 0; e < NE; ++e) lg[e] = 0.f;
#pragma unroll
            for (int j = 0; j < 4; ++j) {
                v4f tw[16];
#pragma unroll
                for (int qe = 0; qe < 16; ++qe) tw[qe] = rwl[(j * 16 + qe) * 64 + lane];
                __builtin_amdgcn_sched_barrier(0);
#pragma unroll
                for (int q = 0; q < 4; ++q) {
                    const float hh = hv[4 * j + q];
#pragma unroll
                    for (int e4 = 0; e4 < 4; ++e4) { const v4f t = tw[q * 4 + e4]; lg[4 * e4] += hh * t[0]; lg[4 * e4 + 1] += hh * t[1]; lg[4 * e4 + 2] += hh * t[2]; lg[4 * e4 + 3] += hh * t[3]; }
                }
            }
            {
                const bool b5 = (lane & 32) != 0, b4 = (lane & 16) != 0, b3 = (lane & 8) != 0, b2 = (lane & 4) != 0;
                float a8[8], a4[4], a2[2];
#pragma unroll
                for (int j = 0; j < 8; ++j) { const float keep = b5 ? lg[j + 8] : lg[j], send = b5 ? lg[j] : lg[j + 8]; a8[j] = keep + __shfl_xor(send, 32); }
#pragma unroll
                for (int j = 0; j < 4; ++j) { const float keep = b4 ? a8[j + 4] : a8[j], send = b4 ? a8[j] : a8[j + 4]; a4[j] = keep + __shfl_xor(send, 16); }
#pragma unroll
                for (int j = 0; j < 2; ++j) { const float keep = b3 ? a4[j + 2] : a4[j], send = b3 ? a4[j] : a4[j + 2]; a2[j] = keep + __shfl_xor(send, 8); }
                float a1 = (b2 ? a2[1] : a2[0]) + __shfl_xor(b2 ? a2[0] : a2[1], 4);
                a1 += __shfl_xor(a1, 2); a1 += __shfl_xor(a1, 1);
                if ((lane & 3) == 0) ((NLAS float*)lgb)[(row - chunk0) * 16 + (lane >> 2)] = a1;
            }
        }
    }
    if (mode == 1) {
        __syncthreads();
        const int row = chunk0 + tid; const bool act = (tid < rpb && row < nrows);
        int i1 = 0, i2 = 0; unsigned lp1 = 0, lp2 = 0; float w1 = 0.f, w2 = 0.f;
        if (act) {
            float sc[NE], sel[NE];
#pragma unroll
            for (int e4 = 0; e4 < 4; ++e4) { const v4f t = lgb[tid * 4 + e4];
#pragma unroll
                for (int q = 0; q < 4; ++q) { const int e = 4 * e4 + q; sc[e] = 1.f / (1.f + expf(-t[q])); sel[e] = sc[e] + p.router_b[e]; } }
            int bg = 0; float bgs = -INFINITY;
#pragma unroll
            for (int g = 0; g < 4; ++g) {
                float m1 = -INFINITY, m2 = -INFINITY;
#pragma unroll
                for (int q = 0; q < 4; ++q) { const float t = sel[4 * g + q]; if (t > m1) { m2 = m1; m1 = t; } else if (t > m2) m2 = t; }
                const float gs = m1 + m2;
                if (gs > bgs) { bgs = gs; bg = g; }
            }
            float m1 = -INFINITY, m2 = -INFINITY;
#pragma unroll
            for (int g = 0; g < 4; ++g) {
                if (g == bg) {
#pragma unroll
                    for (int q = 0; q < 4; ++q) { const float t = sel[4 * g + q]; if (t > m1) { m2 = m1; i2 = i1; m1 = t; i1 = 4 * g + q; } else if (t > m2) { m2 = t; i2 = 4 * g + q; } }
                }
            }
            float s1 = 0.f, s2 = 0.f;
#pragma unroll
            for (int e = 0; e < NE; ++e) { if (e == i1) s1 = sc[e]; if (e == i2) s2 = sc[e]; }
            const float inv = 1.f / (s1 + s2); w1 = s1 * inv; w2 = s2 * inv;
            lp1 = __hip_atomic_fetch_add(lcnt + i1, 1u, __ATOMIC_RELAXED, __HIP_MEMORY_SCOPE_WORKGROUP);
            lp2 = __hip_atomic_fetch_add(lcnt + i2, 1u, __ATOMIC_RELAXED, __HIP_MEMORY_SCOPE_WORKGROUP);
        }
        __syncthreads();
        if (tid < NE) lcnt[16 + tid] = atomicAdd(w.ctl + CW_CNT + (layer * NE + tid) * 64, lcnt[tid]);
        __syncthreads();
        if (act) {
            const int p1 = (int)(lcnt[16 + i1] + lp1), p2 = (int)(lcnt[16 + i2] + lp2);
            w.list[(size_t)i1 * NTOK + p1] = row; w.list[(size_t)i2 * NTOK + p2] = row;
            w.toki[row] = make_int4(i1, p1, i2, p2); w.tokw[row] = make_float2(w1, w2);
        }
        __syncthreads();
    }
#undef NLAS
}

#define LAS __attribute__((address_space(3)))
#define GAS __attribute__((address_space(1)))
typedef short bf16x8 __attribute__((ext_vector_type(8)));
typedef float f32x4 __attribute__((ext_vector_type(4)));
typedef unsigned u32x4 __attribute__((ext_vector_type(4)));
typedef unsigned u32x2 __attribute__((ext_vector_type(2)));

constexpr int RING_BYTES = 131072;
constexpr int LDSCTL_OFF = RING_BYTES, MISC_OFF = LDSCTL_OFF + 320, TILETAB_OFF = LDSCTL_OFF + 1024, STASH_OFF = LDSCTL_OFF + 4096;
constexpr int LDS_BYTES = 147456;

__device__ __forceinline__ unsigned cvt_pk_bf16(float lo, float hi) { unsigned r; asm volatile("v_cvt_pk_bf16_f32 %0, %1, %2" : "=v"(r) : "v"(lo), "v"(hi)); return r; }

namespace pg8 {
constexpr int BM = 256, BK = 64, HALF = 128, HTB = HALF * BK * 2, STAGE_BYTES = 8 * HTB, NXCD = 8, WGM = 8;
__host__ __device__ __forceinline__ int lds_byte(int r, int c) { const int st = (r >> 4) * 2 + (c >> 5), rr = r & 15, cc = c & 31, ob = rr * 64 + cc * 2; return st * 1024 + (ob ^ (((ob >> 9) & 1) << 5)); }
__host__ __device__ __forceinline__ void stage_rc(int b, int& R, int& C) { const int st = b / 1024, sb = b % 1024, swz = sb ^ (((sb >> 9) & 1) << 5); R = (st >> 1) * 16 + swz / 64; C = (st & 1) * 32 + (swz % 64) / 2; }
__host__ __device__ __forceinline__ int perm32(int rho) { const int n = rho >> 4, i = rho & 15; return 8 * (i >> 2) + 4 * n + (i & 3); }

struct Unit { int pm, pn, kind, aux; const char* a; const char* b; const int* lst; int valid; };
__device__ __forceinline__ void tile_order(int L, int nM, int nN, int& pm, int& pn) {
    const int nwg = nM * nN; int wgid = L;
    { const int q = nwg / NXCD, r = nwg % NXCD, xcd = wgid % NXCD, off = wgid / NXCD; wgid = (xcd < r ? xcd * (q + 1) : r * (q + 1) + (xcd - r) * q) + off; }
    const int nig = WGM * nN, gid = wgid / nig, fm = gid * WGM, gsz = (nM - fm) < WGM ? (nM - fm) : WGM;
    pm = fm + ((wgid % nig) % gsz); pn = (wgid % nig) / gsz;
}

template <class Epi, class Sched, bool ALIGN_EPI, bool SP2>
__device__ __forceinline__ void gemm_phase(LAS unsigned char* lds, const int K, const Sched& S, const Epi& E) {
    const int tid = tidx(), wid = __builtin_amdgcn_readfirstlane(tid >> 6), lane = tid & 63, wr = wid >> 2, wc = wid & 3, fr = lane & 15, fq = lane >> 4;
    const int nt = K / BK;
    unsigned voffB[2];
#pragma unroll
    for (int i = 0; i < 2; ++i) { int R, C; stage_rc(tid * 16 + i * 8192, R, C); const int Rb = Epi::PERM ? ((R & ~31) + perm32(R & 31)) : R; voffB[i] = (unsigned)(Rb * K + C) * 2u; }
#define PG8_AOFF(u, h, i) ([&]() { int R_, C_; stage_rc(tid * 16 + (i) * 8192, R_, C_); return S.a_off((u), (h), R_, C_, K); }())
    const size_t kstep = (size_t)(BK * 2);
    const size_t hstep = (size_t)HALF * K * 2;
    const unsigned ldsw = (unsigned)wid * 1024u;
    const int aoff = lds_byte(wr * 64 + fr, fq * 8), boff = lds_byte(wc * 32 + fr, fq * 8);
#define PG8_SA(b, h) (((b) * 2 + (h)) * HTB)
#define PG8_SB(b, h) ((4 + (b) * 2 + (h)) * HTB)
#define PG8_STAGE(bufoff, gbase, voff) do { _Pragma("unroll") for (int _i = 0; _i < 2; ++_i) \
        __builtin_amdgcn_global_load_lds((const unsigned*)((const char*)(gbase) + (voff)[_i]), (LAS unsigned*)(lds + (bufoff) + ldsw + _i * 8192), 16, 0, 0); } while (0)
#define PG8_LDA(dst, b, h) do { _Pragma("unroll") for (int m = 0; m < 4; ++m) _Pragma("unroll") for (int k = 0; k < 2; ++k) dst[m][k] = *(const LAS bf16x8*)(lds + PG8_SA(b, h) + aoff + m * 2048 + k * 1024); } while (0)
#define PG8_LDB(dst, b, h) do { _Pragma("unroll") for (int n = 0; n < 2; ++n) _Pragma("unroll") for (int k = 0; k < 2; ++k) dst[n][k] = *(const LAS bf16x8*)(lds + PG8_SB(b, h) + boff + n * 2048 + k * 1024); } while (0)
#define PG8_MMA(ai, bj, At, Bt) do { __builtin_amdgcn_s_setprio(1); _Pragma("unroll") for (int m = 0; m < 4; ++m) _Pragma("unroll") for (int n = 0; n < 2; ++n) _Pragma("unroll") for (int k = 0; k < 2; ++k) \
        acc[ai][bj][m][n] = __builtin_amdgcn_mfma_f32_16x16x32_bf16(Bt[n][k], At[m][k], acc[ai][bj][m][n], 0, 0, 0); __builtin_amdgcn_s_setprio(0); } while (0)
#define PG8_WAIT_V(n) asm volatile("s_waitcnt vmcnt(" #n ")" ::: "memory")
#define PG8_WAIT_L(n) asm volatile("s_waitcnt lgkmcnt(" #n ")" ::: "memory")
#define PG8_BAR __builtin_amdgcn_s_barrier()
#define PG8_SCHED __builtin_amdgcn_sched_barrier(0)
    Unit cur, nxt; int ui = 0;
    if (!S.next(0, cur)) return;
    unsigned vAc[2][2];
#define PG8_STASH ((LAS u32x4*)(lds + (STASH_OFF - 0)) + tid)
#pragma unroll
    for (int h = 0; h < 2; ++h)
#pragma unroll
        for (int i = 0; i < 2; ++i) vAc[h][i] = PG8_AOFF(cur, h, i);
    f32x4 acc[2][2][4][2];
#pragma unroll
    for (int a = 0; a < 2; ++a)
#pragma unroll
        for (int b = 0; b < 2; ++b)
#pragma unroll
            for (int m = 0; m < 4; ++m)
#pragma unroll
                for (int n = 0; n < 2; ++n) acc[a][b][m][n] = (f32x4){0.f, 0.f, 0.f, 0.f};
    bf16x8 At[4][2], B0[2][2], B1[2][2];
    const char* cA = cur.a; const char* cB = cur.b;
    if constexpr (SP2) {
        PG8_STAGE(PG8_SB(0, 0), cB, voffB); PG8_STAGE(PG8_SB(0, 1), cB + hstep, voffB); PG8_STAGE(PG8_SA(0, 0), cA, vAc[0]); PG8_STAGE(PG8_SA(0, 1), cA, vAc[1]);
        if (wr == 1) PG8_BAR;
        PG8_WAIT_V(2); PG8_BAR;
        PG8_STAGE(PG8_SB(1, 0), cB + kstep, voffB); PG8_STAGE(PG8_SA(1, 0), cA + kstep, vAc[0]); PG8_STAGE(PG8_SB(1, 1), cB + hstep + kstep, voffB);
        PG8_WAIT_V(6); PG8_BAR;
    } else {
        PG8_STAGE(PG8_SB(0, 0), cB, voffB); PG8_STAGE(PG8_SA(0, 0), cA, vAc[0]); PG8_STAGE(PG8_SB(0, 1), cB + hstep, voffB); PG8_STAGE(PG8_SA(0, 1), cA, vAc[1]);
        if (wr == 1) PG8_BAR;
        PG8_WAIT_V(4); PG8_BAR;
        PG8_STAGE(PG8_SB(1, 0), cB + kstep, voffB); PG8_STAGE(PG8_SA(1, 0), cA + kstep, vAc[0]); PG8_STAGE(PG8_SB(1, 1), cB + hstep + kstep, voffB);
        PG8_WAIT_V(6); PG8_BAR;
    }
    for (;;) {
        const bool has_next = S.next(ui + 1, nxt);
        const char* nA = has_next ? nxt.a : cA; const char* nB = has_next ? nxt.b : cB;
        if (Sched::GATHER && has_next) { u32x4 t4; t4.x = PG8_AOFF(nxt, 0, 0); t4.y = PG8_AOFF(nxt, 0, 1); t4.z = PG8_AOFF(nxt, 1, 0); t4.w = PG8_AOFF(nxt, 1, 1); *PG8_STASH = t4; }
        for (int t = 0; t < nt; t += 2) {
            const bool last = (t == nt - 2);
            const char* a1 = cA + (size_t)(t + 1) * kstep;
            const char* a2 = last ? nA : cA + (size_t)(t + 2) * kstep; const char* b2 = last ? nB : cB + (size_t)(t + 2) * kstep;
            const char* a3 = a2 + kstep; const char* b3 = b2 + kstep;
            if constexpr (SP2) {
            PG8_LDB(B0, 0, 0); PG8_LDB(B1, 0, 1); PG8_SCHED; PG8_LDA(At, 0, 0); PG8_STAGE(PG8_SA(1, 1), a1, vAc[1]);
            if (Sched::GATHER && last && has_next) { const u32x4 t4 = *PG8_STASH; vAc[0][0] = t4.x; vAc[0][1] = t4.y; vAc[1][0] = t4.z; vAc[1][1] = t4.w; }
            PG8_WAIT_V(8); PG8_WAIT_L(0); PG8_BAR; PG8_MMA(0, 0, At, B0); PG8_MMA(0, 1, At, B1); PG8_BAR; PG8_SCHED;
            PG8_LDA(At, 0, 1); PG8_STAGE(PG8_SB(0, 0), b2, voffB); PG8_STAGE(PG8_SB(0, 1), b2 + hstep, voffB); PG8_STAGE(PG8_SA(0, 0), a2, vAc[0]);
            PG8_WAIT_V(8); PG8_WAIT_L(0); PG8_BAR; PG8_MMA(1, 0, At, B0); PG8_MMA(1, 1, At, B1); PG8_BAR; PG8_SCHED;
            PG8_LDB(B0, 1, 0); PG8_LDB(B1, 1, 1); PG8_SCHED; PG8_LDA(At, 1, 0); PG8_STAGE(PG8_SA(0, 1), a2, vAc[1]);
            PG8_WAIT_V(8); PG8_WAIT_L(0); PG8_BAR; PG8_MMA(0, 0, At, B0); PG8_MMA(0, 1, At, B1); PG8_BAR; PG8_SCHED;
            PG8_LDA(At, 1, 1); PG8_STAGE(PG8_SB(1, 0), b3, voffB); PG8_STAGE(PG8_SB(1, 1), b3 + hstep, voffB); PG8_STAGE(PG8_SA(1, 0), a3, vAc[0]);
            PG8_WAIT_V(8); PG8_WAIT_L(0); PG8_BAR; PG8_MMA(1, 0, At, B0); PG8_MMA(1, 1, At, B1); PG8_BAR; PG8_SCHED;
            } else {
            PG8_LDB(B0, 0, 0); PG8_SCHED; PG8_LDA(At, 0, 0); PG8_STAGE(PG8_SA(1, 1), a1, vAc[1]);
            if (Sched::GATHER && last && has_next) { const u32x4 t4 = *PG8_STASH; vAc[0][0] = t4.x; vAc[0][1] = t4.y; vAc[1][0] = t4.z; vAc[1][1] = t4.w; }
            PG8_WAIT_L(8); PG8_BAR; PG8_WAIT_L(0); PG8_MMA(0, 0, At, B0); PG8_BAR; PG8_SCHED;
            PG8_LDB(B1, 0, 1); PG8_STAGE(PG8_SB(0, 0), b2, voffB);
            PG8_BAR; PG8_WAIT_L(0); PG8_MMA(0, 1, At, B1); PG8_BAR;
            PG8_LDA(At, 0, 1); PG8_STAGE(PG8_SA(0, 0), a2, vAc[0]);
            PG8_BAR; PG8_WAIT_L(0); PG8_MMA(1, 0, At, B0); PG8_BAR; PG8_SCHED;
            PG8_STAGE(PG8_SB(0, 1), b2 + hstep, voffB);
            PG8_WAIT_V(6); PG8_BAR; PG8_MMA(1, 1, At, B1); PG8_BAR;
            PG8_LDB(B0, 1, 0); PG8_SCHED; PG8_LDA(At, 1, 0); PG8_STAGE(PG8_SA(0, 1), a2, vAc[1]);
            PG8_WAIT_L(8); PG8_BAR; PG8_WAIT_L(0); PG8_MMA(0, 0, At, B0); PG8_BAR; PG8_SCHED;
            PG8_LDB(B1, 1, 1); PG8_STAGE(PG8_SB(1, 0), b3, voffB);
            PG8_BAR; PG8_WAIT_L(0); PG8_MMA(0, 1, At, B1); PG8_BAR;
            PG8_LDA(At, 1, 1); PG8_STAGE(PG8_SA(1, 0), a3, vAc[0]);
            PG8_BAR; PG8_WAIT_L(0); PG8_MMA(1, 0, At, B0); PG8_BAR; PG8_SCHED;
            PG8_STAGE(PG8_SB(1, 1), b3 + hstep, voffB);
            PG8_WAIT_V(6); PG8_BAR; PG8_MMA(1, 1, At, B1); PG8_BAR;
            }
        }
        if constexpr (ALIGN_EPI) { if (wr == 0) PG8_BAR; }
        E(acc, cur, wr, wc, fr, fq);
        if (!has_next) break;
#pragma unroll
        for (int a = 0; a < 2; ++a)
#pragma unroll
            for (int b = 0; b < 2; ++b)
#pragma unroll
                for (int m = 0; m < 4; ++m)
#pragma unroll
                    for (int n = 0; n < 2; ++n) acc[a][b][m][n] = (f32x4){0.f, 0.f, 0.f, 0.f};
        cur = nxt; cA = nA; cB = nB; ++ui;
        if constexpr (ALIGN_EPI) { if (wr == 1) PG8_BAR; }
    }
    PG8_WAIT_V(0);
    if constexpr (!ALIGN_EPI) { if (wr == 0) PG8_BAR; }
    PG8_BAR;
#undef PG8_SA
#undef PG8_AOFF
#undef PG8_STASH
#undef PG8_SB
#undef PG8_STAGE
#undef PG8_LDA
#undef PG8_LDB
#undef PG8_MMA
#undef PG8_WAIT_V
#undef PG8_WAIT_L
#undef PG8_BAR
#undef PG8_SCHED
}
}

constexpr size_t TSTEP = (size_t)256 * D * 2;
struct SchedQKV {
    static constexpr bool GATHER = false;
    const char *H, *Wqk, *Wv; int G, c;
    __device__ __forceinline__ bool next(int i, pg8::Unit& u) const {
        const int L = i * G + c;
        if (L < 576) { pg8::tile_order(L, 72, 8, u.pm, u.pn); u.kind = 0; u.a = H + (size_t)u.pm * TSTEP; u.b = Wqk + (size_t)u.pn * TSTEP; return true; }
        if (L < 576 + 288) { pg8::tile_order(L - 576, 4, 72, u.pm, u.pn); u.kind = 1; u.a = Wv + (size_t)u.pm * TSTEP; u.b = H + (size_t)u.pn * TSTEP; return true; }
        return false;
    }
    __device__ __forceinline__ unsigned a_off(const pg8::Unit&, int h, int R, int C, int K) const { return (unsigned)((h * 128 + R) * K + C) * 2u; }
};
struct SchedDense {
    static constexpr bool GATHER = false;
    const char *A, *Bt; int nM, nN, G, c;
    __device__ __forceinline__ bool next(int i, pg8::Unit& u) const {
        const int L = i * G + c; if (L >= nM * nN) return false;
        pg8::tile_order(L, nM, nN, u.pm, u.pn); u.kind = 0; u.a = A + (size_t)u.pm * TSTEP; u.b = Bt + (size_t)u.pn * TSTEP; return true;
    }
    __device__ __forceinline__ unsigned a_off(const pg8::Unit&, int h, int R, int C, int K) const { return (unsigned)((h * 128 + R) * K + C) * 2u; }
};
template <bool GATHERT> struct SchedMoe {
    static constexpr bool GATHER = GATHERT;
    const char* A;
    const char* W;
    const int* list; const LAS unsigned* tab; int ntile, nN, G, c; size_t wofs;
    __device__ __forceinline__ bool next(int i, pg8::Unit& u) const {
        const int L = i * G + c; if (L >= ntile * nN) return false;
        const int mt = L / nN; u.pn = L % nN; u.pm = mt; u.kind = 0;
        const unsigned t0 = __builtin_amdgcn_readfirstlane(tab[2 * mt]), t1 = __builtin_amdgcn_readfirstlane(tab[2 * mt + 1]);
        const int e = (int)(t0 >> 20), first = (int)(t0 & 0xfffff);
        u.aux = e; u.valid = (int)t1; u.lst = list + (size_t)e * NTOK + first;
        u.a = GATHERT ? A : A + (size_t)mt * TSTEP;
        u.b = W + (size_t)e * WE_BYTES + wofs + (size_t)u.pn * TSTEP;
        return true;
    }
    __device__ __forceinline__ unsigned a_off(const pg8::Unit& u, int h, int R, int C, int K) const {
        const int rr = h * 128 + R;
        if (!GATHERT) return (unsigned)(rr * K + C) * 2u;
        const int tok = (rr < u.valid) ? u.lst[rr] : 0;
        return (unsigned)(tok * K + C) * 2u;
    }
};

struct EpiQKV {
    static constexpr bool PERM = true;
    bf16_t* QK; bf16_t* VT; const float* rcos; const float* rsin; bool rope;
    __device__ __forceinline__ void operator()(const f32x4 (&acc)[2][2][4][2], const pg8::Unit& u, int wr, int wc, int fr, int fq) const {
        if (u.kind == 0) {
            const float sc = (u.pn < 4) ? QSCALE : 1.f;
            const bool do_rope = rope && (u.pm * 256 < NLAT);
#pragma unroll
            for (int ai = 0; ai < 2; ++ai)
#pragma unroll
                for (int m = 0; m < 4; ++m) {
                    const int row = u.pm * 256 + ai * 128 + wr * 64 + m * 16 + fr;
                    f32x4 v[2][2];
#pragma unroll
                    for (int bj = 0; bj < 2; ++bj)
#pragma unroll
                        for (int n = 0; n < 2; ++n) v[bj][n] = acc[ai][bj][m][n] * sc;
                    if (do_rope) {
                        const int t = row & (SEQ - 1);
#pragma unroll
                        for (int n = 0; n < 2; ++n) {
                            const f32x4 cs = *(const f32x4*)(rcos + t * 32 + 8 * fq + 4 * n), sn = *(const f32x4*)(rsin + t * 32 + 8 * fq + 4 * n);
                            const f32x4 x1 = v[0][n], x2 = v[1][n];
                            v[0][n] = x1 * cs - x2 * sn; v[1][n] = x1 * sn + x2 * cs;
                        }
                    }
                    bf16_t* rowp = QK + (size_t)row * 2048 + u.pn * 256 + wc * 64 + 8 * fq;
#pragma unroll
                    for (int bj = 0; bj < 2; ++bj) {
                        u32x4 o; o.x = cvt_pk_bf16(v[bj][0][0], v[bj][0][1]); o.y = cvt_pk_bf16(v[bj][0][2], v[bj][0][3]); o.z = cvt_pk_bf16(v[bj][1][0], v[bj][1][1]); o.w = cvt_pk_bf16(v[bj][1][2], v[bj][1][3]);
                        *(u32x4*)(rowp + bj * 32) = o;
                    }
                }
        } else {
#pragma unroll
            for (int ai = 0; ai < 2; ++ai)
#pragma unroll
                for (int m = 0; m < 4; ++m) {
                    const int row = u.pm * 256 + ai * 128 + wr * 64 + m * 16 + fr;
                    bf16_t* rowp = VT + (size_t)row * NTOK + u.pn * 256 + wc * 32 + 8 * fq;
#pragma unroll
                    for (int bj = 0; bj < 2; ++bj) {
                        const f32x4 v0 = acc[ai][bj][m][0], v1 = acc[ai][bj][m][1];
                        u32x4 o; o.x = cvt_pk_bf16(v0[0], v0[1]); o.y = cvt_pk_bf16(v0[2], v0[3]); o.z = cvt_pk_bf16(v1[0], v1[1]); o.w = cvt_pk_bf16(v1[2], v1[3]);
                        *(u32x4*)(rowp + bj * 128) = o;
                    }
                }
        }
    }
};
struct EpiWO {
    static constexpr bool PERM = false;
    const float* xin; const float* cin; float* X; const float* gate  ; bool from_input;
    __device__ __forceinline__ void operator()(const f32x4 (&acc)[2][2][4][2], const pg8::Unit& u, int wr, int wc, int fr, int fq) const {
        const int r = (u.pm * 256 < NLAT) ? (u.pm * 256) / SEQ : NB;
        const int col0 = u.pn * 256 + wc * 32 + 4 * fq;
        f32x4 g[2][2];
#pragma unroll
        for (int bj = 0; bj < 2; ++bj)
#pragma unroll
            for (int n = 0; n < 2; ++n) g[bj][n] = *(const f32x4*)(gate + (size_t)r * (NMOD * D) + col0 + bj * 128 + n * 16);
#pragma unroll
        for (int ai = 0; ai < 2; ++ai) {
            f32x4 bs[4][2][2];
#pragma unroll
            for (int m = 0; m < 4; ++m) {
                const int row = u.pm * 256 + ai * 128 + wr * 64 + m * 16 + fr;
                const float* base = from_input ? (row < NLAT ? xin + (size_t)row * D : cin + (size_t)(row - NLAT) * D) : X + (size_t)row * D;
#pragma unroll
                for (int bj = 0; bj < 2; ++bj)
#pragma unroll
                    for (int n = 0; n < 2; ++n) bs[m][bj][n] = *(const f32x4*)(base + col0 + bj * 128 + n * 16);
            }
#pragma unroll
            for (int m = 0; m < 4; ++m) {
                const int row = u.pm * 256 + ai * 128 + wr * 64 + m * 16 + fr;
                float* outp = X + (size_t)row * D;
#pragma unroll
                for (int bj = 0; bj < 2; ++bj)
#pragma unroll
                    for (int n = 0; n < 2; ++n) *(f32x4*)(outp + col0 + bj * 128 + n * 16) = bs[m][bj][n] + g[bj][n] * acc[ai][bj][m][n];
            }
            asm volatile("" ::: "memory");
        }
    }
};
struct EpiGLU {
    static constexpr bool PERM = true;
    bf16_t* ACT;
    __device__ __forceinline__ void operator()(const f32x4 (&acc)[2][2][4][2], const pg8::Unit& u, int wr, int wc, int fr, int fq) const {
#pragma unroll
        for (int ai = 0; ai < 2; ++ai)
#pragma unroll
            for (int m = 0; m < 4; ++m) {
                const int row = u.pm * 256 + ai * 128 + wr * 64 + m * 16 + fr;
                float t[8];
#pragma unroll
                for (int n = 0; n < 2; ++n)
#pragma unroll
                    for (int q = 0; q < 4; ++q) { const float a = acc[ai][0][m][n][q], b = acc[ai][1][m][n][q]; t[4 * n + q] = a * __builtin_amdgcn_rcpf(1.f + __builtin_amdgcn_exp2f(-a * LOG2E)) * b; }
                u32x4 o; o.x = cvt_pk_bf16(t[0], t[1]); o.y = cvt_pk_bf16(t[2], t[3]); o.z = cvt_pk_bf16(t[4], t[5]); o.w = cvt_pk_bf16(t[6], t[7]);
                *(u32x4*)(ACT + (size_t)row * D + u.pn * 128 + wc * 32 + 8 * fq) = o;
            }
    }
};
struct EpiDown {
    static constexpr bool PERM = true;
    bf16_t* Y;
    __device__ __forceinline__ void operator()(const f32x4 (&acc)[2][2][4][2], const pg8::Unit& u, int wr, int wc, int fr, int fq) const {
#pragma unroll
        for (int ai = 0; ai < 2; ++ai)
#pragma unroll
            for (int m = 0; m < 4; ++m) {
                const int row = u.pm * 256 + ai * 128 + wr * 64 + m * 16 + fr;
                bf16_t* rowp = Y + (size_t)row * D + u.pn * 256 + wc * 32 + 8 * fq;
#pragma unroll
                for (int bj = 0; bj < 2; ++bj) {
                    const f32x4 v0 = acc[ai][bj][m][0], v1 = acc[ai][bj][m][1];
                    u32x4 o; o.x = cvt_pk_bf16(v0[0], v0[1]); o.y = cvt_pk_bf16(v0[2], v0[3]); o.z = cvt_pk_bf16(v1[0], v1[1]); o.w = cvt_pk_bf16(v1[2], v1[3]);
                    *(u32x4*)(rowp + bj * 128) = o;
                }
            }
    }
};

__device__ __forceinline__ unsigned pk2_rne(float lo, float hi) { return (unsigned)f2bf(lo) | ((unsigned)f2bf(hi) << 16); }
__device__ __forceinline__ void conv_item(const float* W, int ldw, int k0, int n0, bf16_t* WT, int drow0, LAS float* scr, int lane) {
    float t[32];
    const float* src = W + (size_t)(k0 + (lane >> 5)) * ldw + n0 + (lane & 31);
#pragma unroll
    for (int i = 0; i < 32; ++i) t[i] = __builtin_nontemporal_load(src + (size_t)(2 * i) * ldw);
#pragma unroll
    for (int i = 0; i < 32; ++i) scr[(2 * i + (lane >> 5)) * 33 + (lane & 31)] = t[i];
    asm volatile("s_waitcnt lgkmcnt(0)" ::: "memory");
    const int c = lane & 7;
#pragma unroll
    for (int j = 0; j < 4; ++j) { const int n = (lane >> 3) + 8 * j; const LAS float* s = scr + (8 * c) * 33 + n;
        u32x4 o; o.x = pk2_rne(s[0 * 33], s[1 * 33]); o.y = pk2_rne(s[2 * 33], s[3 * 33]); o.z = pk2_rne(s[4 * 33], s[5 * 33]); o.w = pk2_rne(s[6 * 33], s[7 * 33]);
        __builtin_nontemporal_store(o, (u32x4*)(WT + (size_t)(drow0 + n) * D + k0 + 8 * c)); }
    asm volatile("s_waitcnt lgkmcnt(0)" ::: "memory");
}
constexpr int CONV_QKV = 16 * 96, CONV_O = 16 * 32, CONV_E = 16 * 32, CONV_LAYER = CONV_QKV + CONV_O + NE * 3 * CONV_E;
__device__ __forceinline__ void conv_layer_item(const Params& p, unsigned char* ws, int l, int r, LAS float* scr, int lane) {
    unsigned char* wl = ws + WS_W + (size_t)l * WL_BYTES;
    if (r < CONV_QKV) {
        const int kb = r / 96, nb = r % 96, n0 = nb * 32;
        if (n0 < 2048) { const int pn = n0 >> 8, a = n0 & 255, hd = a >> 6, half = (a >> 5) & 1;
            conv_item(p.w_qkv + (size_t)l * D * 3072, 3072, kb * 64, n0, (bf16_t*)(wl + WO_QK), pn * 256 + half * 128 + hd * 32, scr, lane); }
        else conv_item(p.w_qkv + (size_t)l * D * 3072, 3072, kb * 64, n0, (bf16_t*)(wl + WO_V), n0 - 2048, scr, lane);
        return;
    }
    r -= CONV_QKV;
    if (r < CONV_O) { const int kb = r / 32, nb = r % 32; conv_item(p.w_o + (size_t)l * D * D, D, kb * 64, nb * 32, (bf16_t*)(wl + WO_O), nb * 32, scr, lane); return; }
    r -= CONV_O;
    const int e = r / (3 * CONV_E), r2 = r % (3 * CONV_E), which = r2 / CONV_E, r3 = r2 % CONV_E, kb = r3 / 32, nb = r3 % 32, n0 = nb * 32;
    unsigned char* we = wl + WO_E + (size_t)e * WE_BYTES;
    const size_t eo = ((size_t)l * NE + e) * D * D;
    if (which == 0) conv_item(p.wg + eo, D, kb * 64, n0, (bf16_t*)we, (n0 >> 7) * 256 + (n0 & 127), scr, lane);
    else if (which == 1) conv_item(p.wu + eo, D, kb * 64, n0, (bf16_t*)we, (n0 >> 7) * 256 + 128 + (n0 & 127), scr, lane);
    else conv_item(p.wd + eo, D, kb * 64, n0, (bf16_t*)(we + WE_2), n0, scr, lane);
}
__device__ __forceinline__ void phase_convert(const Params& p, unsigned char* ws, LAS unsigned char* lds, int layer_lo, int layer_hi) {
    const int tid = tidx(), lane = tid & 63, wave = tid >> 6;
    LAS float* scr = (LAS float*)(lds + wave * 16384);
    const int gw = bidx() * NWAVE + wave, ngw = gridDim.x * NWAVE;
    for (int it = layer_lo * CONV_LAYER + gw; it < layer_hi * CONV_LAYER; it += ngw) conv_layer_item(p, ws, it / CONV_LAYER, it % CONV_LAYER, scr, lane);
}
constexpr int CONV_CHUNK = 4, CW_CONVQ = 6144;
__device__ __forceinline__ void convert_pull(const Params& p, unsigned char* ws, LAS unsigned char* lds, int l, int budget) {
    if (l >= DEPTH) return;
    const int tid = tidx(), lane = tid & 63, wave = tid >> 6;
    LAS float* scr = (LAS float*)(lds + wave * 16384);
    volatile LAS unsigned* slot = (volatile LAS unsigned*)(lds + MISC_OFF + 96);
    unsigned* q = (unsigned*)(ws + WS_CTL) + CW_CONVQ + 64 * l;
    for (int c = 0; budget < 0 || c < budget; ++c) {
        if (tid == 0) *slot = __hip_atomic_fetch_add(q, (unsigned)(CONV_CHUNK * NWAVE), __ATOMIC_RELAXED, __HIP_MEMORY_SCOPE_AGENT);
        __syncthreads();
        const unsigned base = *slot;
        __syncthreads();
        if (base >= (unsigned)CONV_LAYER) break;
        for (int k = 0; k < CONV_CHUNK; ++k) conv_layer_item(p, ws, l, (int)base + wave * CONV_CHUNK + k, scr, lane);
    }
}

__device__ __forceinline__ int build_tile_table(const Ws& w, int layer, LAS unsigned* tab) {
    int cnt[NE], off[NE + 1];
    expert_offsets(w, layer, cnt, off);
    const int tid = tidx();
    if (tid < 256) {
        int e = -1;
#pragma unroll
        for (int q = 0; q < NE; ++q) if (tid * 256 >= off[q] && tid * 256 < off[q + 1]) e = q;
        int oe = 0, ce = 0;
#pragma unroll
        for (int q = 0; q < NE; ++q) if (q == e) { oe = off[q]; ce = cnt[q]; }
        if (e >= 0) { const int first = tid * 256 - oe; const int valid = min(256, ce - first);
            tab[2 * tid] = ((unsigned)e << 20) | (unsigned)first; tab[2 * tid + 1] = (unsigned)valid; }
    }
    __syncthreads();
    return off[NE] / 256;
}

namespace att {
typedef float f32x16 __attribute__((ext_vector_type(16)));
constexpr int STAGE_B = 32768, K_OFF = 0, V_OFF = 16384, RPB_OFF = 65536, RPB_W = 144, XCH_OFF = 0;
__device__ __forceinline__ int swz(int row, int chunk) { return row * 128 + ((chunk ^ ((row >> 1) & 7)) << 4); }
__device__ __forceinline__ int pi64(int r) { return (r & ~12) | ((r & 4) << 1) | ((r & 8) >> 1); }

template <int DV, int NKSUB> struct Stage { u32x4 k[NKSUB]; u32x4 v[DV / 64]; };

template <int DV, int NKSUB>
__device__ __forceinline__ void stage_load(Stage<DV, NKSUB>& st, const bf16_t* QK, const bf16_t* VT, int tok0, int kcolbase, int vch0, int tid) {
#pragma unroll
    for (int i = 0; i < NKSUB; ++i) { const int idx = tid + NTHR * i, row = idx / (8 * NKSUB), cc = idx % (8 * NKSUB);
        st.k[i] = *(const u32x4*)(QK + (size_t)(tok0 + row) * 2048 + 1024 + kcolbase + cc * 8); }
#pragma unroll
    for (int i = 0; i < DV / 64; ++i) { const int idx = tid + NTHR * i, row = idx >> 3, ch = idx & 7;
        st.v[i] = *(const u32x4*)(VT + (size_t)(vch0 + row) * NTOK + tok0 + ch * 8); }
}
template <int DV, int NKSUB>
__device__ __forceinline__ void stage_store(const Stage<DV, NKSUB>& st, LAS unsigned char* buf, int tid) {
#pragma unroll
    for (int i = 0; i < NKSUB; ++i) { const int idx = tid + NTHR * i, row = idx / (8 * NKSUB), cc = idx % (8 * NKSUB), sub = cc >> 3, ch = cc & 7;
        *(LAS u32x4*)(buf + K_OFF + sub * 8192 + swz(pi64(row), ch)) = st.k[i]; }
#pragma unroll
    for (int i = 0; i < DV / 64; ++i) { const int idx = tid + NTHR * i, row = idx >> 3, ch = idx & 7;
        *(LAS u32x4*)(buf + V_OFF + swz(row, ch)) = st.v[i]; }
}

__device__ __forceinline__ void stage_store_nat(const Stage<64, 1>& st, LAS unsigned char* buf, int tid) {
    { const int row = tid >> 3, ch = tid & 7; *(LAS u32x4*)(buf + K_OFF + swz(row, ch)) = st.k[0]; }
    { const int row = tid >> 3, ch = tid & 7; *(LAS u32x4*)(buf + V_OFF + swz(row, ch)) = st.v[0]; }
}
constexpr float ATT_THR = 8.f;
#ifndef ATT_PRIO
#define ATT_PRIO 1
#endif
template <int DV, bool BIAS>
__device__ __forceinline__ void qk_softmax(const LAS unsigned char* kb, const bf16x8 (&qf)[4], f32x16 (&o)[DV / 32], float& mref, float& l, bool& started,
                                           const float (&pen)[32], const LAS float* brow, int r, int h, bf16x8 (&pb)[4]) {
    f32x16 p0, p1;
#pragma unroll
    for (int i = 0; i < 16; ++i) { p0[i] = -mref; p1[i] = -mref; }
    bf16x8 kfa[4], kfb[4];
#pragma unroll
    for (int s = 0; s < 2; ++s) { kfa[2 * s] = *(const LAS bf16x8*)(kb + swz(r, 2 * s + h)); kfa[2 * s + 1] = *(const LAS bf16x8*)(kb + swz(32 + r, 2 * s + h)); }
#pragma unroll
    for (int s = 2; s < 4; ++s) { kfb[2 * (s - 2)] = *(const LAS bf16x8*)(kb + swz(r, 2 * s + h)); kfb[2 * (s - 2) + 1] = *(const LAS bf16x8*)(kb + swz(32 + r, 2 * s + h)); }
    __builtin_amdgcn_sched_barrier(0);
    if (ATT_PRIO) __builtin_amdgcn_s_setprio(1);
#pragma unroll
    for (int s = 0; s < 2; ++s) { p0 = __builtin_amdgcn_mfma_f32_32x32x16_bf16(kfa[2 * s], qf[s], p0, 0, 0, 0); p1 = __builtin_amdgcn_mfma_f32_32x32x16_bf16(kfa[2 * s + 1], qf[s], p1, 0, 0, 0); }
#pragma unroll
    for (int s = 2; s < 4; ++s) { p0 = __builtin_amdgcn_mfma_f32_32x32x16_bf16(kfb[2 * (s - 2)], qf[s], p0, 0, 0, 0); p1 = __builtin_amdgcn_mfma_f32_32x32x16_bf16(kfb[2 * (s - 2) + 1], qf[s], p1, 0, 0, 0); }
    if (ATT_PRIO) __builtin_amdgcn_s_setprio(0);
    __builtin_amdgcn_sched_barrier(0);
    if (BIAS) {
#pragma unroll
        for (int i = 0; i < 16; ++i) { const int kcl = 16 * (i >> 3) + (i & 7);
            p0[i] = (p0[i] + pen[i]) + brow[kcl]; p1[i] = (p1[i] + pen[16 + i]) + brow[32 + kcl]; }
    }
    float ma = fmaxf(fmaxf(p0[0], p0[1]), p1[0]), mb = fmaxf(fmaxf(p0[2], p0[3]), p1[1]);
    ma = fmaxf(fmaxf(ma, p1[2]), p1[3]);
#pragma unroll
    for (int i = 4; i < 16; i += 4) { ma = fmaxf(fmaxf(ma, p0[i]), p0[i + 1]); mb = fmaxf(fmaxf(mb, p0[i + 2]), p0[i + 3]); ma = fmaxf(fmaxf(ma, p1[i]), p1[i + 1]); mb = fmaxf(fmaxf(mb, p1[i + 2]), p1[i + 3]); }
    float mx = fmaxf(ma, mb);
    mx = fmaxf(mx, __shfl_xor(mx, 32));
    const bool need = (!started && mx > -INFINITY) || (mx > ATT_THR);
    if (__any(need)) {
        const float delta = need ? (started ? fmaxf(mx, 0.f) : mx) : 0.f;
        const float alpha = started ? __builtin_amdgcn_exp2f(-delta) : 1.f;
        started = started || need;
        mref += delta;
#pragma unroll
        for (int i = 0; i < 16; ++i) { p0[i] -= delta; p1[i] -= delta; }
        l *= alpha;
#pragma unroll
        for (int b = 0; b < DV / 32; ++b)
#pragma unroll
            for (int i = 0; i < 16; ++i) o[b][i] *= alpha;
    }
    float rs = 0.f;
#pragma unroll
    for (int i = 0; i < 16; ++i) { p0[i] = __builtin_amdgcn_exp2f(p0[i]); p1[i] = __builtin_amdgcn_exp2f(p1[i]); rs += p0[i] + p1[i]; }
    l += rs;
#pragma unroll
    for (int ks = 0; ks < 4; ++ks) {
        u32x4 t;
        if (ks < 2) { t.x = cvt_pk_bf16(p0[8 * ks + 0], p0[8 * ks + 1]); t.y = cvt_pk_bf16(p0[8 * ks + 2], p0[8 * ks + 3]); t.z = cvt_pk_bf16(p0[8 * ks + 4], p0[8 * ks + 5]); t.w = cvt_pk_bf16(p0[8 * ks + 6], p0[8 * ks + 7]); }
        else { const int q = ks - 2; t.x = cvt_pk_bf16(p1[8 * q + 0], p1[8 * q + 1]); t.y = cvt_pk_bf16(p1[8 * q + 2], p1[8 * q + 3]); t.z = cvt_pk_bf16(p1[8 * q + 4], p1[8 * q + 5]); t.w = cvt_pk_bf16(p1[8 * q + 6], p1[8 * q + 7]); }
        pb[ks] = __builtin_bit_cast(bf16x8, t);
    }
}
template <int DV>
__device__ __forceinline__ void pv_accum(const LAS unsigned char* vb, const bf16x8 (&pb)[4], f32x16 (&o)[DV / 32], int r, int h) {
    bf16x8 vfa[4], vfb[4];
#pragma unroll
    for (int ks = 0; ks < 4; ++ks) vfa[ks] = *(const LAS bf16x8*)(vb + swz(r, 2 * ks + h));
#pragma unroll
    for (int b = 0; b < DV / 32; b += 2) {
        if (b + 1 < DV / 32) {
#pragma unroll
            for (int ks = 0; ks < 4; ++ks) vfb[ks] = *(const LAS bf16x8*)(vb + swz(32 * (b + 1) + r, 2 * ks + h));
        }
        __builtin_amdgcn_sched_barrier(0);
        if (ATT_PRIO) __builtin_amdgcn_s_setprio(1);
#pragma unroll
        for (int ks = 0; ks < 4; ++ks) o[b] = __builtin_amdgcn_mfma_f32_32x32x16_bf16(vfa[ks], pb[ks], o[b], 0, 0, 0);
        if (ATT_PRIO) __builtin_amdgcn_s_setprio(0);
        if (b + 2 < DV / 32) {
#pragma unroll
            for (int ks = 0; ks < 4; ++ks) vfa[ks] = *(const LAS bf16x8*)(vb + swz(32 * (b + 2) + r, 2 * ks + h));
        }
        __builtin_amdgcn_sched_barrier(0);
        if (b + 1 < DV / 32) {
            if (ATT_PRIO) __builtin_amdgcn_s_setprio(1);
#pragma unroll
            for (int ks = 0; ks < 4; ++ks) o[b + 1] = __builtin_amdgcn_mfma_f32_32x32x16_bf16(vfb[ks], pb[ks], o[b + 1], 0, 0, 0);
            if (ATT_PRIO) __builtin_amdgcn_s_setprio(0);
        }
    }
}
template <int DV, bool BIAS>
__device__ __forceinline__ void tile_compute(const LAS unsigned char* buf, int ksub, const bf16x8 (&qf)[4], f32x16 (&o)[DV / 32], float& mref, float& l, bool& started,
                                             const float (&pen)[32], const LAS float* brow, int r, int h) {
    bf16x8 pb[4];
    qk_softmax<DV, BIAS>(buf + K_OFF + ksub * 8192, qf, o, mref, l, started, pen, brow, r, h, pb);
    __builtin_amdgcn_sched_barrier(0);
    pv_accum<DV>(buf + V_OFF, pb, o, r, h);
}

__device__ __forceinline__ void band_tile32(const LAS unsigned char* buf, int x0, const bf16x8 (&qf)[4], f32x16 (&o)[2], float& mref, float& l, bool& started,
                                            const float (&pen16)[16], const LAS float* brow, int r, int h) {
    f32x16 p0;
#pragma unroll
    for (int i = 0; i < 16; ++i) p0[i] = -mref;
    const LAS unsigned char* kb = buf + K_OFF; const LAS unsigned char* vb = buf + V_OFF;
    const int krow = x0 + pi64(r);
    bf16x8 kf[4];
#pragma unroll
    for (int s = 0; s < 4; ++s) kf[s] = *(const LAS bf16x8*)(kb + swz(krow, 2 * s + h));
    __builtin_amdgcn_sched_barrier(0);
    if (ATT_PRIO) __builtin_amdgcn_s_setprio(1);
#pragma unroll
    for (int s = 0; s < 4; ++s) p0 = __builtin_amdgcn_mfma_f32_32x32x16_bf16(kf[s], qf[s], p0, 0, 0, 0);
    if (ATT_PRIO) __builtin_amdgcn_s_setprio(0);
    const int vch = (x0 >> 3) + h;
    bf16x8 vf[4];
#pragma unroll
    for (int b = 0; b < 2; ++b)
#pragma unroll
        for (int ks = 0; ks < 2; ++ks) vf[2 * b + ks] = *(const LAS bf16x8*)(vb + swz(32 * b + r, vch + 2 * ks));
    __builtin_amdgcn_sched_barrier(0);
#pragma unroll
    for (int i = 0; i < 16; ++i) p0[i] = (p0[i] + pen16[i]) + brow[16 * (i >> 3) + (i & 7)];
    float ma = fmaxf(fmaxf(p0[0], p0[1]), p0[2]), mb = fmaxf(fmaxf(p0[3], p0[4]), p0[5]);
#pragma unroll
    for (int i = 6; i < 16; i += 2) { ma = fmaxf(ma, p0[i]); mb = fmaxf(mb, p0[i + 1]); }
    float mx = fmaxf(ma, mb);
    mx = fmaxf(mx, __shfl_xor(mx, 32));
    const bool need = (!started && mx > -INFINITY) || (mx > ATT_THR);
    if (__any(need)) {
        const float delta = need ? (started ? fmaxf(mx, 0.f) : mx) : 0.f;
        const float alpha = started ? __builtin_amdgcn_exp2f(-delta) : 1.f;
        started = started || need;
        mref += delta;
#pragma unroll
        for (int i = 0; i < 16; ++i) p0[i] -= delta;
        l *= alpha;
#pragma unroll
        for (int b = 0; b < 2; ++b)
#pragma unroll
            for (int i = 0; i < 16; ++i) o[b][i] *= alpha;
    }
    float rs = 0.f;
#pragma unroll
    for (int i = 0; i < 16; ++i) { p0[i] = __builtin_amdgcn_exp2f(p0[i]); rs += p0[i]; }
    l += rs;
    bf16x8 pb[2];
#pragma unroll
    for (int ks = 0; ks < 2; ++ks) { u32x4 t; t.x = cvt_pk_bf16(p0[8 * ks + 0], p0[8 * ks + 1]); t.y = cvt_pk_bf16(p0[8 * ks + 2], p0[8 * ks + 3]); t.z = cvt_pk_bf16(p0[8 * ks + 4], p0[8 * ks + 5]); t.w = cvt_pk_bf16(p0[8 * ks + 6], p0[8 * ks + 7]);
        pb[ks] = __builtin_bit_cast(bf16x8, t); }
    __builtin_amdgcn_sched_barrier(0);
    if (ATT_PRIO) __builtin_amdgcn_s_setprio(1);
#pragma unroll
    for (int b = 0; b < 2; ++b)
#pragma unroll
        for (int ks = 0; ks < 2; ++ks) o[b] = __builtin_amdgcn_mfma_f32_32x32x16_bf16(vf[2 * b + ks], pb[ks], o[b], 0, 0, 0);
    if (ATT_PRIO) __builtin_amdgcn_s_setprio(0);
}

__device__ __forceinline__ void natten_phase(const Params& P, const Ws& w, LAS unsigned char* lds, int layer) {
    const bool last = (layer == DEPTH - 1);
    const float* rpb = P.na_rpb + (size_t)(layer / 2) * 16 * 15 * 31;
    LAS float* rtab = (LAS float*)(lds + RPB_OFF);
    const int nlat = NB * 16 * 8, nctx = last ? 0 : NB * 16;
    int tab_head = -1;
    const int vcu = (gridDim.x % 8 == 0) ? (bidx() % 8) * ((int)gridDim.x / 8) + bidx() / 8 : bidx();
    for (int u = vcu; u < nlat + nctx; u += gridDim.x) {
        const int tid = tidx(), lane = tid & 63, wave = __builtin_amdgcn_readfirstlane(tid >> 6), r = lane & 31, h = lane >> 5;
        const bool isctx = (u >= nlat);
        int b, head, rg = 0;
        if (!isctx) { rg = u & 7; head = (u >> 3) & 15; b = u >> 7; } else { const int u2 = u - nlat; head = u2 & 15; b = u2 >> 4; }
        const int cg = wave & 3, rp = wave >> 2;
        const int qr = 4 * rg + 2 * rp + (r >> 4), qc = 16 * cg + (r & 15);
        const int qtok = isctx ? NLAT + b * CL + 32 * wave + r : b * SEQ + qr * GW + qc;
        const int x0 = (cg == 0) ? 0 : (cg == 1) ? 8 : (cg == 2) ? 24 : 32;
        const int c0 = min(max(qc - 8, 0), 48), r0l = min(max(qr - 4, 0), 24);
        const int rfirst = min(max(4 * rg - 4, 0), 24), rlast = min(max(4 * rg + 3 - 4, 0), 24) + 7;
        const int nband = isctx ? 0 : rlast - rfirst + 1, NT = nband + 4;
        const int wlo = min(max(4 * rg + 2 * rp - 4, 0), 24), whi = min(max(4 * rg + 2 * rp + 1 - 4, 0), 24) + 7;
        auto tile_tok = [&](int t) -> int { return (t < nband) ? b * SEQ + (rfirst + t) * GW : NLAT + b * CL + (t - nband) * 64; };
        Stage<64, 1> st;
        stage_load<64, 1>(st, w.QK, w.VT, tile_tok(0), head * 64, head * 64, tid);
        bf16x8 qf[4];
#pragma unroll
        for (int s = 0; s < 4; ++s) qf[s] = *(const bf16x8*)(w.QK + (size_t)qtok * 2048 + head * 64 + 16 * s + 8 * h);
        if (!isctx && head != tab_head) {
            for (int i = tid; i < 16 * RPB_W; i += NTHR) { const int dr = i / RPB_W, d = i % RPB_W - 63;
                rtab[i] = (dr == 15) ? -INFINITY : (d >= -15 && d <= 15) ? rpb[(head * 15 + dr) * 31 + d + 15] * LOG2E : 0.f; }
            tab_head = head;
        }
        float pen16[16];
#pragma unroll
        for (int i = 0; i < 16; ++i) { const int kc = x0 + 16 * (i >> 3) + 8 * h + (i & 7); pen16[i] = ((unsigned)(kc - c0) < 16u) ? 0.f : -INFINITY; }
        float pen[32];
#pragma unroll
        for (int i = 0; i < 32; ++i) pen[i] = 0.f;
        f32x16 o[2];
#pragma unroll
        for (int i = 0; i < 16; ++i) { o[0][i] = 0.f; o[1][i] = 0.f; }
        float m = 0.f, l = 0.f; bool started = false;
        if (0 < nband) stage_store_nat(st, lds, tid); else stage_store<64, 1>(st, lds, tid);
        __syncthreads();
        for (int t = 0; t < NT; ++t) {
            if (t + 1 < NT) stage_load<64, 1>(st, w.QK, w.VT, tile_tok(t + 1), head * 64, head * 64, tid);
            const LAS unsigned char* buf = lds + (t & 1) * STAGE_B;
            if (t < nband) {
                const int kr = rfirst + t;
                if (kr >= wlo && kr <= whi) {
                    const bool rowok = (kr >= r0l) && (kr < r0l + 8);
                    const LAS float* brow = rtab + (rowok ? (kr - qr + 7) : 15) * RPB_W + 63 - qc + x0 + 8 * h;
                    band_tile32(buf, x0, qf, o, m, l, started, pen16, brow, r, h);
                }
            } else tile_compute<64, false>(buf, 0, qf, o, m, l, started, pen, rtab, r, h);
            if (t + 1 < NT) { if (t + 1 < nband) stage_store_nat(st, lds + ((t + 1) & 1) * STAGE_B, tid); else stage_store<64, 1>(st, lds + ((t + 1) & 1) * STAGE_B, tid); }
            __syncthreads();
        }
        l += __shfl_xor(l, 32);
        const float il = 1.f / l;
        bf16_t* op = w.O + (size_t)qtok * D + head * 64;
#pragma unroll
        for (int bb = 0; bb < 2; ++bb)
#pragma unroll
            for (int g = 0; g < 4; ++g) {
                u32x2 v; v.x = cvt_pk_bf16(o[bb][4 * g] * il, o[bb][4 * g + 1] * il); v.y = cvt_pk_bf16(o[bb][4 * g + 2] * il, o[bb][4 * g + 3] * il);
                *(u32x2*)(op + 32 * bb + 8 * g + 4 * h) = v;
            }
    }
}

__device__ __forceinline__ void diff_phase(const Params& P, const Ws& w, LAS unsigned char* lds, int layer) {
    const int tid = tidx(), lane = tid & 63, wave = __builtin_amdgcn_readfirstlane(tid >> 6), r = lane & 31, h = lane >> 5;
    const bool last = (layer == DEPTH - 1);
    const int j = layer / 2;
    const float* lam = P.diff_lambda + (size_t)j * 4 * 64; const float* sg = P.diff_subln + (size_t)j * 128;
    float d01 = 0.f, d23 = 0.f;
    for (int i = 0; i < 64; ++i) { d01 += lam[i] * lam[64 + i]; d23 += lam[128 + i] * lam[192 + i]; }
    const float li = lam_init_of(layer);
    const float lam_full = expf(d01) - expf(d23) + li;
    const int nlat = NB * 8 * 16, nctx = last ? 0 : NB * 8 * 2;
    const int map = wave >> 2, wq = wave & 3;
    const int vcu = (gridDim.x % 8 == 0) ? (bidx() % 8) * ((int)gridDim.x / 8) + bidx() / 8 : bidx();
    for (int u = vcu; u < nlat + nctx; u += gridDim.x) {
        const bool isctx = (u >= nlat);
        int b, head, qb;
        if (!isctx) { qb = u & 15; head = (u >> 4) & 7; b = u >> 7; } else { const int u2 = u - nlat; qb = u2 & 1; head = (u2 >> 1) & 7; b = u2 >> 4; }
        const int qtok = (isctx ? NLAT + b * CL : b * SEQ) + 128 * qb + 32 * wq + r;
        const int NT = isctx ? 4 : 36;
        bf16x8 qf[4];
#pragma unroll
        for (int s = 0; s < 4; ++s) qf[s] = *(const bf16x8*)(w.QK + (size_t)qtok * 2048 + head * 128 + map * 64 + 16 * s + 8 * h);
        f32x16 o[4];
#pragma unroll
        for (int bb = 0; bb < 4; ++bb)
#pragma unroll
            for (int i = 0; i < 16; ++i) o[bb][i] = 0.f;
        float m = 0.f, l = 0.f; bool started = false;
        float pen[32];
#pragma unroll
        for (int i = 0; i < 32; ++i) pen[i] = 0.f;
        auto tile_tok = [&](int t) -> int { return (!isctx && t < 32) ? b * SEQ + t * 64 : NLAT + b * CL + (isctx ? t : t - 32) * 64; };
        Stage<128, 2> st;
        stage_load<128, 2>(st, w.QK, w.VT, tile_tok(0), head * 128, head * 128, tid);
        stage_store<128, 2>(st, lds, tid);
        __syncthreads();
        for (int t = 0; t < NT; ++t) {
            if (t + 1 < NT) stage_load<128, 2>(st, w.QK, w.VT, tile_tok(t + 1), head * 128, head * 128, tid);
            tile_compute<128, false>(lds + (t & 1) * STAGE_B, map, qf, o, m, l, started, pen, (const LAS float*)lds, r, h);
            if (t + 1 < NT) stage_store<128, 2>(st, lds + ((t + 1) & 1) * STAGE_B, tid);
            __syncthreads();
        }
        l += __shfl_xor(l, 32);
        const float il = 1.f / l;
        LAS float* xch = (LAS float*)(lds + XCH_OFF) + wq * (128 * 32);
        if (map == 1) {
#pragma unroll
            for (int bb = 0; bb < 4; ++bb)
#pragma unroll
                for (int i = 0; i < 16; ++i) { const int dv = 32 * bb + (i & 3) + 8 * (i >> 2) + 4 * h; xch[dv * 32 + r] = o[bb][i] * il; }
        }
        __syncthreads();
        if (map == 0) {
            float ss = 0.f;
#pragma unroll
            for (int bb = 0; bb < 4; ++bb)
#pragma unroll
                for (int i = 0; i < 16; ++i) { const int dv = 32 * bb + (i & 3) + 8 * (i >> 2) + 4 * h; const float v = o[bb][i] * il - lam_full * xch[dv * 32 + r]; o[bb][i] = v; ss += v * v; }
            ss += __shfl_xor(ss, 32);
            const float rinv = rsqrtf(ss * (1.f / 128.f) + EPS) * (1.f - li);
            bf16_t* op = w.O + (size_t)qtok * D + head * 128;
#pragma unroll
            for (int bb = 0; bb < 4; ++bb)
#pragma unroll
                for (int g = 0; g < 4; ++g) {
                    const int dv = 32 * bb + 8 * g + 4 * h;
                    const f32x4 gg = *(const f32x4*)(sg + dv);
                    u32x2 v; v.x = cvt_pk_bf16(o[bb][4 * g] * rinv * gg[0], o[bb][4 * g + 1] * rinv * gg[1]); v.y = cvt_pk_bf16(o[bb][4 * g + 2] * rinv * gg[2], o[bb][4 * g + 3] * rinv * gg[3]);
                    *(u32x2*)(op + dv) = v;
                }
        }
        __syncthreads();
    }
}
}

#define XB_TMO      128
#define XB_XCNT(j)  (256  + 64 * (j))
#define XB_XSUB(j)  (1280 + 64 * (j))
#define XB_XGEN(j)  (2304 + 64 * (j))
#define XB_TOP      3328
#define XB_TOPGEN   3392
#define XCD_BAR_WORDS 3456
#define XB_SPIN_CAP (1u << 22)
constexpr int CW_BAR = 8192;
__device__ __forceinline__ unsigned xb_ld(unsigned* p)              { return __hip_atomic_load(p, __ATOMIC_RELAXED, __HIP_MEMORY_SCOPE_AGENT); }
__device__ __forceinline__ unsigned xb_add(unsigned* p, unsigned v) { return __hip_atomic_fetch_add(p, v, __ATOMIC_RELAXED, __HIP_MEMORY_SCOPE_AGENT); }
__device__ __forceinline__ unsigned xb_xcc_id() { return (unsigned)__builtin_amdgcn_s_getreg((3 << 11) | 20) & 0xFu; }
#define XB_SPIN(cond, bar) do { unsigned _sp = 0; while (cond) { __builtin_amdgcn_s_sleep(1); \
    if ((++_sp & 255u) == 0u) { if (xb_ld(&(bar)[XB_TMO])) break; if (_sp > XB_SPIN_CAP) { atomicAdd(&(bar)[XB_TMO], 1u); break; } } } } while (0)
struct XcdBarrier { unsigned* bar; unsigned x; volatile LAS unsigned* st; };
__device__ __forceinline__ XcdBarrier xcd_barrier_post(unsigned* bar, volatile LAS unsigned* st) {
    XcdBarrier b; b.bar = bar; b.x = xb_xcc_id(); b.st = st;
    if (tidx() == 0) (void)xb_add(&bar[XB_XCNT(b.x)], 1u);
    return b;
}
__device__ __forceinline__ void xcd_barrier_complete(unsigned* bar, unsigned x, unsigned& nloc, unsigned& nx) {
    const unsigned G = gridDim.x * gridDim.y * gridDim.z;
    unsigned sum, cnt, mine, sp = 0u;
    for (;;) {
        sum = 0u; cnt = 0u; mine = 0u;
#pragma unroll
        for (unsigned j = 0; j < 16; ++j) { const unsigned c = xb_ld(&bar[XB_XCNT(j)]); sum += c; cnt += (c > 0u) ? 1u : 0u; mine = (j == x) ? c : mine; }
        if (sum == G) break;
        __builtin_amdgcn_s_sleep(1);
        if ((++sp & 255u) == 0u) { if (xb_ld(&bar[XB_TMO])) break; if (sp > XB_SPIN_CAP) { atomicAdd(&bar[XB_TMO], 1u); break; } }
    }
    nloc = mine > 0u ? mine : 1u; nx = cnt > 0u ? cnt : 1u;
}
__device__ __forceinline__ void xcd_barrier(const XcdBarrier& b) {
    asm volatile("s_waitcnt vmcnt(0)" ::: "memory");
    __syncthreads();
    if (tidx() == 0) {
        unsigned* bar = b.bar;
        __builtin_amdgcn_s_waitcnt(0);
        unsigned nloc = b.st[0], nx = b.st[1];
        if (nloc == 0u) { xcd_barrier_complete(bar, b.x, nloc, nx); b.st[0] = nloc; b.st[1] = nx; }
        const unsigned old = xb_add(&bar[XB_XSUB(b.x)], 1u);
        const unsigned gen = old / nloc;
        if (old + 1u == (gen + 1u) * nloc) {
            __builtin_amdgcn_fence(__ATOMIC_RELEASE, "agent");
            asm volatile("s_waitcnt vmcnt(0)" ::: "memory");
            const unsigned og = xb_add(&bar[XB_TOP], 1u);
            const unsigned tg = og / nx;
            if (og + 1u == (tg + 1u) * nx) xb_add(&bar[XB_TOPGEN], 1u);
            else XB_SPIN(xb_ld(&bar[XB_TOPGEN]) == tg, bar);
            __builtin_amdgcn_fence(__ATOMIC_ACQUIRE, "agent");
            xb_add(&bar[XB_XGEN(b.x)], 1u);
            asm volatile("s_waitcnt vmcnt(0)" ::: "memory");
        } else {
            XB_SPIN(xb_ld(&bar[XB_XGEN(b.x)]) == gen, bar);
            __builtin_amdgcn_fence(__ATOMIC_ACQUIRE, "agent");
            asm volatile("s_waitcnt vmcnt(0)" ::: "memory");
        }
    }
    __syncthreads();
}

constexpr int MK_NSTEPS = 2 + 7 * DEPTH;
#ifndef CONV_BUDGET
#define CONV_BUDGET 2
#endif
__global__ void __launch_bounds__(NTHR, 2) mk_fwd(Params p) {
    extern __shared__ __attribute__((aligned(16))) unsigned char lds_raw[];
    LAS unsigned char* lds = (LAS unsigned char*)lds_raw;
    const int tid = tidx();
    for (int u = tid; u < (LDS_BYTES - LDSCTL_OFF) / 4; u += NTHR) ((LAS unsigned*)(lds + LDSCTL_OFF))[u] = 0u;
    __syncthreads();
    volatile LAS unsigned* MISC = (volatile LAS unsigned*)(lds + MISC_OFF);
    XcdBarrier bar = xcd_barrier_post((unsigned*)(p.ws + WS_CTL) + CW_BAR, MISC + 8);
    const int G = gridDim.x, c = bidx();
    for (int s = p.step_lo; s < p.step_hi; ++s) {
        if (s > p.step_lo) {
            if (p.step_hi > 1000000) cg::this_grid().sync();
            xcd_barrier(bar);
        }
#if defined(__HIP_DEVICE_COMPILE__)
        const __attribute__((address_space(4))) Params* pp4 = (const __attribute__((address_space(4))) Params*)__builtin_amdgcn_kernarg_segment_ptr();
        asm volatile("" : "+s"(pp4));
        const Params P = *pp4;
#else
        const Params P = p;
#endif
        unsigned char* wsb = P.ws;
        const Ws w = make_ws(wsb);
        if (s == 0) {
            phase_convert(P, wsb, lds, 0, 1); __syncthreads();
            phase_prologue(P, w, (float*)lds_raw); __syncthreads();
            continue;
        }
        if (s == MK_NSTEPS - 1) { phase_norm(P, w, DEPTH - 1, 2, lds); continue; }
        const int l = (s - 1) / 7, ph = (s - 1) % 7;
        const char* wl = (const char*)(wsb + WS_W + (size_t)l * WL_BYTES);
        if (ph == 0) { phase_norm(P, w, l, 0, lds);
            if (l > 0) { __syncthreads(); convert_pull(P, wsb, lds, l, -1); } }
        else if (ph == 1) {
            SchedQKV S{(const char*)w.H, wl + WO_QK, wl + WO_V, G, c};
            EpiQKV E{w.QK, w.VT, w.rope_cos, w.rope_sin, (l & 1) != 0};
            pg8::gemm_phase<EpiQKV, SchedQKV, true, true>(lds, D, S, E); __syncthreads();
            if (864 % G != 0 && c >= 864 % G) convert_pull(P, wsb, lds, l + 1, CONV_BUDGET);
        } else if (ph == 2) {
            if (l & 1) att::diff_phase(P, w, lds, l); else att::natten_phase(P, w, lds, l);
        } else if (ph == 3) {
            SchedDense S{(const char*)w.O, wl + WO_O, (l == DEPTH - 1) ? NLAT / 256 : NTOK / 256, 4, G, c};
            EpiWO E{P.x, P.ctx, w.X, w.mods + (size_t)l * 9 * (NMOD * D) + 2 * D, l == 0};
            pg8::gemm_phase<EpiWO, SchedDense, true, true>(lds, D, S, E);
            __syncthreads();
            if (l < DEPTH - 1 && 288 % G != 0 && c >= 288 % G) convert_pull(P, wsb, lds, l + 1, CONV_BUDGET);
        } else if (ph == 4) phase_norm(P, w, l, 1, lds);
        else if (ph == 5) {
            LAS unsigned* tab = (LAS unsigned*)(lds + TILETAB_OFF);
            const int ntile = build_tile_table(w, l, tab);
            SchedMoe<true> S{(const char*)w.H, wl + WO_E, w.list, tab, ntile, 8, G, c, 0};
            EpiGLU E{w.ACT};
            pg8::gemm_phase<EpiGLU, SchedMoe<true>, true, true>(lds, D, S, E);
        } else {
            LAS unsigned* tab = (LAS unsigned*)(lds + TILETAB_OFF);
            const int ntile = build_tile_table(w, l, tab);
            SchedMoe<false> S{(const char*)w.ACT, wl + WO_E, w.list, tab, ntile, 4, G, c, WE_2};
            EpiDown E{w.Y};
            pg8::gemm_phase<EpiDown, SchedMoe<false>, true, true>(lds, D, S, E); __syncthreads();
            if ((ntile * 4) % G != 0 && c >= (ntile * 4) % G) convert_pull(P, wsb, lds, l + 1, CONV_BUDGET);
        }
    }
}

extern "C" void kernel_launch(void* const* d_in, const int* in_sizes, int n_in, void* d_out, int out_size, void* d_ws, size_t ws_size, hipStream_t stream) {
    static int grid = 0;
    if (grid == 0) {
        int dev = 0, cus = 0, per_cu = 0;
        (void)hipGetDevice(&dev);
        (void)hipDeviceGetAttribute(&cus, hipDeviceAttributeMultiprocessorCount, dev);
        if (hipFuncSetAttribute((const void*)mk_fwd, hipFuncAttributeMaxDynamicSharedMemorySize, LDS_BYTES) != hipSuccess) { fprintf(stderr, "kernel_launch: hipFuncSetAttribute failed\n"); grid = -1; }
        if (hipOccupancyMaxActiveBlocksPerMultiprocessor(&per_cu, (const void*)mk_fwd, NTHR, LDS_BYTES) != hipSuccess || per_cu < 1) { fprintf(stderr, "kernel_launch: occupancy query says %d blocks per CU\n", per_cu); if (grid == 0) grid = -1; }
        (void)hipGetLastError();
        if (grid == 0) grid = cus;
        if (grid > 0 && grid < 144) { fprintf(stderr, "kernel_launch: built for >= 144 CUs (got %d)\n", grid); grid = -1; }
        if (ws_size < WS_END) { fprintf(stderr, "kernel_launch: workspace too small (%zu < %zu)\n", ws_size, (size_t)WS_END); grid = -1; }
    }
    if (grid < 0) return;
    (void)hipMemsetAsync((char*)d_ws + WS_CTL, 0, CTL_BYTES, stream);
    Params p{};
    const float** pp = (const float**)&p;
    for (int i = 0; i < 19; ++i) pp[i] = (const float*)d_in[i];
    p.out = (float*)d_out; p.ws = (unsigned char*)d_ws;
    const dim3 blk(NTHR);
    p.step_lo = 0; p.step_hi = MK_NSTEPS;
    void* args[] = {&p};
    hipError_t e = hipLaunchCooperativeKernel((const void*)mk_fwd, dim3(grid), blk, args, LDS_BYTES, stream);
    if (e != hipSuccess) fprintf(stderr, "cooperative launch failed: %s (grid %d)\n", hipGetErrorString(e), grid);
}
```

```cpp
#include <hip/hip_runtime.h>
#include <hip/hip_cooperative_groups.h>
#include <cstdio>
#include <cstdint>
namespace cg = cooperative_groups;


typedef unsigned short bf16_t;
typedef float v4f __attribute__((ext_vector_type(4)));
constexpr int D = 1024, NB = 8, SEQ = 2048, CL = 256, NLAT = NB * SEQ, NCTX = NB * CL, NTOK = NLAT + NCTX;
constexpr int DEPTH = 4, NE = 16, NMOD = 6, GW = 64;
constexpr float EPS = 1e-6f, LOG2E = 1.4426950408889634f, QSCALE = 0.125f * 1.4426950408889634f;
constexpr int NTHR = 512, NWAVE = 8;
constexpr int SLOTS = 40960;

constexpr size_t MiB = 1u << 20;
constexpr size_t WS_CTL = 0, CTL_BYTES = 1 * MiB;
constexpr size_t WS_MODS = 1 * MiB;
constexpr size_t WS_ROPE = 2 * MiB;
constexpr size_t WS_TOKI = 3 * MiB;
constexpr size_t WS_LIST = 4 * MiB;
constexpr size_t WS_X = 6 * MiB;
constexpr size_t WS_H = 78 * MiB;
constexpr size_t WS_QK = 114 * MiB;
constexpr size_t WS_VT = 186 * MiB;
constexpr size_t WS_O = 222 * MiB;
constexpr size_t WS_ACT = 258 * MiB;
constexpr size_t WS_Y = 338 * MiB;
constexpr size_t WS_W = 418 * MiB;
constexpr size_t WL_BYTES = 104 * MiB, WO_QK = 0, WO_V = 4 * MiB, WO_O = 6 * MiB, WO_E = 8 * MiB, WE_BYTES = 6 * MiB, WE_2 = 4 * MiB;
constexpr size_t WS_END = WS_W + 4 * WL_BYTES;
constexpr int CW_CNT = 1024;
constexpr int CW_WOD = 16384;

struct Params {
    const float *x, *c, *ctx, *c_ctx, *mod_w, *mod_b, *norm_mix, *norm_ffn, *w_qkv, *w_o, *na_rpb, *diff_lambda, *diff_subln,
        *router_w, *router_b, *wg, *wu, *wd, *final_norm;
    float* out;
    unsigned char* ws;
    int step_lo, step_hi;
};

__device__ __forceinline__ int tidx() { int t = threadIdx.x; asm volatile("" : "+v"(t)); return t; }
__device__ __forceinline__ int bidx() { int t = blockIdx.x; asm volatile("" : "+s"(t)); return t; }
__device__ __forceinline__ float bf2f(bf16_t v) { return __uint_as_float(((unsigned)v) << 16); }
__device__ __forceinline__ bf16_t f2bf(float f) { unsigned u = __float_as_uint(f); return (bf16_t)((u + 0x7fffu + ((u >> 16) & 1u)) >> 16); }
__device__ __forceinline__ unsigned cvt_pk_bf16(float lo, float hi) { unsigned r; asm volatile("v_cvt_pk_bf16_f32 %0, %1, %2" : "=v"(r) : "v"(lo), "v"(hi)); return r; }
typedef __bf16 bf16v2_t __attribute__((ext_vector_type(2)));
typedef float f32v2_t __attribute__((ext_vector_type(2)));
__device__ __forceinline__ unsigned cvt_pk_bf16_c(float lo, float hi) { const f32v2_t v = {lo, hi}; return __builtin_bit_cast(unsigned, __builtin_convertvector(v, bf16v2_t)); }
__device__ __forceinline__ float wave_sum(float v) {
#pragma unroll
    for (int o = 1; o < 64; o <<= 1) v += __shfl_xor(v, o);
    return v;
}
__device__ __forceinline__ float silu_f(float v) { return v / (1.f + __expf(-v)); }
__device__ __forceinline__ int mod_row(int row) { return row < NLAT ? row / SEQ : NB; }
__device__ __forceinline__ float lam_init_of(int layer) { return 0.8f - 0.6f * expf(-0.3f * (float)layer); }

struct Ws {
    unsigned* ctl; float* mods; float* rope_cos; float* rope_sin; int4* toki; float2* tokw; int* list;
    float* X; bf16_t *H, *QK, *VT, *O, *ACT, *Y;
};
__device__ __forceinline__ Ws make_ws(unsigned char* ws) {
    Ws w;
    w.ctl = (unsigned*)(ws + WS_CTL); w.mods = (float*)(ws + WS_MODS); w.rope_cos = (float*)(ws + WS_ROPE); w.rope_sin = w.rope_cos + SEQ * 32;
    w.toki = (int4*)(ws + WS_TOKI); w.tokw = (float2*)(ws + WS_TOKI + (size_t)NTOK * 16); w.list = (int*)(ws + WS_LIST);
    w.X = (float*)(ws + WS_X); w.H = (bf16_t*)(ws + WS_H); w.QK = (bf16_t*)(ws + WS_QK); w.VT = (bf16_t*)(ws + WS_VT); w.O = (bf16_t*)(ws + WS_O);
    w.ACT = (bf16_t*)(ws + WS_ACT); w.Y = (bf16_t*)(ws + WS_Y);
    return w;
}
__device__ __forceinline__ void expert_offsets(const Ws& w, int layer, int* cnt, int* off) {
    int acc = 0;
#pragma unroll
    for (int e = 0; e < NE; ++e) {
        const int c = (int)__hip_atomic_load(w.ctl + CW_CNT + (layer * NE + e) * 64, __ATOMIC_RELAXED, __HIP_MEMORY_SCOPE_AGENT);
        cnt[e] = c; off[e] = acc; acc += (c + 255) & ~255;
    }
    off[NE] = acc;
}

__device__ __forceinline__ void phase_prologue(const Params& p, const Ws& w, float* smem) {
    const int tid = tidx(), bid = bidx(), nb = gridDim.x;
    float* sact = smem;
    float* part = smem + 9 * 1024;
    for (int i = tid; i < 9 * 1024; i += NTHR) { const int r = i >> 10, k = i & 1023; const float v = r < NB ? p.c[r * D + k] : p.c_ctx[k]; sact[i] = silu_f(v); }
    __syncthreads();
    const int col = tid & 127, ks = tid >> 7;
    for (int u = bid; u < DEPTH * (NMOD * D / 128); u += nb) {
        const int layer = u / (NMOD * D / 128), col0 = (u % (NMOD * D / 128)) * 128;
        float acc[9];
#pragma unroll
        for (int r = 0; r < 9; ++r) acc[r] = 0.f;
        const float* wp = p.mod_w + ((size_t)layer * D + ks * 256) * (NMOD * D) + col0 + col;
#pragma unroll 4
        for (int k = 0; k < 256; ++k) {
            const float wv = wp[(size_t)k * (NMOD * D)];
#pragma unroll
            for (int r = 0; r < 9; ++r) acc[r] += sact[r * 1024 + ks * 256 + k] * wv;
        }
#pragma unroll
        for (int r = 0; r < 9; ++r) part[(ks * 9 + r) * 128 + col] = acc[r];
        __syncthreads();
        for (int i = tid; i < 9 * 128; i += NTHR) {
            const int r = i >> 7, cc = i & 127;
            const float v = part[(0 * 9 + r) * 128 + cc] + part[(1 * 9 + r) * 128 + cc] + part[(2 * 9 + r) * 128 + cc] + part[(3 * 9 + r) * 128 + cc];
            w.mods[((size_t)layer * 9 + r) * (NMOD * D) + col0 + cc] = v + p.mod_b[layer * (NMOD * D) + col0 + cc];
        }
        __syncthreads();
    }
    for (int i = bid * NTHR + tid; i < SEQ * 32; i += nb * NTHR) {
        const int t = i >> 5, j = i & 31, f = j & 15;
        const float pos = (float)(j < 16 ? t / GW : t % GW);
        const float inv = powf(10000.0f, -(float)f / 16.0f);
        const float ang = pos * inv;
        w.rope_cos[i] = cosf(ang); w.rope_sin[i] = sinf(ang);
    }
}

__device__ __forceinline__ void phase_norm(const Params& p, const Ws& w, int layer, int mode, __attribute__((address_space(3))) unsigned char* lds) {
#define NLAS __attribute__((address_space(3)))
    const int tid = tidx(), lane = tid & 63, wave = tid >> 6;
    const int gw = bidx() * NWAVE + wave, ngw = gridDim.x * NWAVE;
    const bool combine = (mode == 0 && layer > 0) || mode == 2;
    const int clayer = (mode == 2) ? DEPTH - 1 : layer - 1;
    int cnt[NE], off[NE + 1];
    if (combine) expert_offsets(w, clayer, cnt, off);
    int nrows = NTOK;
    if (mode == 2) nrows = NLAT;
    if (mode == 1 && layer == DEPTH - 1) nrows = NLAT;
    NLAS unsigned* lcnt = (NLAS unsigned*)lds;
    NLAS v4f* lgb = (NLAS v4f*)(lds + 1024);
    const NLAS v4f* rwl = (const NLAS v4f*)(lds + 16384);
    const int rpb = (nrows + (int)gridDim.x - 1) / (int)gridDim.x;
    const int chunk0 = bidx() * rpb;
    if (mode == 1) {
        if (tid < 32) lcnt[tid] = 0u;
        for (int c = tid; c < D * 4; c += NTHR) { const int k = c >> 2, e4 = c & 3, j = k >> 8, ln = (k & 255) >> 2, q = k & 3;
            ((NLAS v4f*)(lds + 16384))[((j * 4 + q) * 4 + e4) * 64 + ln] = ((const v4f*)p.router_w)[c]; }
        __syncthreads();
    }
    const bool from_input = (layer == 0 && mode == 0);
    const int row0 = (mode == 1) ? chunk0 + wave : gw, rstep = (mode == 1) ? NWAVE : ngw;
    const int rend = (mode == 1) ? min(nrows, chunk0 + rpb) : nrows;
    v4f vn[4]; int4 tin = make_int4(0, 0, 0, 0); float2 twn = make_float2(0.f, 0.f);
    if (row0 < rend) {
        const float* src = from_input ? (row0 < NLAT ? p.x + (size_t)row0 * D : p.ctx + (size_t)(row0 - NLAT) * D) : w.X + (size_t)row0 * D;
#pragma unroll
        for (int j = 0; j < 4; ++j) vn[j] = __builtin_nontemporal_load((const v4f*)src + 64 * j + lane);
        if (combine) { tin = w.toki[row0]; twn = w.tokw[row0]; }
    }
    for (int row = row0; row < rend; row += rstep) {
        const int r = mod_row(row);
        v4f v[4];
#pragma unroll
        for (int j = 0; j < 4; ++j) v[j] = vn[j];
        const int4 ti = tin; const float2 tw = twn;
        {
            const int nrow = row + rstep;
            if (nrow < rend) {
                const float* src = from_input ? (nrow < NLAT ? p.x + (size_t)nrow * D : p.ctx + (size_t)(nrow - NLAT) * D) : w.X + (size_t)nrow * D;
#pragma unroll
                for (int j = 0; j < 4; ++j) vn[j] = __builtin_nontemporal_load((const v4f*)src + 64 * j + lane);
                if (combine) { tin = w.toki[nrow]; twn = w.tokw[nrow]; }
            }
        }
        if (combine) {
            int o0 = 0, o1 = 0;
#pragma unroll
            for (int e = 0; e < NE; ++e) { if (e == ti.x) o0 = off[e]; if (e == ti.z) o1 = off[e]; }
            const bf16_t* y0 = w.Y + (size_t)(o0 + ti.y) * D; const bf16_t* y1 = w.Y + (size_t)(o1 + ti.w) * D;
            const float* g5 = w.mods + ((size_t)clayer * 9 + r) * (NMOD * D) + 5 * D;
#pragma unroll
            for (int j = 0; j < 4; ++j) {
                const int k = 4 * (64 * j + lane);
                typedef unsigned v2u __attribute__((ext_vector_type(2)));
                const v2u a_ = __builtin_nontemporal_load((const v2u*)(y0 + k)), b_ = __builtin_nontemporal_load((const v2u*)(y1 + k));
                const uint2 a = make_uint2(a_[0], a_[1]), b = make_uint2(b_[0], b_[1]);
                const v4f g = *(const v4f*)(g5 + k);
                v[j][0] += g[0] * (tw.x * bf2f((bf16_t)(a.x & 0xffff)) + tw.y * bf2f((bf16_t)(b.x & 0xffff)));
                v[j][1] += g[1] * (tw.x * bf2f((bf16_t)(a.x >> 16)) + tw.y * bf2f((bf16_t)(b.x >> 16)));
                v[j][2] += g[2] * (tw.x * bf2f((bf16_t)(a.y & 0xffff)) + tw.y * bf2f((bf16_t)(b.y & 0xffff)));
                v[j][3] += g[3] * (tw.x * bf2f((bf16_t)(a.y >> 16)) + tw.y * bf2f((bf16_t)(b.y >> 16)));
            }
            if (mode != 2) {
                float* xdst = w.X;
#pragma unroll
                for (int j = 0; j < 4; ++j) ((v4f*)(xdst + (size_t)row * D))[64 * j + lane] = v[j];
            }
        }
        float ss = 0.f;
#pragma unroll
        for (int j = 0; j < 4; ++j) ss += v[j][0] * v[j][0] + v[j][1] * v[j][1] + v[j][2] * v[j][2] + v[j][3] * v[j][3];
        ss = wave_sum(ss);
        const float rinv = rsqrtf(ss * (1.f / D) + EPS);
        if (mode == 2) {
#pragma unroll
            for (int j = 0; j < 4; ++j) {
                const int k = 4 * (64 * j + lane); const v4f g = *(const v4f*)(p.final_norm + k);
                __builtin_nontemporal_store(v[j] * rinv * g, (v4f*)(p.out + (size_t)row * D) + 64 * j + lane);
            }
            continue;
        }
        const float* gn = (mode == 0 ? p.norm_mix : p.norm_ffn) + layer * D;
        const float* mv = w.mods + ((size_t)layer * 9 + r) * (NMOD * D) + (mode == 0 ? 0 : 3 * D);
        float hv[16];
#pragma unroll
        for (int j = 0; j < 4; ++j) {
            const int k = 4 * (64 * j + lane);
            const v4f g = *(const v4f*)(gn + k), sh = *(const v4f*)(mv + k), sc = *(const v4f*)(mv + D + k);
            const v4f hh = v[j] * rinv * g * (1.f + sc) + sh;
            hv[4 * j + 0] = hh[0]; hv[4 * j + 1] = hh[1]; hv[4 * j + 2] = hh[2]; hv[4 * j + 3] = hh[3];
            uint2 o; o.x = cvt_pk_bf16(hv[4 * j], hv[4 * j + 1]); o.y = cvt_pk_bf16(hv[4 * j + 2], hv[4 * j + 3]);
            *(uint2*)(w.H + (size_t)row * D + k) = o;
        }
        if (mode == 1) {
            float lg[NE];
#pragma unroll
            for (int e = 0; e < NE; ++e) lg[e] = 0.f;
#pragma unroll
            for (int j = 0; j < 4; ++j) {
                v4f tw[16];
#pragma unroll
                for (int qe = 0; qe < 16; ++qe) tw[qe] = rwl[(j * 16 + qe) * 64 + lane];
                __builtin_amdgcn_sched_barrier(0);
#pragma unroll
                for (int q = 0; q < 4; ++q) {
                    const float hh = hv[4 * j + q];
#pragma unroll
                    for (int e4 = 0; e4 < 4; ++e4) { const v4f t = tw[q * 4 + e4]; lg[4 * e4] += hh * t[0]; lg[4 * e4 + 1] += hh * t[1]; lg[4 * e4 + 2] += hh * t[2]; lg[4 * e4 + 3] += hh * t[3]; }
                }
            }
            {
                const bool b5 = (lane & 32) != 0, b4 = (lane & 16) != 0, b3 = (lane & 8) != 0, b2 = (lane & 4) != 0;
                float a8[8], a4[4], a2[2];
#pragma unroll
                for (int j = 0; j < 8; ++j) { const float keep = b5 ? lg[j + 8] : lg[j], send = b5 ? lg[j] : lg[j + 8]; a8[j] = keep + __shfl_xor(send, 32); }
#pragma unroll
                for (int j = 0; j < 4; ++j) { const float keep = b4 ? a8[j + 4] : a8[j], send = b4 ? a8[j] : a8[j + 4]; a4[j] = keep + __shfl_xor(send, 16); }
#pragma unroll
                for (int j = 0; j < 2; ++j) { const float keep = b3 ? a4[j + 2] : a4[j], send = b3 ? a4[j] : a4[j + 2]; a2[j] = keep + __shfl_xor(send, 8); }
                float a1 = (b2 ? a2[1] : a2[0]) + __shfl_xor(b2 ? a2[0] : a2[1], 4);
                a1 += __shfl_xor(a1, 2); a1 += __shfl_xor(a1, 1);
                if ((lane & 3) == 0) ((NLAS float*)lgb)[(row - chunk0) * 16 + (lane >> 2)] = a1;
            }
        }
    }
    if (mode == 1) {
        __syncthreads();
        const int row = chunk0 + tid; const bool act = (tid < rpb && row < nrows);
        int i1 = 0, i2 = 0; unsigned lp1 = 0, lp2 = 0; float w1 = 0.f, w2 = 0.f;
        if (act) {
            float sc[NE], sel[NE];
#pragma unroll
            for (int e4 = 0; e4 < 4; ++e4) { const v4f t = lgb[tid * 4 + e4];
#pragma unroll
                for (int q = 0; q < 4; ++q) { const int e = 4 * e4 + q; sc[e] = 1.f / (1.f + expf(-t[q])); sel[e] = sc[e] + p.router_b[e]; } }
            int bg = 0; float bgs = -INFINITY;
#pragma unroll
            for (int g = 0; g < 4; ++g) {
                float m1 = -INFINITY, m2 = -INFINITY;
#pragma unroll
                for (int q = 0; q < 4; ++q) { const float t = sel[4 * g + q]; if (t > m1) { m2 = m1; m1 = t; } else if (t > m2) m2 = t; }
                const float gs = m1 + m2;
                if (gs > bgs) { bgs = gs; bg = g; }
            }
            float m1 = -INFINITY, m2 = -INFINITY;
#pragma unroll
            for (int g = 0; g < 4; ++g) {
                if (g == bg) {
#pragma unroll
                    for (int q = 0; q < 4; ++q) { const float t = sel[4 * g + q]; if (t > m1) { m2 = m1; i2 = i1; m1 = t; i1 = 4 * g + q; } else if (t > m2) { m2 = t; i2 = 4 * g + q; } }
                }
            }
            float s1 = 0.f, s2 = 0.f;
#pragma unroll
            for (int e = 0; e < NE; ++e) { if (e == i1) s1 = sc[e]; if (e == i2) s2 = sc[e]; }
            const float inv = 1.f / (s1 + s2); w1 = s1 * inv; w2 = s2 * inv;
            lp1 = __hip_atomic_fetch_add(lcnt + i1, 1u, __ATOMIC_RELAXED, __HIP_MEMORY_SCOPE_WORKGROUP);
            lp2 = __hip_atomic_fetch_add(lcnt + i2, 1u, __ATOMIC_RELAXED, __HIP_MEMORY_SCOPE_WORKGROUP);
        }
        __syncthreads();
        if (tid < NE) lcnt[16 + tid] = atomicAdd(w.ctl + CW_CNT + (layer * NE + tid) * 64, lcnt[tid]);
        __syncthreads();
        if (act) {
            const int p1 = (int)(lcnt[16 + i1] + lp1), p2 = (int)(lcnt[16 + i2] + lp2);
            w.list[(size_t)i1 * NTOK + p1] = row; w.list[(size_t)i2 * NTOK + p2] = row;
            w.toki[row] = make_int4(i1, p1, i2, p2); w.tokw[row] = make_float2(w1, w2);
        }
        __syncthreads();
    }
#undef NLAS
}

__device__ __forceinline__ void phase_norm2(const Params& p, const Ws& w, int layer, __attribute__((address_space(3))) unsigned char* lds) {
#define NLAS __attribute__((address_space(3)))
    const int tid = tidx(), lane = tid & 63, wave = tid >> 6;
    const int nrows = (layer == DEPTH - 1) ? NLAT : NTOK;
    NLAS unsigned* lcnt = (NLAS unsigned*)lds;
    NLAS v4f* lgb = (NLAS v4f*)(lds + 1024);
    const NLAS v4f* rwl = (const NLAS v4f*)(lds + 16384);
    int ra0, rb0, ra1, rb1;
    if (gridDim.x == 256 && nrows == NTOK) {
        const int c = bidx();
        if (c < 224) { ra0 = (c * NLAT) / 224; rb0 = ((c + 1) * NLAT) / 224; ra1 = NLAT + (c * 768) / 224; rb1 = NLAT + ((c + 1) * 768) / 224; }
        else { ra0 = rb0 = 0; ra1 = NLAT + 768 + (c - 224) * 40; rb1 = ra1 + 40; }
    } else {
        const int rpb = (nrows + (int)gridDim.x - 1) / (int)gridDim.x;
        ra0 = min(nrows, bidx() * rpb); rb0 = min(nrows, ra0 + rpb); ra1 = rb1 = 0;
    }
    const int n0 = rb0 - ra0, ntot = n0 + (rb1 - ra1);
    if (tid < 32) lcnt[tid] = 0u;
    for (int c = tid; c < D * 4; c += NTHR) { const int k = c >> 2, e4 = c & 3, j = k >> 8, ln = (k & 255) >> 2, q = k & 3;
        ((NLAS v4f*)(lds + 16384))[((j * 4 + q) * 4 + e4) * 64 + ln] = ((const v4f*)p.router_w)[c]; }
#pragma unroll 1
    for (int rg = 0; rg < 2; ++rg) {
    const int chunk0 = rg ? ra1 : ra0, rend = rg ? rb1 : rb0, lbase = rg ? n0 : 0;
    if (tid == 0 && chunk0 < rend) {
        const unsigned* done = w.ctl + CW_WOD + 128 * layer;
        for (int pm = chunk0 >> 8; pm <= (rend - 1) >> 8; ++pm) {
            unsigned sp = 0;
            while (__hip_atomic_load(done + pm, __ATOMIC_RELAXED, __HIP_MEMORY_SCOPE_AGENT) < 32u) { __builtin_amdgcn_s_sleep(2); if (++sp > (1u << 24)) break; }
        }
        __builtin_amdgcn_fence(__ATOMIC_ACQUIRE, "agent");
    }
    __syncthreads();
    const int row0 = chunk0 + wave;
    v4f vn[2][4];
#pragma unroll
    for (int s = 0; s < 2; ++s) {
        const int rr = row0 + 8 * s;
#pragma unroll
        for (int j = 0; j < 4; ++j) vn[s][j] = v4f{0.f, 0.f, 0.f, 0.f};
        if (rr < rend) {
#pragma unroll
            for (int j = 0; j < 4; ++j) vn[s][j] = __builtin_nontemporal_load((const v4f*)(w.X + (size_t)rr * D) + 64 * j + lane);
        }
    }
    for (int row = row0; row < rend; row += 16) {
        const bool hasB = row + 8 < rend;
        const int rA = mod_row(row), rB = hasB ? mod_row(row + 8) : rA;
        v4f v[2][4];
#pragma unroll
        for (int s = 0; s < 2; ++s)
#pragma unroll
            for (int j = 0; j < 4; ++j) v[s][j] = vn[s][j];
#pragma unroll
        for (int s = 0; s < 2; ++s) {
            const int nr = row + 16 + 8 * s;
            if (nr < rend) {
#pragma unroll
                for (int j = 0; j < 4; ++j) vn[s][j] = __builtin_nontemporal_load((const v4f*)(w.X + (size_t)nr * D) + 64 * j + lane);
            }
        }
        float ss0 = 0.f, ss1 = 0.f;
#pragma unroll
        for (int j = 0; j < 4; ++j) {
            ss0 += v[0][j][0] * v[0][j][0] + v[0][j][1] * v[0][j][1] + v[0][j][2] * v[0][j][2] + v[0][j][3] * v[0][j][3];
            ss1 += v[1][j][0] * v[1][j][0] + v[1][j][1] * v[1][j][1] + v[1][j][2] * v[1][j][2] + v[1][j][3] * v[1][j][3];
        }
#pragma unroll
        for (int o = 1; o < 64; o <<= 1) { ss0 += __shfl_xor(ss0, o); ss1 += __shfl_xor(ss1, o); }
        const float rinv0 = rsqrtf(ss0 * (1.f / D) + EPS), rinv1 = rsqrtf(ss1 * (1.f / D) + EPS);
        const float* gn = p.norm_ffn + layer * D;
        const float* mvA = w.mods + ((size_t)layer * 9 + rA) * (NMOD * D) + 3 * D;
        const float* mvB = w.mods + ((size_t)layer * 9 + rB) * (NMOD * D) + 3 * D;
        float hv[2][16];
#pragma unroll
        for (int j = 0; j < 4; ++j) {
            const int k = 4 * (64 * j + lane);
            const v4f g = *(const v4f*)(gn + k);
            v4f shA = *(const v4f*)(mvA + k), gA = g * (1.f + *(const v4f*)(mvA + D + k));
            v4f shB = shA, gB = gA;
            if (rB != rA) { shB = *(const v4f*)(mvB + k); gB = g * (1.f + *(const v4f*)(mvB + D + k)); }
            const v4f ha = v[0][j] * rinv0 * gA + shA, hb = v[1][j] * rinv1 * gB + shB;
            hv[0][4 * j + 0] = ha[0]; hv[0][4 * j + 1] = ha[1]; hv[0][4 * j + 2] = ha[2]; hv[0][4 * j + 3] = ha[3];
            hv[1][4 * j + 0] = hb[0]; hv[1][4 * j + 1] = hb[1]; hv[1][4 * j + 2] = hb[2]; hv[1][4 * j + 3] = hb[3];
            uint2 o; o.x = cvt_pk_bf16(ha[0], ha[1]); o.y = cvt_pk_bf16(ha[2], ha[3]);
            *(uint2*)(w.H + (size_t)row * D + k) = o;
            if (hasB) { uint2 o2; o2.x = cvt_pk_bf16(hb[0], hb[1]); o2.y = cvt_pk_bf16(hb[2], hb[3]); *(uint2*)(w.H + (size_t)(row + 8) * D + k) = o2; }
        }
        float lg[2][NE];
#pragma unroll
        for (int e = 0; e < NE; ++e) { lg[0][e] = 0.f; lg[1][e] = 0.f; }
#pragma unroll
        for (int j = 0; j < 4; ++j) {
#pragma unroll
            for (int hf = 0; hf < 2; ++hf) {
                v4f tw[8];
#pragma unroll
                for (int qe = 0; qe < 8; ++qe) tw[qe] = rwl[(j * 16 + hf * 8 + qe) * 64 + lane];
                __builtin_amdgcn_sched_barrier(0);
#pragma unroll
                for (int q2 = 0; q2 < 2; ++q2) {
                    const float ha = hv[0][4 * j + hf * 2 + q2], hb = hv[1][4 * j + hf * 2 + q2];
#pragma unroll
                    for (int e4 = 0; e4 < 4; ++e4) { const v4f t = tw[q2 * 4 + e4];
                        lg[0][4 * e4] += ha * t[0]; lg[0][4 * e4 + 1] += ha * t[1]; lg[0][4 * e4 + 2] += ha * t[2]; lg[0][4 * e4 + 3] += ha * t[3];
                        lg[1][4 * e4] += hb * t[0]; lg[1][4 * e4 + 1] += hb * t[1]; lg[1][4 * e4 + 2] += hb * t[2]; lg[1][4 * e4 + 3] += hb * t[3]; }
                }
            }
        }
        float a1s[2];
#pragma unroll
        for (int s = 0; s < 2; ++s) {
            const bool b5 = (lane & 32) != 0, b4 = (lane & 16) != 0, b3 = (lane & 8) != 0, b2 = (lane & 4) != 0;
            float a8[8], a4[4], a2[2];
#pragma unroll
            for (int j = 0; j < 8; ++j) { const float keep = b5 ? lg[s][j + 8] : lg[s][j], send = b5 ? lg[s][j] : lg[s][j + 8]; a8[j] = keep + __shfl_xor(send, 32); }
#pragma unroll
            for (int j = 0; j < 4; ++j) { const float keep = b4 ? a8[j + 4] : a8[j], send = b4 ? a8[j] : a8[j + 4]; a4[j] = keep + __shfl_xor(send, 16); }
#pragma unroll
            for (int j = 0; j < 2; ++j) { const float keep = b3 ? a4[j + 2] : a4[j], send = b3 ? a4[j] : a4[j + 2]; a2[j] = keep + __shfl_xor(send, 8); }
            float a1 = (b2 ? a2[1] : a2[0]) + __shfl_xor(b2 ? a2[0] : a2[1], 4);
            a1 += __shfl_xor(a1, 2); a1 += __shfl_xor(a1, 1);
            a1s[s] = a1;
        }
        if ((lane & 3) == 0) {
            ((NLAS float*)lgb)[(row - chunk0 + lbase) * 16 + (lane >> 2)] = a1s[0];
            if (hasB) ((NLAS float*)lgb)[(row + 8 - chunk0 + lbase) * 16 + (lane >> 2)] = a1s[1];
        }
    }
    }
    {
        __syncthreads();
        const int row = (tid < n0) ? ra0 + tid : ra1 + (tid - n0); const bool act = (tid < ntot);
        int i1 = 0, i2 = 0; unsigned lp1 = 0, lp2 = 0; float w1 = 0.f, w2 = 0.f;
        if (act) {
            float sc[NE], sel[NE];
#pragma unroll
            for (int e4 = 0; e4 < 4; ++e4) { const v4f t = lgb[tid * 4 + e4];
#pragma unroll
                for (int q = 0; q < 4; ++q) { const int e = 4 * e4 + q; sc[e] = 1.f / (1.f + expf(-t[q])); sel[e] = sc[e] + p.router_b[e]; } }
            int bg = 0; float bgs = -INFINITY;
#pragma unroll
            for (int g = 0; g < 4; ++g) {
                float m1 = -INFINITY, m2 = -INFINITY;
#pragma unroll
                for (int q = 0; q < 4; ++q) { const float t = sel[4 * g + q]; if (t > m1) { m2 = m1; m1 = t; } else if (t > m2) m2 = t; }
                const float gs = m1 + m2;
                if (gs > bgs) { bgs = gs; bg = g; }
            }
            float m1 = -INFINITY, m2 = -INFINITY;
#pragma unroll
            for (int g = 0; g < 4; ++g) {
                if (g == bg) {
#pragma unroll
                    for (int q = 0; q < 4; ++q) { const float t = sel[4 * g + q]; if (t > m1) { m2 = m1; i2 = i1; m1 = t; i1 = 4 * g + q; } else if (t > m2) { m2 = t; i2 = 4 * g + q; } }
                }
            }
            float s1 = 0.f, s2 = 0.f;
#pragma unroll
            for (int e = 0; e < NE; ++e) { if (e == i1) s1 = sc[e]; if (e == i2) s2 = sc[e]; }
            const float inv = 1.f / (s1 + s2); w1 = s1 * inv; w2 = s2 * inv;
            lp1 = __hip_atomic_fetch_add(lcnt + i1, 1u, __ATOMIC_RELAXED, __HIP_MEMORY_SCOPE_WORKGROUP);
            lp2 = __hip_atomic_fetch_add(lcnt + i2, 1u, __ATOMIC_RELAXED, __HIP_MEMORY_SCOPE_WORKGROUP);
        }
        __syncthreads();
        if (tid < NE) lcnt[16 + tid] = atomicAdd(w.ctl + CW_CNT + (layer * NE + tid) * 64, lcnt[tid]);
        __syncthreads();
        if (act) {
            const int p1 = (int)(lcnt[16 + i1] + lp1), p2 = (int)(lcnt[16 + i2] + lp2);
            w.list[(size_t)i1 * NTOK + p1] = row; w.list[(size_t)i2 * NTOK + p2] = row;
            w.toki[row] = make_int4(i1, p1, i2, p2); w.tokw[row] = make_float2(w1, w2);
        }
        __syncthreads();
    }
#undef NLAS
}

#define LAS __attribute__((address_space(3)))
#define GAS __attribute__((address_space(1)))
typedef short bf16x8 __attribute__((ext_vector_type(8)));
typedef float f32x4 __attribute__((ext_vector_type(4)));
typedef unsigned u32x4 __attribute__((ext_vector_type(4)));
typedef unsigned u32x2 __attribute__((ext_vector_type(2)));

constexpr int RING_BYTES = 131072;
constexpr int LDSCTL_OFF = RING_BYTES, MISC_OFF = LDSCTL_OFF + 320, TILETAB_OFF = LDSCTL_OFF + 1024, STASH_OFF = LDSCTL_OFF + 4096;
constexpr int LDS_BYTES = 147456;


namespace pg8 {
constexpr int BM = 256, BK = 64, HALF = 128, HTB = HALF * BK * 2, STAGE_BYTES = 8 * HTB, NXCD = 8, WGM = 8;
__host__ __device__ __forceinline__ int lds_byte(int r, int c) { const int st = (r >> 4) * 2 + (c >> 5), rr = r & 15, cc = c & 31, ob = rr * 64 + cc * 2; return st * 1024 + (ob ^ (((ob >> 9) & 1) << 5)); }
__host__ __device__ __forceinline__ void stage_rc(int b, int& R, int& C) { const int st = b / 1024, sb = b % 1024, swz = sb ^ (((sb >> 9) & 1) << 5); R = (st >> 1) * 16 + swz / 64; C = (st & 1) * 32 + (swz % 64) / 2; }
__host__ __device__ __forceinline__ int perm32(int rho) { const int n = rho >> 4, i = rho & 15; return 8 * (i >> 2) + 4 * n + (i & 3); }

struct Unit { int pm, pn, kind, aux; const char* a; const char* b; const int* lst; int valid; };
__device__ __forceinline__ void tile_order(int L, int nM, int nN, int& pm, int& pn) {
    const int nwg = nM * nN; int wgid = L;
    { const int q = nwg / NXCD, r = nwg % NXCD, xcd = wgid % NXCD, off = wgid / NXCD; wgid = (xcd < r ? xcd * (q + 1) : r * (q + 1) + (xcd - r) * q) + off; }
    const int nig = WGM * nN, gid = wgid / nig, fm = gid * WGM, gsz = (nM - fm) < WGM ? (nM - fm) : WGM;
    pm = fm + ((wgid % nig) % gsz); pn = (wgid % nig) / gsz;
}

template <class Epi, class Sched, bool ALIGN_EPI, bool SP2>
__device__ __forceinline__ void gemm_phase(LAS unsigned char* lds, const int K, const Sched& S, const Epi& E) {
    const int tid = tidx(), wid = __builtin_amdgcn_readfirstlane(tid >> 6), lane = tid & 63, wr = wid >> 2, wc = wid & 3, fr = lane & 15, fq = lane >> 4;
    const int nt = K / BK;
    unsigned voffB[2];
#pragma unroll
    for (int i = 0; i < 2; ++i) { int R, C; stage_rc(tid * 16 + i * 8192, R, C); const int Rb = Epi::PERM ? ((R & ~31) + perm32(R & 31)) : R; voffB[i] = (unsigned)(Rb * K + C) * 2u; }
#define PG8_AOFF(u, h, i) ([&]() { int R_, C_; stage_rc(tid * 16 + (i) * 8192, R_, C_); return S.a_off((u), (h), R_, C_, K); }())
    const size_t kstep = (size_t)(BK * 2);
    const size_t hstep = (size_t)HALF * K * 2;
    const unsigned ldsw = (unsigned)wid * 1024u;
    const int aoff = lds_byte(wr * 64 + fr, fq * 8), boff = lds_byte(wc * 32 + fr, fq * 8);
#define PG8_SA(b, h) (((b) * 2 + (h)) * HTB)
#define PG8_SB(b, h) ((4 + (b) * 2 + (h)) * HTB)
#define PG8_STAGE(bufoff, gbase, voff) do { _Pragma("unroll") for (int _i = 0; _i < 2; ++_i) \
        __builtin_amdgcn_global_load_lds((const unsigned*)((const char*)(gbase) + (voff)[_i]), (LAS unsigned*)(lds + (bufoff) + ldsw + _i * 8192), 16, 0, 0); } while (0)
#define PG8_LDA(dst, b, h) do { _Pragma("unroll") for (int m = 0; m < 4; ++m) _Pragma("unroll") for (int k = 0; k < 2; ++k) dst[m][k] = *(const LAS bf16x8*)(lds + PG8_SA(b, h) + aoff + m * 2048 + k * 1024); } while (0)
#define PG8_LDB(dst, b, h) do { _Pragma("unroll") for (int n = 0; n < 2; ++n) _Pragma("unroll") for (int k = 0; k < 2; ++k) dst[n][k] = *(const LAS bf16x8*)(lds + PG8_SB(b, h) + boff + n * 2048 + k * 1024); } while (0)
#define PG8_MMA(ai, bj, At, Bt) do { __builtin_amdgcn_s_setprio(1); _Pragma("unroll") for (int m = 0; m < 4; ++m) _Pragma("unroll") for (int n = 0; n < 2; ++n) _Pragma("unroll") for (int k = 0; k < 2; ++k) \
        acc[ai][bj][m][n] = __builtin_amdgcn_mfma_f32_16x16x32_bf16(Bt[n][k], At[m][k], acc[ai][bj][m][n], 0, 0, 0); __builtin_amdgcn_s_setprio(0); } while (0)
#define PG8_WAIT_V(n) asm volatile("s_waitcnt vmcnt(" #n ")" ::: "memory")
#define PG8_WAIT_L(n) asm volatile("s_waitcnt lgkmcnt(" #n ")" ::: "memory")
#define PG8_BAR __builtin_amdgcn_s_barrier()
#define PG8_SCHED __builtin_amdgcn_sched_barrier(0)
    Unit cur, nxt; int ui = 0;
    if (!S.next(0, cur)) return;
    unsigned vAc[2][2];
#define PG8_STASH ((LAS u32x4*)(lds + (STASH_OFF - 0)) + tid)
#pragma unroll
    for (int h = 0; h < 2; ++h)
#pragma unroll
        for (int i = 0; i < 2; ++i) vAc[h][i] = PG8_AOFF(cur, h, i);
    f32x4 acc[2][2][4][2];
#pragma unroll
    for (int a = 0; a < 2; ++a)
#pragma unroll
        for (int b = 0; b < 2; ++b)
#pragma unroll
            for (int m = 0; m < 4; ++m)
#pragma unroll
                for (int n = 0; n < 2; ++n) acc[a][b][m][n] = (f32x4){0.f, 0.f, 0.f, 0.f};
    bf16x8 At[4][2], B0[2][2], B1[2][2];
    const char* cA = cur.a; const char* cB = cur.b;
    if constexpr (SP2) {
        PG8_STAGE(PG8_SB(0, 0), cB, voffB); PG8_STAGE(PG8_SB(0, 1), cB + hstep, voffB); PG8_STAGE(PG8_SA(0, 0), cA, vAc[0]); PG8_STAGE(PG8_SA(0, 1), cA, vAc[1]);
        if (wr == 1) PG8_BAR;
        PG8_WAIT_V(2); PG8_BAR;
        PG8_STAGE(PG8_SB(1, 0), cB + kstep, voffB); PG8_STAGE(PG8_SA(1, 0), cA + kstep, vAc[0]); PG8_STAGE(PG8_SB(1, 1), cB + hstep + kstep, voffB);
        PG8_WAIT_V(6); PG8_BAR;
    } else {
        PG8_STAGE(PG8_SB(0, 0), cB, voffB); PG8_STAGE(PG8_SA(0, 0), cA, vAc[0]); PG8_STAGE(PG8_SB(0, 1), cB + hstep, voffB); PG8_STAGE(PG8_SA(0, 1), cA, vAc[1]);
        if (wr == 1) PG8_BAR;
        PG8_WAIT_V(4); PG8_BAR;
        PG8_STAGE(PG8_SB(1, 0), cB + kstep, voffB); PG8_STAGE(PG8_SA(1, 0), cA + kstep, vAc[0]); PG8_STAGE(PG8_SB(1, 1), cB + hstep + kstep, voffB);
        PG8_WAIT_V(6); PG8_BAR;
    }
    for (;;) {
        const bool has_next = S.next(ui + 1, nxt);
        const char* nA = has_next ? nxt.a : cA; const char* nB = has_next ? nxt.b : cB;
        if (Sched::GATHER && has_next) { u32x4 t4; t4.x = PG8_AOFF(nxt, 0, 0); t4.y = PG8_AOFF(nxt, 0, 1); t4.z = PG8_AOFF(nxt, 1, 0); t4.w = PG8_AOFF(nxt, 1, 1); *PG8_STASH = t4; }
        for (int t = 0; t < nt; t += 2) {
            const bool last = (t == nt - 2);
            const char* a1 = cA + (size_t)(t + 1) * kstep;
            const char* a2 = last ? nA : cA + (size_t)(t + 2) * kstep; const char* b2 = last ? nB : cB + (size_t)(t + 2) * kstep;
            const char* a3 = a2 + kstep; const char* b3 = b2 + kstep;
            if constexpr (SP2) {
            PG8_LDB(B0, 0, 0); PG8_LDB(B1, 0, 1); PG8_SCHED; PG8_LDA(At, 0, 0); PG8_STAGE(PG8_SA(1, 1), a1, vAc[1]);
            if (Sched::GATHER && last && has_next) { const u32x4 t4 = *PG8_STASH; vAc[0][0] = t4.x; vAc[0][1] = t4.y; vAc[1][0] = t4.z; vAc[1][1] = t4.w; }
            PG8_WAIT_V(8); PG8_WAIT_L(0); PG8_BAR; PG8_MMA(0, 0, At, B0); PG8_MMA(0, 1, At, B1); PG8_BAR; PG8_SCHED;
            PG8_LDA(At, 0, 1); PG8_STAGE(PG8_SB(0, 0), b2, voffB); PG8_STAGE(PG8_SB(0, 1), b2 + hstep, voffB); PG8_STAGE(PG8_SA(0, 0), a2, vAc[0]);
            PG8_WAIT_V(8); PG8_WAIT_L(0); PG8_BAR; PG8_MMA(1, 0, At, B0); PG8_MMA(1, 1, At, B1); PG8_BAR; PG8_SCHED;
            PG8_LDB(B0, 1, 0); PG8_LDB(B1, 1, 1); PG8_SCHED; PG8_LDA(At, 1, 0); PG8_STAGE(PG8_SA(0, 1), a2, vAc[1]);
            PG8_WAIT_V(8); PG8_WAIT_L(0); PG8_BAR; PG8_MMA(0, 0, At, B0); PG8_MMA(0, 1, At, B1); PG8_BAR; PG8_SCHED;
            PG8_LDA(At, 1, 1); PG8_STAGE(PG8_SB(1, 0), b3, voffB); PG8_STAGE(PG8_SB(1, 1), b3 + hstep, voffB); PG8_STAGE(PG8_SA(1, 0), a3, vAc[0]);
            PG8_WAIT_V(8); PG8_WAIT_L(0); PG8_BAR; PG8_MMA(1, 0, At, B0); PG8_MMA(1, 1, At, B1); PG8_BAR; PG8_SCHED;
            } else {
            PG8_LDB(B0, 0, 0); PG8_SCHED; PG8_LDA(At, 0, 0); PG8_STAGE(PG8_SA(1, 1), a1, vAc[1]);
            if (Sched::GATHER && last && has_next) { const u32x4 t4 = *PG8_STASH; vAc[0][0] = t4.x; vAc[0][1] = t4.y; vAc[1][0] = t4.z; vAc[1][1] = t4.w; }
            PG8_WAIT_L(8); PG8_BAR; PG8_WAIT_L(0); PG8_MMA(0, 0, At, B0); PG8_BAR; PG8_SCHED;
            PG8_LDB(B1, 0, 1); PG8_STAGE(PG8_SB(0, 0), b2, voffB);
            PG8_BAR; PG8_WAIT_L(0); PG8_MMA(0, 1, At, B1); PG8_BAR;
            PG8_LDA(At, 0, 1); PG8_STAGE(PG8_SA(0, 0), a2, vAc[0]);
            PG8_BAR; PG8_WAIT_L(0); PG8_MMA(1, 0, At, B0); PG8_BAR; PG8_SCHED;
            PG8_STAGE(PG8_SB(0, 1), b2 + hstep, voffB);
            PG8_WAIT_V(6); PG8_BAR; PG8_MMA(1, 1, At, B1); PG8_BAR;
            PG8_LDB(B0, 1, 0); PG8_SCHED; PG8_LDA(At, 1, 0); PG8_STAGE(PG8_SA(0, 1), a2, vAc[1]);
            PG8_WAIT_L(8); PG8_BAR; PG8_WAIT_L(0); PG8_MMA(0, 0, At, B0); PG8_BAR; PG8_SCHED;
            PG8_LDB(B1, 1, 1); PG8_STAGE(PG8_SB(1, 0), b3, voffB);
            PG8_BAR; PG8_WAIT_L(0); PG8_MMA(0, 1, At, B1); PG8_BAR;
            PG8_LDA(At, 1, 1); PG8_STAGE(PG8_SA(1, 0), a3, vAc[0]);
            PG8_BAR; PG8_WAIT_L(0); PG8_MMA(1, 0, At, B0); PG8_BAR; PG8_SCHED;
            PG8_STAGE(PG8_SB(1, 1), b3 + hstep, voffB);
            PG8_WAIT_V(6); PG8_BAR; PG8_MMA(1, 1, At, B1); PG8_BAR;
            }
        }
        if constexpr (ALIGN_EPI) { if (wr == 0) PG8_BAR; }
        E(acc, cur, wr, wc, fr, fq);
        if (!has_next) break;
#pragma unroll
        for (int a = 0; a < 2; ++a)
#pragma unroll
            for (int b = 0; b < 2; ++b)
#pragma unroll
                for (int m = 0; m < 4; ++m)
#pragma unroll
                    for (int n = 0; n < 2; ++n) acc[a][b][m][n] = (f32x4){0.f, 0.f, 0.f, 0.f};
        cur = nxt; cA = nA; cB = nB; ++ui;
        if constexpr (ALIGN_EPI) { if (wr == 1) PG8_BAR; }
    }
    PG8_WAIT_V(0);
    if constexpr (!ALIGN_EPI) { if (wr == 0) PG8_BAR; }
    PG8_BAR;
#undef PG8_SA
#undef PG8_AOFF
#undef PG8_STASH
#undef PG8_SB
#undef PG8_STAGE
#undef PG8_LDA
#undef PG8_LDB
#undef PG8_MMA
#undef PG8_WAIT_V
#undef PG8_WAIT_L
#undef PG8_BAR
#undef PG8_SCHED
}
}

constexpr size_t TSTEP = (size_t)256 * D * 2;
struct SchedQKV {
    static constexpr bool GATHER = false;
    const char *H, *Wqk, *Wv; int G, c;
    __device__ __forceinline__ bool next(int i, pg8::Unit& u) const {
        const int L = i * G + c;
        if (L < 576) { pg8::tile_order(L, 72, 8, u.pm, u.pn); u.kind = 0; u.a = H + (size_t)u.pm * TSTEP; u.b = Wqk + (size_t)u.pn * TSTEP; return true; }
        if (L < 576 + 288) { pg8::tile_order(L - 576, 4, 72, u.pm, u.pn); u.kind = 1; u.a = Wv + (size_t)u.pm * TSTEP; u.b = H + (size_t)u.pn * TSTEP; return true; }
        return false;
    }
    __device__ __forceinline__ unsigned a_off(const pg8::Unit&, int h, int R, int C, int K) const { return (unsigned)((h * 128 + R) * K + C) * 2u; }
};
struct SchedDense {
    static constexpr bool GATHER = false;
    const char *A, *Bt; int nM, nN, G, c;
    __device__ __forceinline__ bool next(int i, pg8::Unit& u) const {
        const int L = i * G + c; if (L >= nM * nN) return false;
        pg8::tile_order(L, nM, nN, u.pm, u.pn); u.kind = 0; u.a = A + (size_t)u.pm * TSTEP; u.b = Bt + (size_t)u.pn * TSTEP; return true;
    }
    __device__ __forceinline__ unsigned a_off(const pg8::Unit&, int h, int R, int C, int K) const { return (unsigned)((h * 128 + R) * K + C) * 2u; }
};
struct SchedWO {
    static constexpr bool GATHER = false;
    const char *A, *Bt; int nM, nN, G, c;
    __device__ __forceinline__ bool next(int i, pg8::Unit& u) const {
        if (G == 256 && nN == 4 && (nM == 64 || nM == 72)) {
            if (i == 0) { const int x = c & 7, j = c >> 3; u.pm = 8 * x + (j >> 2); u.pn = j & 3; }
            else if (i == 1 && nM == 72 && c >= 224) { const int k = c - 224; u.pm = 64 + (k & 7); u.pn = k >> 3; }
            else return false;
        } else {
            const int L = i * G + c; if (L >= nM * nN) return false;
            pg8::tile_order(L, nM, nN, u.pm, u.pn);
        }
        u.kind = 0; u.a = A + (size_t)u.pm * TSTEP; u.b = Bt + (size_t)u.pn * TSTEP; return true;
    }
    __device__ __forceinline__ unsigned a_off(const pg8::Unit&, int h, int R, int C, int K) const { return (unsigned)((h * 128 + R) * K + C) * 2u; }
};
template <bool GATHERT> struct SchedMoe {
    static constexpr bool GATHER = GATHERT;
    const char* A;
    const char* W;
    const int* list; const LAS unsigned* tab; int ntile, nN, G, c; size_t wofs;
    __device__ __forceinline__ bool next(int i, pg8::Unit& u) const {
        const int L = i * G + c; if (L >= ntile * nN) return false;
        const int mt = L / nN; u.pn = L % nN; u.pm = mt; u.kind = 0;
        const unsigned t0 = __builtin_amdgcn_readfirstlane(tab[2 * mt]), t1 = __builtin_amdgcn_readfirstlane(tab[2 * mt + 1]);
        const int e = (int)(t0 >> 20), first = (int)(t0 & 0xfffff);
        u.aux = e; u.valid = (int)t1; u.lst = list + (size_t)e * NTOK + first;
        u.a = GATHERT ? A : A + (size_t)mt * TSTEP;
        u.b = W + (size_t)e * WE_BYTES + wofs + (size_t)u.pn * TSTEP;
        return true;
    }
    __device__ __forceinline__ unsigned a_off(const pg8::Unit& u, int h, int R, int C, int K) const {
        const int rr = h * 128 + R;
        if (!GATHERT) return (unsigned)(rr * K + C) * 2u;
        const int tok = (rr < u.valid) ? u.lst[rr] : 0;
        return (unsigned)(tok * K + C) * 2u;
    }
};

struct EpiQKV {
    static constexpr bool PERM = true;
    bf16_t* QK; bf16_t* VT; const float* rcos; const float* rsin; bool rope;
    __device__ __forceinline__ void operator()(const f32x4 (&acc)[2][2][4][2], const pg8::Unit& u, int wr, int wc, int fr, int fq) const {
        if (u.kind == 0) {
            const float sc = (u.pn < 4) ? QSCALE : 1.f;
            const bool do_rope = rope && (u.pm * 256 < NLAT);
#pragma unroll
            for (int ai = 0; ai < 2; ++ai)
#pragma unroll
                for (int m = 0; m < 4; ++m) {
                    const int row = u.pm * 256 + ai * 128 + wr * 64 + m * 16 + fr;
                    f32x4 v[2][2];
#pragma unroll
                    for (int bj = 0; bj < 2; ++bj)
#pragma unroll
                        for (int n = 0; n < 2; ++n) v[bj][n] = acc[ai][bj][m][n] * sc;
                    if (do_rope) {
                        const int t = row & (SEQ - 1);
#pragma unroll
                        for (int n = 0; n < 2; ++n) {
                            const f32x4 cs = *(const f32x4*)(rcos + t * 32 + 8 * fq + 4 * n), sn = *(const f32x4*)(rsin + t * 32 + 8 * fq + 4 * n);
                            const f32x4 x1 = v[0][n], x2 = v[1][n];
                            v[0][n] = x1 * cs - x2 * sn; v[1][n] = x1 * sn + x2 * cs;
                        }
                    }
                    bf16_t* rowp = QK + (size_t)row * 2048 + u.pn * 256 + wc * 64 + 8 * fq;
#pragma unroll
                    for (int bj = 0; bj < 2; ++bj) {
                        u32x4 o; o.x = cvt_pk_bf16(v[bj][0][0], v[bj][0][1]); o.y = cvt_pk_bf16(v[bj][0][2], v[bj][0][3]); o.z = cvt_pk_bf16(v[bj][1][0], v[bj][1][1]); o.w = cvt_pk_bf16(v[bj][1][2], v[bj][1][3]);
                        *(u32x4*)(rowp + bj * 32) = o;
                    }
                }
        } else {
#pragma unroll
            for (int ai = 0; ai < 2; ++ai)
#pragma unroll
                for (int m = 0; m < 4; ++m) {
                    const int row = u.pm * 256 + ai * 128 + wr * 64 + m * 16 + fr;
                    bf16_t* rowp = VT + (size_t)row * NTOK + u.pn * 256 + wc * 32 + 8 * fq;
#pragma unroll
                    for (int bj = 0; bj < 2; ++bj) {
                        const f32x4 v0 = acc[ai][bj][m][0], v1 = acc[ai][bj][m][1];
                        u32x4 o; o.x = cvt_pk_bf16(v0[0], v0[1]); o.y = cvt_pk_bf16(v0[2], v0[3]); o.z = cvt_pk_bf16(v1[0], v1[1]); o.w = cvt_pk_bf16(v1[2], v1[3]);
                        *(u32x4*)(rowp + bj * 128) = o;
                    }
                }
        }
    }
};
struct EpiWO {
    static constexpr bool PERM = false;
    const float* xin; const float* cin; float* X; const float* gate  ; bool from_input;
    unsigned* done;
    __device__ __forceinline__ void operator()(const f32x4 (&acc)[2][2][4][2], const pg8::Unit& u, int wr, int wc, int fr, int fq) const {
        const int r = (u.pm * 256 < NLAT) ? (u.pm * 256) / SEQ : NB;
        const int col0 = u.pn * 256 + wc * 32 + 4 * fq;
        f32x4 g[2][2];
#pragma unroll
        for (int bj = 0; bj < 2; ++bj)
#pragma unroll
            for (int n = 0; n < 2; ++n) g[bj][n] = *(const f32x4*)(gate + (size_t)r * (NMOD * D) + col0 + bj * 128 + n * 16);
#pragma unroll
        for (int ai = 0; ai < 2; ++ai) {
            f32x4 bs[4][2][2];
#pragma unroll
            for (int m = 0; m < 4; ++m) {
                const int row = u.pm * 256 + ai * 128 + wr * 64 + m * 16 + fr;
                const float* base = from_input ? (row < NLAT ? xin + (size_t)row * D : cin + (size_t)(row - NLAT) * D) : X + (size_t)row * D;
#pragma unroll
                for (int bj = 0; bj < 2; ++bj)
#pragma unroll
                    for (int n = 0; n < 2; ++n) bs[m][bj][n] = *(const f32x4*)(base + col0 + bj * 128 + n * 16);
            }
#pragma unroll
            for (int m = 0; m < 4; ++m) {
                const int row = u.pm * 256 + ai * 128 + wr * 64 + m * 16 + fr;
                float* outp = X + (size_t)row * D;
#pragma unroll
                for (int bj = 0; bj < 2; ++bj)
#pragma unroll
                    for (int n = 0; n < 2; ++n) { const f32x4 val = bs[m][bj][n] + g[bj][n] * acc[ai][bj][m][n]; float* dst = outp + col0 + bj * 128 + n * 16;
                        asm volatile("global_store_dwordx4 %0, %1, off sc1" :: "v"(dst), "v"(val) : "memory"); }
            }
            asm volatile("" ::: "memory");
        }
        asm volatile("s_waitcnt vmcnt(0)" ::: "memory");
        if ((tidx() & 63) == 0) __hip_atomic_fetch_add(done + u.pm, 1u, __ATOMIC_RELAXED, __HIP_MEMORY_SCOPE_AGENT);
    }
};
struct EpiGLU {
    static constexpr bool PERM = true;
    bf16_t* ACT;
    __device__ __forceinline__ void operator()(const f32x4 (&acc)[2][2][4][2], const pg8::Unit& u, int wr, int wc, int fr, int fq) const {
#pragma unroll
        for (int ai = 0; ai < 2; ++ai)
#pragma unroll
            for (int m = 0; m < 4; ++m) {
                const int row = u.pm * 256 + ai * 128 + wr * 64 + m * 16 + fr;
                float t[8];
#pragma unroll
                for (int n = 0; n < 2; ++n)
#pragma unroll
                    for (int q = 0; q < 4; ++q) { const float a = acc[ai][0][m][n][q], b = acc[ai][1][m][n][q]; t[4 * n + q] = a * __builtin_amdgcn_rcpf(1.f + __builtin_amdgcn_exp2f(-a * LOG2E)) * b; }
                u32x4 o; o.x = cvt_pk_bf16(t[0], t[1]); o.y = cvt_pk_bf16(t[2], t[3]); o.z = cvt_pk_bf16(t[4], t[5]); o.w = cvt_pk_bf16(t[6], t[7]);
                *(u32x4*)(ACT + (size_t)row * D + u.pn * 128 + wc * 32 + 8 * fq) = o;
            }
    }
};
struct EpiDown {
    static constexpr bool PERM = true;
    bf16_t* Y;
    __device__ __forceinline__ void operator()(const f32x4 (&acc)[2][2][4][2], const pg8::Unit& u, int wr, int wc, int fr, int fq) const {
#pragma unroll
        for (int ai = 0; ai < 2; ++ai)
#pragma unroll
            for (int m = 0; m < 4; ++m) {
                const int row = u.pm * 256 + ai * 128 + wr * 64 + m * 16 + fr;
                bf16_t* rowp = Y + (size_t)row * D + u.pn * 256 + wc * 32 + 8 * fq;
#pragma unroll
                for (int bj = 0; bj < 2; ++bj) {
                    const f32x4 v0 = acc[ai][bj][m][0], v1 = acc[ai][bj][m][1];
                    u32x4 o; o.x = cvt_pk_bf16(v0[0], v0[1]); o.y = cvt_pk_bf16(v0[2], v0[3]); o.z = cvt_pk_bf16(v1[0], v1[1]); o.w = cvt_pk_bf16(v1[2], v1[3]);
                    *(u32x4*)(rowp + bj * 128) = o;
                }
            }
    }
};

__device__ __forceinline__ unsigned pk2_rne(float lo, float hi) { return (unsigned)f2bf(lo) | ((unsigned)f2bf(hi) << 16); }
__device__ __forceinline__ void conv_item(const float* W, int ldw, int k0, int n0, bf16_t* WT, int drow0, LAS float* scr, int lane) {
    float t[32];
    const float* src = W + (size_t)(k0 + (lane >> 5)) * ldw + n0 + (lane & 31);
#pragma unroll
    for (int i = 0; i < 32; ++i) t[i] = __builtin_nontemporal_load(src + (size_t)(2 * i) * ldw);
#pragma unroll
    for (int i = 0; i < 32; ++i) scr[(2 * i + (lane >> 5)) * 33 + (lane & 31)] = t[i];
    asm volatile("s_waitcnt lgkmcnt(0)" ::: "memory");
    const int c = lane & 7;
#pragma unroll
    for (int j = 0; j < 4; ++j) { const int n = (lane >> 3) + 8 * j; const LAS float* s = scr + (8 * c) * 33 + n;
        u32x4 o; o.x = pk2_rne(s[0 * 33], s[1 * 33]); o.y = pk2_rne(s[2 * 33], s[3 * 33]); o.z = pk2_rne(s[4 * 33], s[5 * 33]); o.w = pk2_rne(s[6 * 33], s[7 * 33]);
        __builtin_nontemporal_store(o, (u32x4*)(WT + (size_t)(drow0 + n) * D + k0 + 8 * c)); }
    asm volatile("s_waitcnt lgkmcnt(0)" ::: "memory");
}
constexpr int CONV_QKV = 16 * 96, CONV_O = 16 * 32, CONV_E = 16 * 32, CONV_LAYER = CONV_QKV + CONV_O + NE * 3 * CONV_E;
__device__ __forceinline__ void conv_layer_item(const Params& p, unsigned char* ws, int l, int r, LAS float* scr, int lane) {
    unsigned char* wl = ws + WS_W + (size_t)l * WL_BYTES;
    if (r < CONV_QKV) {
        const int kb = r / 96, nb = r % 96, n0 = nb * 32;
        if (n0 < 2048) { const int pn = n0 >> 8, a = n0 & 255, hd = a >> 6, half = (a >> 5) & 1;
            conv_item(p.w_qkv + (size_t)l * D * 3072, 3072, kb * 64, n0, (bf16_t*)(wl + WO_QK), pn * 256 + half * 128 + hd * 32, scr, lane); }
        else conv_item(p.w_qkv + (size_t)l * D * 3072, 3072, kb * 64, n0, (bf16_t*)(wl + WO_V), n0 - 2048, scr, lane);
        return;
    }
    r -= CONV_QKV;
    if (r < CONV_O) { const int kb = r / 32, nb = r % 32; conv_item(p.w_o + (size_t)l * D * D, D, kb * 64, nb * 32, (bf16_t*)(wl + WO_O), nb * 32, scr, lane); return; }
    r -= CONV_O;
    const int e = r / (3 * CONV_E), r2 = r % (3 * CONV_E), which = r2 / CONV_E, r3 = r2 % CONV_E, kb = r3 / 32, nb = r3 % 32, n0 = nb * 32;
    unsigned char* we = wl + WO_E + (size_t)e * WE_BYTES;
    const size_t eo = ((size_t)l * NE + e) * D * D;
    if (which == 0) conv_item(p.wg + eo, D, kb * 64, n0, (bf16_t*)we, (n0 >> 7) * 256 + (n0 & 127), scr, lane);
    else if (which == 1) conv_item(p.wu + eo, D, kb * 64, n0, (bf16_t*)we, (n0 >> 7) * 256 + 128 + (n0 & 127), scr, lane);
    else conv_item(p.wd + eo, D, kb * 64, n0, (bf16_t*)(we + WE_2), n0, scr, lane);
}
__device__ __forceinline__ void phase_convert(const Params& p, unsigned char* ws, LAS unsigned char* lds, int layer_lo, int layer_hi) {
    const int tid = tidx(), lane = tid & 63, wave = tid >> 6;
    LAS float* scr = (LAS float*)(lds + wave * 16384);
    const int gw = bidx() * NWAVE + wave, ngw = gridDim.x * NWAVE;
    for (int l = layer_lo; l < layer_hi; ++l)
        for (int it = gw; it < CONV_QKV + CONV_O; it += ngw) conv_layer_item(p, ws, l, it, scr, lane);
}
constexpr int CONV_CHUNK = 4, CW_CONVQ = 6144;
constexpr int CONV_A = CONV_QKV + CONV_O;
__device__ __forceinline__ int convert_pull(const Params& p, unsigned char* ws, LAS unsigned char* lds, int l, int budget, int part) {
    if (l >= DEPTH) return 0;
    const int tid = tidx(), lane = tid & 63, wave = tid >> 6;
    LAS float* scr = (LAS float*)(lds + wave * 16384);
    volatile LAS unsigned* slot = (volatile LAS unsigned*)(lds + MISC_OFF + 96);
    unsigned* q = (unsigned*)(ws + WS_CTL) + CW_CONVQ + 64 * l + 32 * part;
    const unsigned lo = part ? (unsigned)CONV_A : 0u, n = part ? (unsigned)(CONV_LAYER - CONV_A) : (unsigned)CONV_A;
    int c = 0;
    for (; budget < 0 || c < budget; ++c) {
        if (tid == 0) *slot = __hip_atomic_fetch_add(q, (unsigned)(CONV_CHUNK * NWAVE), __ATOMIC_RELAXED, __HIP_MEMORY_SCOPE_AGENT);
        __syncthreads();
        const unsigned base = *slot;
        __syncthreads();
        if (base >= n) break;
        for (int k = 0; k < CONV_CHUNK; ++k) conv_layer_item(p, ws, l, (int)(lo + base) + wave * CONV_CHUNK + k, scr, lane);
    }
    return c;
}

__device__ __forceinline__ int build_tile_table(const Ws& w, int layer, LAS unsigned* tab) {
    int cnt[NE], off[NE + 1];
    expert_offsets(w, layer, cnt, off);
    const int tid = tidx();
    if (tid < 256) {
        int e = -1;
#pragma unroll
        for (int q = 0; q < NE; ++q) if (tid * 256 >= off[q] && tid * 256 < off[q + 1]) e = q;
        int oe = 0, ce = 0;
#pragma unroll
        for (int q = 0; q < NE; ++q) if (q == e) { oe = off[q]; ce = cnt[q]; }
        if (e >= 0) { const int first = tid * 256 - oe; const int valid = min(256, ce - first);
            tab[2 * tid] = ((unsigned)e << 20) | (unsigned)first; tab[2 * tid + 1] = (unsigned)valid; }
    }
    __syncthreads();
    return off[NE] / 256;
}

namespace att {
typedef float f32x16 __attribute__((ext_vector_type(16)));
constexpr int STAGE_B = 32768, K_OFF = 0, V_OFF = 16384, RPB_OFF = 65536, RPB_W = 144, XCH_OFF = 0;
__device__ __forceinline__ int swz(int row, int chunk) { return row * 128 + ((chunk ^ ((row >> 1) & 7)) << 4); }
__device__ __forceinline__ int pi64(int r) { return (r & ~12) | ((r & 4) << 1) | ((r & 8) >> 1); }

template <int DV, int NKSUB> struct Stage { u32x4 k[NKSUB]; u32x4 v[DV / 64]; };

template <int DV, int NKSUB>
__device__ __forceinline__ void stage_load(Stage<DV, NKSUB>& st, const bf16_t* QK, const bf16_t* VT, int tok0, int kcolbase, int vch0, int tid) {
#pragma unroll
    for (int i = 0; i < NKSUB; ++i) { const int idx = tid + NTHR * i, row = idx / (8 * NKSUB), cc = idx % (8 * NKSUB);
        st.k[i] = *(const u32x4*)(QK + (size_t)(tok0 + row) * 2048 + 1024 + kcolbase + cc * 8); }
#pragma unroll
    for (int i = 0; i < DV / 64; ++i) { const int idx = tid + NTHR * i, row = idx >> 3, ch = idx & 7;
        st.v[i] = *(const u32x4*)(VT + (size_t)(vch0 + row) * NTOK + tok0 + ch * 8); }
}
template <int DV, int NKSUB>
__device__ __forceinline__ void stage_store(const Stage<DV, NKSUB>& st, LAS unsigned char* buf, int tid) {
#pragma unroll
    for (int i = 0; i < NKSUB; ++i) { const int idx = tid + NTHR * i, row = idx / (8 * NKSUB), cc = idx % (8 * NKSUB), sub = cc >> 3, ch = cc & 7;
        *(LAS u32x4*)(buf + K_OFF + sub * 8192 + swz(pi64(row), ch)) = st.k[i]; }
#pragma unroll
    for (int i = 0; i < DV / 64; ++i) { const int idx = tid + NTHR * i, row = idx >> 3, ch = idx & 7;
        *(LAS u32x4*)(buf + V_OFF + swz(row, ch)) = st.v[i]; }
}

__device__ __forceinline__ void stage_store_nat(const Stage<64, 1>& st, LAS unsigned char* buf, int tid) {
    { const int row = tid >> 3, ch = tid & 7; *(LAS u32x4*)(buf + K_OFF + swz(row, ch)) = st.k[0]; }
    { const int row = tid >> 3, ch = tid & 7; *(LAS u32x4*)(buf + V_OFF + swz(row, ch)) = st.v[0]; }
}
constexpr float ATT_THR = 8.f;
#ifndef ATT_PRIO
#define ATT_PRIO 1
#endif
template <int DV, bool BIAS>
__device__ __forceinline__ void qk_softmax(const LAS unsigned char* kb, const bf16x8 (&qf)[4], f32x16 (&o)[DV / 32], float& mref, float& l, bool& started,
                                           const float (&pen)[32], const LAS float* brow, int r, int h, bf16x8 (&pb)[4]) {
    f32x16 p0, p1;
#pragma unroll
    for (int i = 0; i < 16; ++i) { p0[i] = -mref; p1[i] = -mref; }
    bf16x8 kfa[4], kfb[4];
#pragma unroll
    for (int s = 0; s < 2; ++s) { kfa[2 * s] = *(const LAS bf16x8*)(kb + swz(r, 2 * s + h)); kfa[2 * s + 1] = *(const LAS bf16x8*)(kb + swz(32 + r, 2 * s + h)); }
#pragma unroll
    for (int s = 2; s < 4; ++s) { kfb[2 * (s - 2)] = *(const LAS bf16x8*)(kb + swz(r, 2 * s + h)); kfb[2 * (s - 2) + 1] = *(const LAS bf16x8*)(kb + swz(32 + r, 2 * s + h)); }
    __builtin_amdgcn_sched_barrier(0);
    if (ATT_PRIO) __builtin_amdgcn_s_setprio(1);
#pragma unroll
    for (int s = 0; s < 2; ++s) { p0 = __builtin_amdgcn_mfma_f32_32x32x16_bf16(kfa[2 * s], qf[s], p0, 0, 0, 0); p1 = __builtin_amdgcn_mfma_f32_32x32x16_bf16(kfa[2 * s + 1], qf[s], p1, 0, 0, 0); }
#pragma unroll
    for (int s = 2; s < 4; ++s) { p0 = __builtin_amdgcn_mfma_f32_32x32x16_bf16(kfb[2 * (s - 2)], qf[s], p0, 0, 0, 0); p1 = __builtin_amdgcn_mfma_f32_32x32x16_bf16(kfb[2 * (s - 2) + 1], qf[s], p1, 0, 0, 0); }
    if (ATT_PRIO) __builtin_amdgcn_s_setprio(0);
    __builtin_amdgcn_sched_barrier(0);
    if (BIAS) {
#pragma unroll
        for (int i = 0; i < 16; ++i) { const int kcl = 16 * (i >> 3) + (i & 7);
            p0[i] = (p0[i] + pen[i]) + brow[kcl]; p1[i] = (p1[i] + pen[16 + i]) + brow[32 + kcl]; }
    }
    float ma = fmaxf(fmaxf(p0[0], p0[1]), p1[0]), mb = fmaxf(fmaxf(p0[2], p0[3]), p1[1]);
    ma = fmaxf(fmaxf(ma, p1[2]), p1[3]);
#pragma unroll
    for (int i = 4; i < 16; i += 4) { ma = fmaxf(fmaxf(ma, p0[i]), p0[i + 1]); mb = fmaxf(fmaxf(mb, p0[i + 2]), p0[i + 3]); ma = fmaxf(fmaxf(ma, p1[i]), p1[i + 1]); mb = fmaxf(fmaxf(mb, p1[i + 2]), p1[i + 3]); }
    float mx = fmaxf(ma, mb);
    mx = fmaxf(mx, __shfl_xor(mx, 32));
    const bool need = (!started && mx > -INFINITY) || (mx > ATT_THR);
    if (__any(need)) {
        const float delta = need ? (started ? fmaxf(mx, 0.f) : mx) : 0.f;
        const float alpha = started ? __builtin_amdgcn_exp2f(-delta) : 1.f;
        started = started || need;
        mref += delta;
#pragma unroll
        for (int i = 0; i < 16; ++i) { p0[i] -= delta; p1[i] -= delta; }
        l *= alpha;
#pragma unroll
        for (int b = 0; b < DV / 32; ++b)
#pragma unroll
            for (int i = 0; i < 16; ++i) o[b][i] *= alpha;
    }
    float rs = 0.f;
#pragma unroll
    for (int i = 0; i < 16; ++i) { p0[i] = __builtin_amdgcn_exp2f(p0[i]); p1[i] = __builtin_amdgcn_exp2f(p1[i]); rs += p0[i] + p1[i]; }
    l += rs;
#pragma unroll
    for (int ks = 0; ks < 4; ++ks) {
        u32x4 t;
        if (ks < 2) { t.x = cvt_pk_bf16(p0[8 * ks + 0], p0[8 * ks + 1]); t.y = cvt_pk_bf16(p0[8 * ks + 2], p0[8 * ks + 3]); t.z = cvt_pk_bf16(p0[8 * ks + 4], p0[8 * ks + 5]); t.w = cvt_pk_bf16(p0[8 * ks + 6], p0[8 * ks + 7]); }
        else { const int q = ks - 2; t.x = cvt_pk_bf16(p1[8 * q + 0], p1[8 * q + 1]); t.y = cvt_pk_bf16(p1[8 * q + 2], p1[8 * q + 3]); t.z = cvt_pk_bf16(p1[8 * q + 4], p1[8 * q + 5]); t.w = cvt_pk_bf16(p1[8 * q + 6], p1[8 * q + 7]); }
        pb[ks] = __builtin_bit_cast(bf16x8, t);
    }
}
template <int DV>
__device__ __forceinline__ void pv_accum(const LAS unsigned char* vb, const bf16x8 (&pb)[4], f32x16 (&o)[DV / 32], int r, int h) {
    bf16x8 vfa[4], vfb[4];
#pragma unroll
    for (int ks = 0; ks < 4; ++ks) vfa[ks] = *(const LAS bf16x8*)(vb + swz(r, 2 * ks + h));
#pragma unroll
    for (int b = 0; b < DV / 32; b += 2) {
        if (b + 1 < DV / 32) {
#pragma unroll
            for (int ks = 0; ks < 4; ++ks) vfb[ks] = *(const LAS bf16x8*)(vb + swz(32 * (b + 1) + r, 2 * ks + h));
        }
        __builtin_amdgcn_sched_barrier(0);
        if (ATT_PRIO) __builtin_amdgcn_s_setprio(1);
#pragma unroll
        for (int ks = 0; ks < 4; ++ks) o[b] = __builtin_amdgcn_mfma_f32_32x32x16_bf16(vfa[ks], pb[ks], o[b], 0, 0, 0);
        if (ATT_PRIO) __builtin_amdgcn_s_setprio(0);
        if (b + 2 < DV / 32) {
#pragma unroll
            for (int ks = 0; ks < 4; ++ks) vfa[ks] = *(const LAS bf16x8*)(vb + swz(32 * (b + 2) + r, 2 * ks + h));
        }
        __builtin_amdgcn_sched_barrier(0);
        if (b + 1 < DV / 32) {
            if (ATT_PRIO) __builtin_amdgcn_s_setprio(1);
#pragma unroll
            for (int ks = 0; ks < 4; ++ks) o[b + 1] = __builtin_amdgcn_mfma_f32_32x32x16_bf16(vfb[ks], pb[ks], o[b + 1], 0, 0, 0);
            if (ATT_PRIO) __builtin_amdgcn_s_setprio(0);
        }
    }
}
template <bool HAVE_PREV>
__device__ __forceinline__ void diff_step(const LAS unsigned char* kb, const LAS unsigned char* vb, const LAS unsigned char* qb, f32x16 (&o)[4], float& mref, float& l, bool& started,
                                          bf16x8 (&pb)[4], int r, int h) {
    f32x16 p0, p1;
#pragma unroll
    for (int i = 0; i < 16; ++i) { p0[i] = -mref; p1[i] = -mref; }
    bf16x8 kfa[4], kfb[4], vfa[4], vfb[4], qf[4];
#pragma unroll
    for (int s = 0; s < 4; ++s) qf[s] = *(const LAS bf16x8*)(qb + s * 1024);
#pragma unroll
    for (int s = 0; s < 2; ++s) { kfa[2 * s] = *(const LAS bf16x8*)(kb + swz(r, 2 * s + h)); kfa[2 * s + 1] = *(const LAS bf16x8*)(kb + swz(32 + r, 2 * s + h)); }
#pragma unroll
    for (int s = 2; s < 4; ++s) { kfb[2 * (s - 2)] = *(const LAS bf16x8*)(kb + swz(r, 2 * s + h)); kfb[2 * (s - 2) + 1] = *(const LAS bf16x8*)(kb + swz(32 + r, 2 * s + h)); }
    __builtin_amdgcn_sched_barrier(0);
    if (ATT_PRIO) __builtin_amdgcn_s_setprio(1);
#pragma unroll
    for (int s = 0; s < 2; ++s) { p0 = __builtin_amdgcn_mfma_f32_32x32x16_bf16(kfa[2 * s], qf[s], p0, 0, 0, 0); p1 = __builtin_amdgcn_mfma_f32_32x32x16_bf16(kfa[2 * s + 1], qf[s], p1, 0, 0, 0); }
    if (HAVE_PREV) {
#pragma unroll
        for (int b2 = 0; b2 < 4; ++b2) vfa[b2] = *(const LAS bf16x8*)(vb + swz(32 * b2 + r, h));
    }
#pragma unroll
    for (int s = 2; s < 4; ++s) { p0 = __builtin_amdgcn_mfma_f32_32x32x16_bf16(kfb[2 * (s - 2)], qf[s], p0, 0, 0, 0); p1 = __builtin_amdgcn_mfma_f32_32x32x16_bf16(kfb[2 * (s - 2) + 1], qf[s], p1, 0, 0, 0); }
    if (ATT_PRIO) __builtin_amdgcn_s_setprio(0);
    __builtin_amdgcn_sched_barrier(0);
    float ma = fmaxf(fmaxf(p0[0], p0[1]), p1[0]), mb = fmaxf(fmaxf(p0[2], p0[3]), p1[1]);
    ma = fmaxf(fmaxf(ma, p1[2]), p1[3]);
#pragma unroll
    for (int i = 4; i < 16; i += 4) { ma = fmaxf(fmaxf(ma, p0[i]), p0[i + 1]); mb = fmaxf(fmaxf(mb, p0[i + 2]), p0[i + 3]); ma = fmaxf(fmaxf(ma, p1[i]), p1[i + 1]); mb = fmaxf(fmaxf(mb, p1[i + 2]), p1[i + 3]); }
    float mx = fmaxf(ma, mb);
    mx = fmaxf(mx, __shfl_xor(mx, 32));
    const bool need = (!started && mx > -INFINITY) || (mx > ATT_THR);
    if (__any(need)) {
        const float delta = need ? ceilf(started ? fmaxf(mx, 0.f) : mx) : 0.f;
        const float alpha = started ? __builtin_amdgcn_ldexpf(1.f, -(int)delta) : 1.f;
        started = started || need;
        mref += delta;
#pragma unroll
        for (int i = 0; i < 16; ++i) { p0[i] -= delta; p1[i] -= delta; }
        l *= alpha;
#pragma unroll
        for (int b = 0; b < 4; ++b)
#pragma unroll
            for (int i = 0; i < 16; ++i) o[b][i] *= alpha;
        if (HAVE_PREV) {
#pragma unroll
            for (int ks = 0; ks < 4; ++ks) {
                u32x4 t = __builtin_bit_cast(u32x4, pb[ks]);
#pragma unroll
                for (int j = 0; j < 4; ++j) { const float lo = __uint_as_float(t[j] << 16) * alpha, hi = __uint_as_float(t[j] & 0xffff0000u) * alpha;
                    t[j] = (__float_as_uint(lo) >> 16) | (__float_as_uint(hi) & 0xffff0000u); }
                pb[ks] = __builtin_bit_cast(bf16x8, t);
            }
        }
    }
    float rs0 = 0.f, rs1 = 0.f;
#pragma unroll
    for (int ks = 0; ks < 4; ++ks) {
        if (HAVE_PREV && ks + 1 < 4) {
            if ((ks & 1) == 0) {
#pragma unroll
                for (int b2 = 0; b2 < 4; ++b2) vfb[b2] = *(const LAS bf16x8*)(vb + swz(32 * b2 + r, 2 * (ks + 1) + h));
            } else {
#pragma unroll
                for (int b2 = 0; b2 < 4; ++b2) vfa[b2] = *(const LAS bf16x8*)(vb + swz(32 * b2 + r, 2 * (ks + 1) + h));
            }
        }
        u32x4 pn;
#pragma unroll
        for (int b2 = 0; b2 < 4; ++b2) {
            if (HAVE_PREV) {
                __builtin_amdgcn_sched_barrier(0);
                o[b2] = __builtin_amdgcn_mfma_f32_32x32x16_bf16((ks & 1) ? vfb[b2] : vfa[b2], pb[ks], o[b2], 0, 0, 0);
                __builtin_amdgcn_sched_barrier(0);
            }
            const int e0 = 8 * (ks & 1) + 2 * b2;
            float x0, x1; unsigned pk;
            asm volatile("v_exp_f32 %0, %5\n\tv_exp_f32 %1, %6\n\tv_add_f32 %2, %2, %0\n\tv_add_f32 %3, %3, %1\n\tv_cvt_pk_bf16_f32 %4, %0, %1"
                         : "=&v"(x0), "=&v"(x1), "+v"(rs0), "+v"(rs1), "=v"(pk) : "v"(ks < 2 ? p0[e0] : p1[e0]), "v"(ks < 2 ? p0[e0 + 1] : p1[e0 + 1]));
            pn[b2] = pk;
            __builtin_amdgcn_sched_barrier(0);
        }
        pb[ks] = __builtin_bit_cast(bf16x8, pn);
    }
    l += rs0 + rs1;
}
template <int DV, bool BIAS>
__device__ __forceinline__ void tile_compute(const LAS unsigned char* buf, int ksub, const bf16x8 (&qf)[4], f32x16 (&o)[DV / 32], float& mref, float& l, bool& started,
                                             const float (&pen)[32], const LAS float* brow, int r, int h) {
    bf16x8 pb[4];
    qk_softmax<DV, BIAS>(buf + K_OFF + ksub * 8192, qf, o, mref, l, started, pen, brow, r, h, pb);
    __builtin_amdgcn_sched_barrier(0);
    pv_accum<DV>(buf + V_OFF, pb, o, r, h);
}

__device__ __forceinline__ void band_tile32(const LAS unsigned char* kb, const LAS unsigned char* vb, int x0, const bf16x8 (&qf)[4], f32x16 (&o)[2], float& mref, float& l, bool& started,
                                            const float (&pen16)[16], f32x16& penm, const LAS float* brow, int r, int h) {
    f32x16 p0;
    const int krow = x0 + pi64(r);
    bf16x8 kf[4];
#pragma unroll
    for (int s = 0; s < 4; ++s) kf[s] = *(const LAS bf16x8*)(kb + swz(krow, 2 * s + h));
    __builtin_amdgcn_sched_barrier(0);
    if (ATT_PRIO) __builtin_amdgcn_s_setprio(1);
    p0 = __builtin_amdgcn_mfma_f32_32x32x16_bf16(kf[0], qf[0], penm, 0, 0, 0);
#pragma unroll
    for (int s = 1; s < 4; ++s) p0 = __builtin_amdgcn_mfma_f32_32x32x16_bf16(kf[s], qf[s], p0, 0, 0, 0);
    if (ATT_PRIO) __builtin_amdgcn_s_setprio(0);
    const int vch = (x0 >> 3) + h;
    bf16x8 vf[4];
#pragma unroll
    for (int b = 0; b < 2; ++b)
#pragma unroll
        for (int ks = 0; ks < 2; ++ks) vf[2 * b + ks] = *(const LAS bf16x8*)(vb + swz(32 * b + r, vch + 2 * ks));
    __builtin_amdgcn_sched_barrier(0);
#pragma unroll
    for (int i = 0; i < 16; ++i) p0[i] += brow[16 * (i >> 3) + (i & 7)];
    float ma = fmaxf(fmaxf(p0[0], p0[1]), p0[2]), mb = fmaxf(fmaxf(p0[3], p0[4]), p0[5]);
#pragma unroll
    for (int i = 6; i < 16; i += 2) { ma = fmaxf(ma, p0[i]); mb = fmaxf(mb, p0[i + 1]); }
    float mx = fmaxf(ma, mb);
    mx = fmaxf(mx, __shfl_xor(mx, 32));
    const bool need = (!started && mx > -INFINITY) || (mx > ATT_THR);
    if (__any(need)) {
        const float delta = need ? (started ? fmaxf(mx, 0.f) : mx) : 0.f;
        const float alpha = started ? __builtin_amdgcn_exp2f(-delta) : 1.f;
        started = started || need;
        mref += delta;
#pragma unroll
        for (int i = 0; i < 16; ++i) { p0[i] -= delta; penm[i] = pen16[i] - mref; }
        l *= alpha;
#pragma unroll
        for (int b = 0; b < 2; ++b)
#pragma unroll
            for (int i = 0; i < 16; ++i) o[b][i] *= alpha;
    }
    float rs = 0.f;
#pragma unroll
    for (int i = 0; i < 16; ++i) { p0[i] = __builtin_amdgcn_exp2f(p0[i]); rs += p0[i]; }
    l += rs;
    bf16x8 pb[2];
#pragma unroll
    for (int ks = 0; ks < 2; ++ks) { u32x4 t; t.x = cvt_pk_bf16(p0[8 * ks + 0], p0[8 * ks + 1]); t.y = cvt_pk_bf16(p0[8 * ks + 2], p0[8 * ks + 3]); t.z = cvt_pk_bf16(p0[8 * ks + 4], p0[8 * ks + 5]); t.w = cvt_pk_bf16(p0[8 * ks + 6], p0[8 * ks + 7]);
        pb[ks] = __builtin_bit_cast(bf16x8, t); }
    __builtin_amdgcn_sched_barrier(0);
    if (ATT_PRIO) __builtin_amdgcn_s_setprio(1);
#pragma unroll
    for (int b = 0; b < 2; ++b)
#pragma unroll
        for (int ks = 0; ks < 2; ++ks) o[b] = __builtin_amdgcn_mfma_f32_32x32x16_bf16(vf[2 * b + ks], pb[ks], o[b], 0, 0, 0);
    if (ATT_PRIO) __builtin_amdgcn_s_setprio(0);
}

__device__ __forceinline__ void natten_phase(const Params& P, const Ws& w, LAS unsigned char* lds, int layer) {
    const bool last = (layer == DEPTH - 1);
    const float* rpb = P.na_rpb + (size_t)(layer / 2) * 16 * 15 * 31;
    LAS float* rtab = (LAS float*)(lds + RPB_OFF);
    const int nlat = NB * 16 * 8, nctx = last ? 0 : NB * 16;
    int tab_head = -1;
    const int vcu = (gridDim.x % 8 == 0) ? (bidx() % 8) * ((int)gridDim.x / 8) + bidx() / 8 : bidx();
    bf16x8 qn[4];
#pragma unroll
    for (int s = 0; s < 4; ++s) qn[s] = bf16x8{0, 0, 0, 0, 0, 0, 0, 0};
    bool pref = false; int par = 0;
    for (int u = vcu; u < nlat + nctx; u += gridDim.x) {
        const int tid = tidx(), lane = tid & 63, wave = __builtin_amdgcn_readfirstlane(tid >> 6), r = lane & 31, h = lane >> 5;
        const bool isctx = (u >= nlat);
        int b, head, rg = 0;
        if (!isctx) { rg = ((u & 7) + 2 * (u >> 8)) & 7; head = (u >> 3) & 15; b = u >> 7; } else { const int u2 = u - nlat; head = u2 & 15; b = u2 >> 4; }
        const int cg = wave & 3, rp = wave >> 2;
        const int qr = 4 * rg + 2 * rp + (r >> 4), qc = 16 * cg + (r & 15);
        const int qtok = isctx ? NLAT + b * CL + 32 * wave + r : b * SEQ + qr * GW + qc;
        const int x0 = (cg == 0) ? 0 : (cg == 1) ? 8 : (cg == 2) ? 24 : 32;
        const int c0 = min(max(qc - 8, 0), 48), r0l = min(max(qr - 4, 0), 24);
        const int rfirst = min(max(4 * rg - 4, 0), 24), rlast = min(max(4 * rg + 3 - 4, 0), 24) + 7;
        const int nband = isctx ? 0 : rlast - rfirst + 1, NT = nband + 4;
        const int wlo = min(max(4 * rg + 2 * rp - 4, 0), 24), whi = min(max(4 * rg + 2 * rp + 1 - 4, 0), 24) + 7;
        auto tile_tok = [&](int t) -> int { return (t < nband) ? b * SEQ + (rfirst + t) * GW : NLAT + b * CL + (t - nband) * 64; };
        const int drow = wave * 8 + (lane >> 3), dch = (lane & 7) ^ ((drow >> 1) & 7);
        const unsigned koff_nat = (unsigned)(drow * 2048 + 1024 + head * 64 + dch * 8) * 2u, koff_perm = (unsigned)(pi64(drow) * 2048 + 1024 + head * 64 + dch * 8) * 2u;
        const unsigned voff_d = (unsigned)(((size_t)(head * 64 + drow) * NTOK + dch * 8) * 2u);
#define NDMA_TILE(t_, stage_, sub_) do { const int tok_ = tile_tok(t_); \
            __builtin_amdgcn_global_load_lds((const unsigned*)((const char*)w.QK + (size_t)tok_ * 4096 + (((t_) < nband) ? koff_nat : koff_perm)), (LAS unsigned*)(lds + (stage_) * STAGE_B + K_OFF + (sub_) * 8192 + wave * 1024), 16, 0, 0); \
            __builtin_amdgcn_global_load_lds((const unsigned*)((const char*)w.VT + (size_t)tok_ * 2 + voff_d), (LAS unsigned*)(lds + (stage_) * STAGE_B + V_OFF + (sub_) * 8192 + wave * 1024), 16, 0, 0); } while (0)
        if (!pref) {
            NDMA_TILE(0, par, 0);
            NDMA_TILE(1, par, 1);
#pragma unroll
            for (int s = 0; s < 4; ++s) qn[s] = *(const bf16x8*)(w.QK + (size_t)qtok * 2048 + head * 64 + 16 * s + 8 * h);
        }
        bf16x8 qf[4];
#pragma unroll
        for (int s = 0; s < 4; ++s) qf[s] = qn[s];
        if (!isctx && head != tab_head) {
            for (int i = tid; i < 16 * RPB_W; i += NTHR) { const int dr = i / RPB_W, d = i % RPB_W - 63;
                rtab[i] = (dr == 15) ? -INFINITY : (d >= -15 && d <= 15) ? rpb[(head * 15 + dr) * 31 + d + 15] * LOG2E : 0.f; }
            tab_head = head;
        }
        float pen16[16];
#pragma unroll
        for (int i = 0; i < 16; ++i) { const int kc = x0 + 16 * (i >> 3) + 8 * h + (i & 7); pen16[i] = ((unsigned)(kc - c0) < 16u) ? 0.f : -INFINITY; }
        float pen[32];
#pragma unroll
        for (int i = 0; i < 32; ++i) pen[i] = 0.f;
        f32x16 o[2], penm;
#pragma unroll
        for (int i = 0; i < 16; ++i) { o[0][i] = 0.f; o[1][i] = 0.f; penm[i] = pen16[i]; }
        float m = 0.f, l = 0.f; bool started = false;
        asm volatile("s_waitcnt vmcnt(0)" ::: "memory");
        __syncthreads();
        const int NS = (NT + 1) >> 1;
        for (int sp = 0; sp < NS; ++sp) {
            if (sp + 1 < NS) { NDMA_TILE(2 * sp + 2, (sp + 1 + par) & 1, 0); if (2 * sp + 3 < NT) NDMA_TILE(2 * sp + 3, (sp + 1 + par) & 1, 1); }
            else {
                const int un = u + (int)gridDim.x;
                pref = un < nlat + nctx;
                if (pref) {
                    const bool ic = (un >= nlat);
                    int bn, hn, rgn = 0;
                    if (!ic) { rgn = ((un & 7) + 2 * (un >> 8)) & 7; hn = (un >> 3) & 15; bn = un >> 7; } else { const int u2 = un - nlat; hn = u2 & 15; bn = u2 >> 4; }
                    const int rfn = min(max(4 * rgn - 4, 0), 24);
                    const int t0n = ic ? NLAT + bn * CL : bn * SEQ + rfn * GW, t1n = ic ? t0n + 64 : t0n + GW;
                    const int qrn = 4 * rgn + 2 * rp + (r >> 4);
                    const int qtokn = ic ? NLAT + bn * CL + 32 * wave + r : bn * SEQ + qrn * GW + qc;
#pragma unroll
                    for (int s = 0; s < 4; ++s) qn[s] = *(const bf16x8*)(w.QK + (size_t)qtokn * 2048 + hn * 64 + 16 * s + 8 * h);
                    const unsigned kon = (unsigned)((ic ? pi64(drow) : drow) * 2048 + 1024 + hn * 64 + dch * 8) * 2u;
                    const unsigned von = (unsigned)(((size_t)(hn * 64 + drow) * NTOK + dch * 8) * 2u);
                    const int stn = (sp + 1 + par) & 1;
                    __builtin_amdgcn_global_load_lds((const unsigned*)((const char*)w.QK + (size_t)t0n * 4096 + kon), (LAS unsigned*)(lds + stn * STAGE_B + K_OFF + wave * 1024), 16, 0, 0);
                    __builtin_amdgcn_global_load_lds((const unsigned*)((const char*)w.VT + (size_t)t0n * 2 + von), (LAS unsigned*)(lds + stn * STAGE_B + V_OFF + wave * 1024), 16, 0, 0);
                    __builtin_amdgcn_global_load_lds((const unsigned*)((const char*)w.QK + (size_t)t1n * 4096 + kon), (LAS unsigned*)(lds + stn * STAGE_B + K_OFF + 8192 + wave * 1024), 16, 0, 0);
                    __builtin_amdgcn_global_load_lds((const unsigned*)((const char*)w.VT + (size_t)t1n * 2 + von), (LAS unsigned*)(lds + stn * STAGE_B + V_OFF + 8192 + wave * 1024), 16, 0, 0);
                }
            }
#pragma unroll
            for (int sub = 0; sub < 2; ++sub) {
                const int t = 2 * sp + sub;
                if (t < NT) {
                    const LAS unsigned char* kb = lds + ((sp + par) & 1) * STAGE_B + K_OFF + sub * 8192;
                    const LAS unsigned char* vb = lds + ((sp + par) & 1) * STAGE_B + V_OFF + sub * 8192;
                    if (t < nband) {
                        const int kr = rfirst + t;
                        if (kr >= wlo && kr <= whi) {
                            const bool rowok = (kr >= r0l) && (kr < r0l + 8);
                            const LAS float* brow = rtab + (rowok ? (kr - qr + 7) : 15) * RPB_W + 63 - qc + x0 + 8 * h;
                            band_tile32(kb, vb, x0, qf, o, m, l, started, pen16, penm, brow, r, h);
                        }
                    } else {
                        bf16x8 pb[4];
                        qk_softmax<64, false>(kb, qf, o, m, l, started, pen, rtab, r, h, pb);
                        __builtin_amdgcn_sched_barrier(0);
                        pv_accum<64>(vb, pb, o, r, h);
                    }
                }
            }
            asm volatile("s_waitcnt vmcnt(0)" ::: "memory");
            __syncthreads();
        }
#undef NDMA_TILE
        par = (NS + par) & 1;
        l += __shfl_xor(l, 32);
        const float il = 1.f / l;
        bf16_t* op = w.O + (size_t)qtok * D + head * 64;
#pragma unroll
        for (int bb = 0; bb < 2; ++bb)
#pragma unroll
            for (int g = 0; g < 4; g += 2) {
                u32x2 a, c2;
                a.x = cvt_pk_bf16(o[bb][4 * g] * il, o[bb][4 * g + 1] * il); a.y = cvt_pk_bf16(o[bb][4 * g + 2] * il, o[bb][4 * g + 3] * il);
                c2.x = cvt_pk_bf16(o[bb][4 * g + 4] * il, o[bb][4 * g + 5] * il); c2.y = cvt_pk_bf16(o[bb][4 * g + 6] * il, o[bb][4 * g + 7] * il);
                const auto sx = __builtin_amdgcn_permlane32_swap(a.x, c2.x, false, false), sy = __builtin_amdgcn_permlane32_swap(a.y, c2.y, false, false);
                u32x4 v; v.x = sx[0]; v.y = sy[0]; v.z = sx[1]; v.w = sy[1];
                *(u32x4*)(op + 32 * bb + 8 * g + 8 * h) = v;
            }
    }
}

__device__ __forceinline__ void diff_phase(const Params& P, const Ws& w, LAS unsigned char* lds, int layer) {
    const int tid = tidx(), lane = tid & 63, wave = __builtin_amdgcn_readfirstlane(tid >> 6), r = lane & 31, h = lane >> 5;
    const bool last = (layer == DEPTH - 1);
    const int j = layer / 2;
    const float* lam = P.diff_lambda + (size_t)j * 4 * 64; const float* sg = P.diff_subln + (size_t)j * 128;
    float d01 = 0.f, d23 = 0.f;
    for (int i = 0; i < 64; ++i) { d01 += lam[i] * lam[64 + i]; d23 += lam[128 + i] * lam[192 + i]; }
    const float li = lam_init_of(layer);
    const float lam_full = expf(d01) - expf(d23) + li;
    const int nlat = NB * 8 * 16, nctx = last ? 0 : NB * 8 * 2;
    const int map = wave >> 2, wq = wave & 3;
    if (tid < 128) ((LAS float*)(lds + TILETAB_OFF))[tid] = sg[tid];
    __syncthreads();
    const int vcu = (gridDim.x % 8 == 0) ? (bidx() % 8) * ((int)gridDim.x / 8) + bidx() / 8 : bidx();
    bf16x8 qn[4];
#pragma unroll
    for (int s = 0; s < 4; ++s) qn[s] = bf16x8{0, 0, 0, 0, 0, 0, 0, 0};
    bool pref = false;
    for (int u = vcu; u < nlat + nctx; u += gridDim.x) {
        const bool isctx = (u >= nlat);
        int b, head, qb;
        if (!isctx) { qb = u & 15; head = (u >> 4) & 7; b = u >> 7; } else { const int u2 = u - nlat; qb = u2 & 1; head = (u2 >> 1) & 7; b = u2 >> 4; }
        const int qtok = (isctx ? NLAT + b * CL : b * SEQ) + 128 * qb + 32 * wq + r;
        const int NT = isctx ? 4 : 36;
        LAS unsigned char* qfl = lds + 65536 + wave * 4096 + lane * 16;
        if (!pref) {
#pragma unroll
            for (int s = 0; s < 4; ++s) qn[s] = *(const bf16x8*)(w.QK + (size_t)qtok * 2048 + head * 128 + map * 64 + 16 * s + 8 * h);
        }
#pragma unroll
        for (int s = 0; s < 4; ++s) *(LAS bf16x8*)(qfl + s * 1024) = qn[s];
        f32x16 o[4];
#pragma unroll
        for (int bb = 0; bb < 4; ++bb)
#pragma unroll
            for (int i = 0; i < 16; ++i) o[bb][i] = 0.f;
        float m = 0.f, l = 0.f; bool started = false;
        float pen[32];
#pragma unroll
        for (int i = 0; i < 32; ++i) pen[i] = 0.f;
        auto tile_tok = [&](int t) -> int { return (!isctx && t < 32) ? b * SEQ + t * 64 : NLAT + b * CL + (isctx ? t : t - 32) * 64; };
        const int drow = wave * 8 + (lane >> 3), dsl = lane & 7;
        const unsigned koffs = (unsigned)(pi64(drow) * 2048 + 1024 + head * 128 + ((dsl ^ ((drow >> 1) & 7)) * 8)) * 2u;
        const unsigned voffs = (unsigned)(((size_t)(head * 128 + drow) * NTOK + ((dsl ^ ((drow >> 1) & 7)) * 8)) * 2u);
#define DMA_K(tok0, bufi) do { _Pragma("unroll") for (int i_ = 0; i_ < 2; ++i_) \
            __builtin_amdgcn_global_load_lds((const unsigned*)((const char*)w.QK + (size_t)(tok0) * 4096 + koffs + i_ * 128), (LAS unsigned*)(lds + (bufi) * STAGE_B + K_OFF + i_ * 8192 + wave * 1024), 16, 0, 0); } while (0)
#define DMA_V(tok0, bufi) do { _Pragma("unroll") for (int i_ = 0; i_ < 2; ++i_) \
            __builtin_amdgcn_global_load_lds((const unsigned*)((const char*)w.VT + (size_t)(tok0) * 2 + voffs + (size_t)i_ * 64 * NTOK * 2), (LAS unsigned*)(lds + (bufi) * STAGE_B + V_OFF + i_ * 8192 + wave * 1024), 16, 0, 0); } while (0)
        if (!pref) { DMA_K(tile_tok(0), 0); DMA_V(tile_tok(0), 0); }
        asm volatile("s_waitcnt vmcnt(0)" ::: "memory");
        __syncthreads();
        bf16x8 pb[4];
#pragma unroll
        for (int ks = 0; ks < 4; ++ks) pb[ks] = bf16x8{0, 0, 0, 0, 0, 0, 0, 0};
        {
            DMA_K(tile_tok(1), 1);
            diff_step<false>(lds + K_OFF + map * 8192, lds + STAGE_B + V_OFF, qfl, o, m, l, started, pb, r, h);
            asm volatile("s_waitcnt vmcnt(0)" ::: "memory");
            __syncthreads();
        }
#pragma nounroll
        for (int t = 1; t < NT; ++t) {
            if (t + 1 < NT) DMA_K(tile_tok(t + 1), (t + 1) & 1);
            DMA_V(tile_tok(t), t & 1);
            const LAS unsigned char* kb = lds + (t & 1) * STAGE_B + K_OFF + map * 8192;
            const LAS unsigned char* vb = lds + ((t + 1) & 1) * STAGE_B + V_OFF;
            diff_step<true>(kb, vb, qfl, o, m, l, started, pb, r, h);
            asm volatile("s_waitcnt vmcnt(0)" ::: "memory");
            __syncthreads();
        }
#undef DMA_K
#undef DMA_V
        int tid2 = tid; asm volatile("" : "+v"(tid2));
        const int r2 = tid2 & 31, h2 = (tid2 >> 5) & 1;
        {
            const int un = u + (int)gridDim.x;
            pref = un < nlat + nctx;
            if (pref) {
                const bool ic = (un >= nlat);
                int bn, hn, qbn;
                if (!ic) { qbn = un & 15; hn = (un >> 4) & 7; bn = un >> 7; } else { const int u2 = un - nlat; qbn = u2 & 1; hn = (u2 >> 1) & 7; bn = u2 >> 4; }
                const int tok0n = ic ? NLAT + bn * CL : bn * SEQ;
                const int qtokn = tok0n + 128 * qbn + 32 * wq + r2;
#pragma unroll
                for (int s = 0; s < 4; ++s) qn[s] = *(const bf16x8*)(w.QK + (size_t)qtokn * 2048 + hn * 128 + map * 64 + 16 * s + 8 * h2);
                const int lane2 = tid2 & 63, drow2 = wave * 8 + (lane2 >> 3), dch2 = (lane2 & 7) ^ ((drow2 >> 1) & 7);
                const unsigned kon = (unsigned)(pi64(drow2) * 2048 + 1024 + hn * 128 + dch2 * 8) * 2u;
                const unsigned von = (unsigned)(((size_t)(hn * 128 + drow2) * NTOK + dch2 * 8) * 2u);
#pragma unroll
                for (int i_ = 0; i_ < 2; ++i_) {
                    __builtin_amdgcn_global_load_lds((const unsigned*)((const char*)w.QK + (size_t)tok0n * 4096 + kon + i_ * 128), (LAS unsigned*)(lds + K_OFF + i_ * 8192 + wave * 1024), 16, 0, 0);
                    __builtin_amdgcn_global_load_lds((const unsigned*)((const char*)w.VT + (size_t)tok0n * 2 + von + (size_t)i_ * 64 * NTOK * 2), (LAS unsigned*)(lds + V_OFF + i_ * 8192 + wave * 1024), 16, 0, 0);
                }
            }
        }
        const int qtok2 = (isctx ? NLAT + b * CL : b * SEQ) + 128 * qb + 32 * wq + r2;
        pv_accum<128>(lds + ((NT - 1) & 1) * STAGE_B + V_OFF, pb, o, r2, h2);
        __syncthreads();
        l += __shfl_xor(l, 32);
        const float il = 1.f / l;
        LAS float* xch = (LAS float*)(lds + 65536) + wq * (128 * 32);
        if (map == 1) {
#pragma unroll
            for (int bb = 0; bb < 4; ++bb)
#pragma unroll
                for (int i = 0; i < 16; ++i) { const int dv = 32 * bb + (i & 3) + 8 * (i >> 2) + 4 * h2; xch[dv * 32 + r2] = o[bb][i] * il; }
        }
        __syncthreads();
        if (map == 0) {
            float ss = 0.f;
#pragma unroll
            for (int bb = 0; bb < 4; ++bb)
#pragma unroll
                for (int i = 0; i < 16; ++i) { const int dv = 32 * bb + (i & 3) + 8 * (i >> 2) + 4 * h2; const float v = o[bb][i] * il - lam_full * xch[dv * 32 + r2]; o[bb][i] = v; ss += v * v; }
            ss += __shfl_xor(ss, 32);
            const float rinv = rsqrtf(ss * (1.f / 128.f) + EPS) * (1.f - li);
            bf16_t* op = w.O + (size_t)qtok2 * D + head * 128;
#pragma unroll
            for (int bb = 0; bb < 4; ++bb)
#pragma unroll
                for (int g = 0; g < 4; g += 2) {
                    const int dv = 32 * bb + 8 * g + 4 * h2;
                    const f32x4 g0 = *(const LAS f32x4*)(lds + TILETAB_OFF + dv * 4), g1 = *(const LAS f32x4*)(lds + TILETAB_OFF + (dv + 8) * 4);
                    u32x2 a, c2;
                    a.x = cvt_pk_bf16(o[bb][4 * g] * rinv * g0[0], o[bb][4 * g + 1] * rinv * g0[1]); a.y = cvt_pk_bf16(o[bb][4 * g + 2] * rinv * g0[2], o[bb][4 * g + 3] * rinv * g0[3]);
                    c2.x = cvt_pk_bf16(o[bb][4 * g + 4] * rinv * g1[0], o[bb][4 * g + 5] * rinv * g1[1]); c2.y = cvt_pk_bf16(o[bb][4 * g + 6] * rinv * g1[2], o[bb][4 * g + 7] * rinv * g1[3]);
                    const auto sx = __builtin_amdgcn_permlane32_swap(a.x, c2.x, false, false), sy = __builtin_amdgcn_permlane32_swap(a.y, c2.y, false, false);
                    u32x4 v; v.x = sx[0]; v.y = sy[0]; v.z = sx[1]; v.w = sy[1];
                    *(u32x4*)(op + 32 * bb + 8 * g + 8 * h2) = v;
                }
        }
        __syncthreads();
    }
}
}

#define XB_TMO      128
#define XB_XCNT(j)  (256  + 64 * (j))
#define XB_XSUB(j)  (1280 + 64 * (j))
#define XB_XGEN(j)  (2304 + 64 * (j))
#define XB_TOP      3328
#define XB_TOPGEN   3392
#define XCD_BAR_WORDS 3456
#define XB_SPIN_CAP (1u << 22)
constexpr int CW_BAR = 8192;
__device__ __forceinline__ unsigned xb_ld(unsigned* p)              { return __hip_atomic_load(p, __ATOMIC_RELAXED, __HIP_MEMORY_SCOPE_AGENT); }
__device__ __forceinline__ unsigned xb_add(unsigned* p, unsigned v) { return __hip_atomic_fetch_add(p, v, __ATOMIC_RELAXED, __HIP_MEMORY_SCOPE_AGENT); }
__device__ __forceinline__ unsigned xb_xcc_id() { return (unsigned)__builtin_amdgcn_s_getreg((3 << 11) | 20) & 0xFu; }
#define XB_SPIN(cond, bar) do { unsigned _sp = 0; while (cond) { __builtin_amdgcn_s_sleep(1); \
    if ((++_sp & 255u) == 0u) { if (xb_ld(&(bar)[XB_TMO])) break; if (_sp > XB_SPIN_CAP) { atomicAdd(&(bar)[XB_TMO], 1u); break; } } } } while (0)
struct XcdBarrier { unsigned* bar; unsigned x; volatile LAS unsigned* st; };
__device__ __forceinline__ XcdBarrier xcd_barrier_post(unsigned* bar, volatile LAS unsigned* st) {
    XcdBarrier b; b.bar = bar; b.x = xb_xcc_id(); b.st = st;
    if (tidx() == 0) (void)xb_add(&bar[XB_XCNT(b.x)], 1u);
    return b;
}
__device__ __forceinline__ void xcd_barrier_complete(unsigned* bar, unsigned x, unsigned& nloc, unsigned& nx) {
    const unsigned G = gridDim.x * gridDim.y * gridDim.z;
    unsigned sum, cnt, mine, sp = 0u;
    for (;;) {
        sum = 0u; cnt = 0u; mine = 0u;
#pragma unroll
        for (unsigned j = 0; j < 16; ++j) { const unsigned c = xb_ld(&bar[XB_XCNT(j)]); sum += c; cnt += (c > 0u) ? 1u : 0u; mine = (j == x) ? c : mine; }
        if (sum == G) break;
        __builtin_amdgcn_s_sleep(1);
        if ((++sp & 255u) == 0u) { if (xb_ld(&bar[XB_TMO])) break; if (sp > XB_SPIN_CAP) { atomicAdd(&bar[XB_TMO], 1u); break; } }
    }
    nloc = mine > 0u ? mine : 1u; nx = cnt > 0u ? cnt : 1u;
}
__device__ __forceinline__ void xcd_barrier(const XcdBarrier& b) {
    asm volatile("s_waitcnt vmcnt(0)" ::: "memory");
    __syncthreads();
    if (tidx() == 0) {
        unsigned* bar = b.bar;
        __builtin_amdgcn_s_waitcnt(0);
        unsigned nloc = b.st[0], nx = b.st[1];
        if (nloc == 0u) { xcd_barrier_complete(bar, b.x, nloc, nx); b.st[0] = nloc; b.st[1] = nx; }
        const unsigned old = xb_add(&bar[XB_XSUB(b.x)], 1u);
        const unsigned gen = old / nloc;
        if (old + 1u == (gen + 1u) * nloc) {
            __builtin_amdgcn_fence(__ATOMIC_RELEASE, "agent");
            asm volatile("s_waitcnt vmcnt(0)" ::: "memory");
            const unsigned og = xb_add(&bar[XB_TOP], 1u);
            const unsigned tg = og / nx;
            if (og + 1u == (tg + 1u) * nx) xb_add(&bar[XB_TOPGEN], 1u);
            else XB_SPIN(xb_ld(&bar[XB_TOPGEN]) == tg, bar);
            __builtin_amdgcn_fence(__ATOMIC_ACQUIRE, "agent");
            xb_add(&bar[XB_XGEN(b.x)], 1u);
            asm volatile("s_waitcnt vmcnt(0)" ::: "memory");
        } else {
            XB_SPIN(xb_ld(&bar[XB_XGEN(b.x)]) == gen, bar);
            __builtin_amdgcn_fence(__ATOMIC_ACQUIRE, "agent");
            asm volatile("s_waitcnt vmcnt(0)" ::: "memory");
        }
    }
    __syncthreads();
}

constexpr int MK_NSTEPS = 2 + 7 * DEPTH;
#ifndef CONV_BUDGET
#define CONV_BUDGET 2
#endif
__global__ void __launch_bounds__(NTHR, 2) mk_fwd(Params p) {
    extern __shared__ __attribute__((aligned(16))) unsigned char lds_raw[];
    LAS unsigned char* lds = (LAS unsigned char*)lds_raw;
    const int tid = tidx();
    for (int u = tid; u < (LDS_BYTES - LDSCTL_OFF) / 4; u += NTHR) ((LAS unsigned*)(lds + LDSCTL_OFF))[u] = 0u;
    __syncthreads();
    volatile LAS unsigned* MISC = (volatile LAS unsigned*)(lds + MISC_OFF);
    XcdBarrier bar = xcd_barrier_post((unsigned*)(p.ws + WS_CTL) + CW_BAR, MISC + 8);
    const int G = gridDim.x, c = bidx();
    for (int s = p.step_lo; s < p.step_hi; ++s) {
        if (s > p.step_lo) {
            if (p.step_hi > 1000000) cg::this_grid().sync();
            const bool dataflow = (s >= 1 && s < MK_NSTEPS - 1 && (s - 1) % 7 == 4);
            if (!dataflow) xcd_barrier(bar); else __syncthreads();
        }
#if defined(__HIP_DEVICE_COMPILE__)
        const __attribute__((address_space(4))) Params* pp4 = (const __attribute__((address_space(4))) Params*)__builtin_amdgcn_kernarg_segment_ptr();
        asm volatile("" : "+s"(pp4));
        const Params P = *pp4;
#else
        const Params P = p;
#endif
        unsigned char* wsb = P.ws;
        const Ws w = make_ws(wsb);
        if (s == 0) {
            phase_convert(P, wsb, lds, 0, 1); __syncthreads();
            phase_prologue(P, w, (float*)lds_raw); __syncthreads();
            continue;
        }
        if (s == MK_NSTEPS - 1) { phase_norm(P, w, DEPTH - 1, 2, lds); continue; }
        const int l = (s - 1) / 7, ph = (s - 1) % 7;
        const char* wl = (const char*)(wsb + WS_W + (size_t)l * WL_BYTES);
        if (ph == 0) { phase_norm(P, w, l, 0, lds);
            if (l > 0) { __syncthreads(); convert_pull(P, wsb, lds, l, -1, 0); } }
        else if (ph == 1) {
            SchedQKV S{(const char*)w.H, wl + WO_QK, wl + WO_V, G, c};
            EpiQKV E{w.QK, w.VT, w.rope_cos, w.rope_sin, (l & 1) != 0};
            pg8::gemm_phase<EpiQKV, SchedQKV, true, true>(lds, D, S, E); __syncthreads();
            if (864 % G != 0 && c >= 864 % G) convert_pull(P, wsb, lds, l, CONV_BUDGET, 1);
        } else if (ph == 2) {
            if (l & 1) att::diff_phase(P, w, lds, l); else att::natten_phase(P, w, lds, l);
        } else if (ph == 3) {
            SchedWO S{(const char*)w.O, wl + WO_O, (l == DEPTH - 1) ? NLAT / 256 : NTOK / 256, 4, G, c};
            EpiWO E{P.x, P.ctx, w.X, w.mods + (size_t)l * 9 * (NMOD * D) + 2 * D, l == 0, w.ctl + CW_WOD + 128 * l};
            pg8::gemm_phase<EpiWO, SchedWO, true, true>(lds, D, S, E);
            __syncthreads();
            { const int nwo = ((l == DEPTH - 1) ? NLAT / 256 : NTOK / 256) * 4;
              if (nwo % G == 0 ? (nwo / G == 1) : (G == 256 ? c < 224 : c >= nwo % G)) convert_pull(P, wsb, lds, l, l == 0 ? 2 : 1, 1); }
        } else if (ph == 4) { phase_norm2(P, w, l, lds); __syncthreads();
            convert_pull(P, wsb, lds, l, -1, 1);
        }
        else if (ph == 5) {
            LAS unsigned* tab = (LAS unsigned*)(lds + TILETAB_OFF);
            const int ntile = build_tile_table(w, l, tab);
            SchedMoe<true> S{(const char*)w.H, wl + WO_E, w.list, tab, ntile, 8, G, c, 0};
            EpiGLU E{w.ACT};
            pg8::gemm_phase<EpiGLU, SchedMoe<true>, true, true>(lds, D, S, E);
        } else {
            LAS unsigned* tab = (LAS unsigned*)(lds + TILETAB_OFF);
            const int ntile = build_tile_table(w, l, tab);
            SchedMoe<false> S{(const char*)w.ACT, wl + WO_E, w.list, tab, ntile, 4, G, c, WE_2};
            EpiDown E{w.Y};
            pg8::gemm_phase<EpiDown, SchedMoe<false>, true, true>(lds, D, S, E); __syncthreads();
            if ((ntile * 4) % G != 0 && c >= (ntile * 4) % G) {
                const int done = convert_pull(P, wsb, lds, l + 1, CONV_BUDGET, 0);
                if (done < CONV_BUDGET) convert_pull(P, wsb, lds, l + 1, CONV_BUDGET - done, 1);
            }
        }
    }
}

extern "C" void kernel_launch(void* const* d_in, const int* in_sizes, int n_in, void* d_out, int out_size, void* d_ws, size_t ws_size, hipStream_t stream) {
    static int grid = 0;
    if (grid == 0) {
        int dev = 0, cus = 0, per_cu = 0;
        (void)hipGetDevice(&dev);
        (void)hipDeviceGetAttribute(&cus, hipDeviceAttributeMultiprocessorCount, dev);
        if (hipFuncSetAttribute((const void*)mk_fwd, hipFuncAttributeMaxDynamicSharedMemorySize, LDS_BYTES) != hipSuccess) { fprintf(stderr, "kernel_launch: hipFuncSetAttribute failed\n"); grid = -1; }
        if (hipOccupancyMaxActiveBlocksPerMultiprocessor(&per_cu, (const void*)mk_fwd, NTHR, LDS_BYTES) != hipSuccess || per_cu < 1) { fprintf(stderr, "kernel_launch: occupancy query says %d blocks per CU\n", per_cu); if (grid == 0) grid = -1; }
        (void)hipGetLastError();
        if (grid == 0) grid = cus;
        if (grid > 0 && grid < 144) { fprintf(stderr, "kernel_launch: built for >= 144 CUs (got %d)\n", grid); grid = -1; }
        if (ws_size < WS_END) { fprintf(stderr, "kernel_launch: workspace too small (%zu < %zu)\n", ws_size, (size_t)WS_END); grid = -1; }
    }
    if (grid < 0) return;
    (void)hipMemsetAsync((char*)d_ws + WS_CTL, 0, CTL_BYTES, stream);
    Params p{};
    const float** pp = (const float**)&p;
    for (int i = 0; i < 19; ++i) pp[i] = (const float*)d_in[i];
    p.out = (float*)d_out; p.ws = (unsigned char*)d_ws;
    const dim3 blk(NTHR);
    p.step_lo = 0; p.step_hi = MK_NSTEPS;
    void* args[] = {&p};
    hipError_t e = hipLaunchCooperativeKernel((const void*)mk_fwd, dim3(grid), blk, args, LDS_BYTES, stream);
    if (e != hipSuccess) fprintf(stderr, "cooperative launch failed: %s (grid %d)\n", hipGetErrorString(e), grid);
}
```
